# Optimizing an MI355X kernel written in HIP

```python
import math
import jax, jax.numpy as jnp
from jax import lax
import numpy as np

D_MODEL = 1024
BATCH = 4
SEQ = 8192
DEPTH = 4

GRID_W = 64
CTX_LEN = 256
EPS = 1e-6
ADA_SCALE = 0.5
HEAD_DIM = 128
BLOCK = 128
A_Q_HEADS = 8
A_KV_HEADS = 2
A_REP = A_Q_HEADS // A_KV_HEADS
WINDOW = 128
B_Q_HEADS = 8
B_KV_HEADS = 2
B_REP = B_Q_HEADS // B_KV_HEADS
ROPE_THETA = 10000.0
A_Q = A_Q_HEADS * HEAD_DIM
A_KV = A_KV_HEADS * HEAD_DIM
B_Q = B_Q_HEADS * HEAD_DIM
B_KV = B_KV_HEADS * HEAD_DIM
ATTN_SPLITS = [A_Q, A_KV, A_KV, A_Q, B_Q, B_KV, B_KV, B_Q]
ATTN_IN = sum(ATTN_SPLITS)
ATTN_WIDTH = A_Q + B_Q
D_INNER = 2 * D_MODEL
SSM_HEAD_DIM = 64
SSM_HEADS = D_INNER // SSM_HEAD_DIM
SSM_GROUPS = 8
D_STATE = 128
D_CONV = 3
SSM_CHUNK = 128
CONV_DIM = D_INNER + 2 * SSM_GROUPS * D_STATE
SSM_SPLITS = [D_INNER, CONV_DIM, 2 * SSM_HEADS]
SSM_IN = sum(SSM_SPLITS)

kernel_name = "hybrid_ctx_prefix_attn_ssd_backbone"


def split_cols(t, sizes):
    idx = np.cumsum(sizes)[:-1].tolist()
    return jnp.split(t, idx, axis=-1)


def rms_norm(x, w):
    xf = x.astype(jnp.float32)
    y = xf * lax.rsqrt(jnp.mean(xf * xf, axis=-1, keepdims=True) + EPS)
    return (y * w.astype(jnp.float32)).astype(x.dtype)


def axial_rope_tables(n_rows):
    row = jnp.repeat(jnp.arange(n_rows), GRID_W).astype(jnp.float32)
    col = jnp.tile(jnp.arange(GRID_W), n_rows).astype(jnp.float32)
    n_freq = HEAD_DIM // 4
    inv = 1.0 / (ROPE_THETA ** (jnp.arange(n_freq, dtype=jnp.float32) / n_freq))
    ang = jnp.concatenate([row[:, None] * inv, col[:, None] * inv], axis=-1)
    return jnp.cos(ang), jnp.sin(ang)


def apply_rope(x, cos, sin):
    xp = x.astype(jnp.float32).reshape(*x.shape[:-1], HEAD_DIM // 2, 2)
    x0, x1 = xp[..., 0], xp[..., 1]
    c = cos[None, :, None, :]
    s = sin[None, :, None, :]
    out = jnp.stack([x0 * c - x1 * s, x0 * s + x1 * c], axis=-1)
    return out.reshape(x.shape).astype(x.dtype)


def to_heads(t, n):
    return t.reshape(*t.shape[:-1], n, HEAD_DIM)


def group_q(q, n_kv):
    return q.reshape(q.shape[0], q.shape[1], n_kv, q.shape[2] // n_kv, HEAD_DIM)


def gqa_softmax(q, segments, sink):
    scale = HEAD_DIM ** -0.5
    logits = []
    for k, v, mask in segments:
        s = jnp.einsum('bqgrd,bkgd->bgrqk', q, k).astype(jnp.float32) * scale
        if mask is not None:
            s = jnp.where(mask, s, -jnp.inf)
        logits.append(s)
    if sink is not None:
        sk = sink.astype(jnp.float32)[None, :, :, None, None]
        logits.append(jnp.broadcast_to(sk, logits[-1].shape[:-1] + (1,)))
    p = jax.nn.softmax(jnp.concatenate(logits, axis=-1), axis=-1)
    out = None
    off = 0
    for k, v, _ in segments:
        n = k.shape[1]
        o = jnp.einsum('bgrqk,bkgd->bqgrd', p[..., off:off + n].astype(v.dtype), v)
        out = o if out is None else out + o
        off += n
    return out


def windowed_attn(q, k, v, kc, vc, sink):
    b, T = q.shape[:2]
    nb = T // BLOCK
    pad = ((0, 0), (BLOCK, BLOCK), (0, 0), (0, 0))
    kp = jnp.pad(k, pad)
    vp = jnp.pad(v, pad)
    qoff = jnp.arange(BLOCK)
    koff = jnp.arange(3 * BLOCK) - BLOCK

    def block(i):
        s = i * BLOCK
        qi = lax.dynamic_slice_in_dim(q, s, BLOCK, axis=1)
        ki = lax.dynamic_slice_in_dim(kp, s, 3 * BLOCK, axis=1)
        vi = lax.dynamic_slice_in_dim(vp, s, 3 * BLOCK, axis=1)
        qpos = s + qoff
        kpos = s + koff
        mask = (jnp.abs(qpos[:, None] - kpos[None, :]) <= WINDOW) & (kpos >= 0)[None, :] & (kpos < T)[None, :]
        return gqa_softmax(qi, [(ki, vi, mask), (kc, vc, None)], sink)

    out = lax.map(block, jnp.arange(nb))
    return jnp.moveaxis(out, 0, 1).reshape(b, T, -1)


def dense_attn(q, k, v, kc, vc):
    b, T = q.shape[:2]
    nb = T // BLOCK

    def block(i):
        qi = lax.dynamic_slice_in_dim(q, i * BLOCK, BLOCK, axis=1)
        return gqa_softmax(qi, [(k, v, None), (kc, vc, None)], None)

    out = lax.map(block, jnp.arange(nb))
    return jnp.moveaxis(out, 0, 1).reshape(b, T, -1)


def attn_mixer(h, hc, w_in, w_out, sink, q_norm, k_norm, cos, sin, need_ctx):
    qa, ka, va, ga, qb, kb, vb, gb = split_cols(h @ w_in, ATTN_SPLITS)
    qac, kac, vac, gac, qbc, kbc, vbc, gbc = split_cols(hc @ w_in, ATTN_SPLITS)
    sink_g = sink.reshape(A_KV_HEADS, A_REP)
    qa = apply_rope(to_heads(qa, A_Q_HEADS), cos, sin)
    ka = apply_rope(to_heads(ka, A_KV_HEADS), cos, sin)
    va = to_heads(va, A_KV_HEADS)
    kac = to_heads(kac, A_KV_HEADS)
    vac = to_heads(vac, A_KV_HEADS)
    ya = windowed_attn(group_q(qa, A_KV_HEADS), ka, va, kac, vac, sink_g)
    qb = apply_rope(rms_norm(to_heads(qb, B_Q_HEADS), q_norm), cos, sin)
    kb = apply_rope(rms_norm(to_heads(kb, B_KV_HEADS), k_norm), cos, sin)
    vb = to_heads(vb, B_KV_HEADS)
    kbc = rms_norm(to_heads(kbc, B_KV_HEADS), k_norm)
    vbc = to_heads(vbc, B_KV_HEADS)
    yb = dense_attn(group_q(qb, B_KV_HEADS), kb, vb, kbc, vbc)
    y = jnp.concatenate([ya * jax.nn.silu(ga), yb * jax.nn.silu(gb)], axis=-1) @ w_out
    if not need_ctx:
        return y, None
    b, C = hc.shape[:2]
    yac = gqa_softmax(group_q(to_heads(qac, A_Q_HEADS), A_KV_HEADS), [(kac, vac, None)], sink_g).reshape(b, C, A_Q)
    qbc = rms_norm(to_heads(qbc, B_Q_HEADS), q_norm)
    ybc = gqa_softmax(group_q(qbc, B_KV_HEADS), [(kbc, vbc, None)], None).reshape(b, C, B_Q)
    yc = jnp.concatenate([yac * jax.nn.silu(gac), ybc * jax.nn.silu(gbc)], axis=-1) @ w_out
    return y, yc


def dwconv_centered(u, w, bias):
    L = u.shape[1]
    p = D_CONV // 2
    up = jnp.pad(u, ((0, 0), (p, p), (0, 0)))
    out = bias
    for j in range(D_CONV):
        out = out + w[j] * up[:, j:j + L]
    return out


def ssd_chunked(x, dt, A, Bm, Cm, h0):
    b, L, H, P = x.shape
    G, N = Bm.shape[2], Bm.shape[3]
    R = H // G
    Q = SSM_CHUNK
    nc = L // Q
    f32 = jnp.float32
    xdt = x.astype(f32) * dt[..., None]
    a = dt * A
    tri = jnp.tril(jnp.ones((Q, Q), dtype=bool))

    def chunks(t):
        return jnp.moveaxis(t.reshape(b, nc, Q, *t.shape[2:]), 1, 0)

    def step(h, inp):
        xc, ac, Bc, Cc = inp
        acum = jnp.cumsum(ac, axis=1)
        seg = acum[:, :, None, :] - acum[:, None, :, :]
        Lm = jnp.exp(jnp.where(tri[None, :, :, None], seg, -jnp.inf)).reshape(b, Q, Q, G, R)
        CB = jnp.einsum('blgn,bsgn->bgls', Cc, Bc)
        xg = xc.reshape(b, Q, G, R, P)
        y_diag = jnp.einsum('bgls,blsgr,bsgrp->blgrp', CB, Lm, xg)
        hg = h.reshape(b, G, R, P, N)
        y_off = jnp.einsum('blgn,bgrpn->blgrp', Cc, hg) * jnp.exp(acum).reshape(b, Q, G, R)[..., None]
        w_end = jnp.exp(acum[:, -1:, :] - acum).reshape(b, Q, G, R)
        h_new = jnp.exp(acum[:, -1])[:, :, None, None] * h + jnp.einsum('bsgn,bsgr,bsgrp->bgrpn', Bc, w_end, xg).reshape(b, H, P, N)
        return h_new, (y_diag + y_off).reshape(b, Q, H, P)

    h_fin, ys = lax.scan(step, h0.astype(f32), (chunks(xdt), chunks(a), chunks(Bm.astype(f32)), chunks(Cm.astype(f32))))
    y = jnp.moveaxis(ys, 0, 1).reshape(b, L, H, P)
    return y.astype(x.dtype), h_fin


def gated_rms_norm(y, z, w):
    g = (y * jax.nn.silu(z)).astype(jnp.float32)
    gr = g.reshape(*g.shape[:-1], SSM_GROUPS, D_INNER // SSM_GROUPS)
    gr = gr * lax.rsqrt(jnp.mean(gr * gr, axis=-1, keepdims=True) + EPS)
    return (gr.reshape(g.shape) * w.astype(jnp.float32)).astype(y.dtype)


def ssm_mixer(h, hc, w_in, conv_w, conv_b, dt_bias, a_log, d_skip, norm_w, w_out, need_ctx):
    def prep(u):
        bsz, L = u.shape[:2]
        z, xbc, dt = split_cols(u @ w_in, SSM_SPLITS)
        xbc = jax.nn.silu(dwconv_centered(xbc, conv_w, conv_b))
        xs, Bm, Cm = split_cols(xbc, [D_INNER, SSM_GROUPS * D_STATE, SSM_GROUPS * D_STATE])
        xs = xs.reshape(bsz, L, SSM_HEADS, SSM_HEAD_DIM)
        Bm = Bm.reshape(bsz, L, SSM_GROUPS, D_STATE)
        Cm = Cm.reshape(bsz, L, SSM_GROUPS, D_STATE)
        dt = jax.nn.softplus(dt.astype(jnp.float32).reshape(bsz, L, 2, SSM_HEADS) + dt_bias.astype(jnp.float32))
        return z, xs, Bm, Cm, dt

    rev = lambda t: t[:, ::-1]
    A = -jnp.exp(a_log.astype(jnp.float32))
    zc, xc, Bc, Cc, dtc = prep(hc)
    z, xl, Bl, Cl, dtl = prep(h)
    h0 = jnp.zeros((h.shape[0], SSM_HEADS, SSM_HEAD_DIM, D_STATE), jnp.float32)
    yc_f, sc_f = ssd_chunked(xc, dtc[:, :, 0], A[0], Bc, Cc, h0)
    yc_b, sc_b = ssd_chunked(rev(xc), rev(dtc[:, :, 1]), A[1], rev(Bc), rev(Cc), h0)
    y_f, _ = ssd_chunked(xl, dtl[:, :, 0], A[0], Bl, Cl, sc_f)
    y_b, _ = ssd_chunked(rev(xl), rev(dtl[:, :, 1]), A[1], rev(Bl), rev(Cl), sc_b)

    def finish(yf, yb_rev, xs, zz):
        y = yf + rev(yb_rev) + d_skip[:, None] * xs
        y = gated_rms_norm(y.reshape(*xs.shape[:2], D_INNER), zz, norm_w)
        return y @ w_out

    out = finish(y_f, y_b, xl, z)
    out_c = finish(yc_f, yc_b, xc, zc) if need_ctx else None
    return out, out_c


def setup_inputs(seed: int = 0) -> dict:
    key = jax.random.key(seed)
    ks = jax.random.split(key, 24)
    na = (DEPTH + 1) // 2
    ns = DEPTH // 2
    nrm = lambda k, shape, scale: jax.random.normal(k, shape, jnp.float32) * scale
    dt0 = jnp.exp(jax.random.uniform(ks[16], (ns, 2, SSM_HEADS), jnp.float32, math.log(1e-3), math.log(1e-1)))
    return {
        "x": nrm(ks[0], (BATCH, SEQ, D_MODEL), 1.0),
        "c": nrm(ks[1], (BATCH, D_MODEL), 1.0),
        "ctx": nrm(ks[2], (BATCH, CTX_LEN, D_MODEL), 1.0),
        "c_ctx": nrm(ks[3], (D_MODEL,), 1.0),
        "w_ada": nrm(ks[4], (DEPTH, D_MODEL, 3 * D_MODEL), ADA_SCALE * D_MODEL ** -0.5),
        "b_ada": nrm(ks[5], (DEPTH, 3 * D_MODEL), 0.01),
        "norm_pre": 1.0 + nrm(ks[6], (DEPTH, D_MODEL), 0.05),
        "norm_post": 1.0 + nrm(ks[7], (DEPTH, D_MODEL), 0.05),
        "attn_w_in": nrm(ks[8], (na, D_MODEL, ATTN_IN), D_MODEL ** -0.5),
        "attn_w_out": nrm(ks[9], (na, ATTN_WIDTH, D_MODEL), ATTN_WIDTH ** -0.5),
        "attn_sink": nrm(ks[10], (na, A_Q_HEADS), 0.5),
        "attn_q_norm": 1.0 + nrm(ks[11], (na, HEAD_DIM), 0.05),
        "attn_k_norm": 1.0 + nrm(ks[12], (na, HEAD_DIM), 0.05),
        "ssm_w_in": nrm(ks[13], (ns, D_MODEL, SSM_IN), D_MODEL ** -0.5),
        "ssm_conv_w": nrm(ks[14], (ns, D_CONV, CONV_DIM), D_CONV ** -0.5),
        "ssm_conv_b": nrm(ks[15], (ns, CONV_DIM), 0.01),
        "ssm_dt_bias": dt0 + jnp.log(-jnp.expm1(-dt0)),
        "ssm_a_log": jnp.log(jax.random.uniform(ks[17], (ns, 2, SSM_HEADS), jnp.float32, 1.0, 16.0)),
        "ssm_d": 1.0 + nrm(ks[18], (ns, SSM_HEADS), 0.1),
        "ssm_norm": 1.0 + nrm(ks[19], (ns, D_INNER), 0.05),
        "ssm_w_out": nrm(ks[20], (ns, D_INNER, D_MODEL), D_INNER ** -0.5),
    }


def reference(x, c, ctx, c_ctx, w_ada, b_ada, norm_pre, norm_post, attn_w_in, attn_w_out, attn_sink,
              attn_q_norm, attn_k_norm, ssm_w_in, ssm_conv_w, ssm_conv_b, ssm_dt_bias, ssm_a_log, ssm_d,
              ssm_norm, ssm_w_out):
    T = x.shape[1]
    ROWS = T // GRID_W
    cos, sin = axial_rope_tables(ROWS)
    silu_c = jax.nn.silu(c)
    silu_cc = jax.nn.silu(c_ctx)
    for l in range(DEPTH):
        need_ctx = l < DEPTH - 1
        sh, sc, gt = jnp.split(silu_c @ w_ada[l] + b_ada[l], 3, axis=-1)
        shc, scc, gtc = jnp.split(silu_cc @ w_ada[l] + b_ada[l], 3, axis=-1)
        h = rms_norm(x, norm_pre[l]) * (1.0 + sc[:, None, :]) + sh[:, None, :]
        hc = rms_norm(ctx, norm_pre[l]) * (1.0 + scc) + shc
        i = l // 2
        if l % 2 == 0:
            y, yc = attn_mixer(h, hc, attn_w_in[i], attn_w_out[i], attn_sink[i], attn_q_norm[i],
                               attn_k_norm[i], cos, sin, need_ctx)
        else:
            y, yc = ssm_mixer(h, hc, ssm_w_in[i], ssm_conv_w[i], ssm_conv_b[i], ssm_dt_bias[i],
                              ssm_a_log[i], ssm_d[i], ssm_norm[i], ssm_w_out[i], need_ctx)
        x = x + gt[:, None, :] * rms_norm(y, norm_post[l])
        if need_ctx:
            ctx = ctx + gtc * rms_norm(yc, norm_post[l])
    return x
```

```cpp
#include <hip/hip_runtime.h>
#include <hip/hip_bf16.h>
#include <hip/hip_cooperative_groups.h>
#include <cstdio>
#include <cstdint>
namespace cg = cooperative_groups;

constexpr int T_ = 8192, NB = 4, CL = 256, DM = 1024, MLAT = NB * T_, MCTX = NB * CL, MTOT = MLAT + MCTX;
constexpr int DEPTH_ = 4;
constexpr int AIN = 5120, AW = 2048;
constexpr int DI = 2048, CONVD = 4096, SSMH = 32, NXB = 4352;
constexpr float EPS_ = 1e-6f;
constexpr int PC_QA = 0, PC_QB = 1024, PC_KA = 2048, PC_VA = 2304, PC_KB = 2560, PC_VB = 2816, PC_GA = 3072, PC_GB = 4096;

constexpr size_t MiB = 1u << 20;
constexpr size_t WS_MOD = 1 * MiB;
constexpr size_t WS_ROPE = WS_MOD + 512 * 1024;
constexpr size_t WS_CTX = 2 * MiB;
constexpr size_t WS_W1 = 6 * MiB;
constexpr size_t WS_W2 = 19 * MiB;
constexpr size_t WS_HY = 26 * MiB;
constexpr size_t WS_DT = 92 * MiB;
constexpr size_t WS_HALO = 101 * MiB;
constexpr size_t WS_BIG = 106 * MiB;
constexpr size_t WS_Y = 370 * MiB;
constexpr size_t WS_END = 502 * MiB;

typedef unsigned short bf16_t;
typedef short bf16x8 __attribute__((ext_vector_type(8)));
typedef short s16x4 __attribute__((ext_vector_type(4)));
typedef float f32x4 __attribute__((ext_vector_type(4)));
typedef float f32x2 __attribute__((ext_vector_type(2)));
typedef float f32x16 __attribute__((ext_vector_type(16)));
typedef unsigned u32x4 __attribute__((ext_vector_type(4)));
typedef unsigned u32x2 __attribute__((ext_vector_type(2)));

__device__ __forceinline__ unsigned cvtpk(float lo, float hi) { unsigned r; asm volatile("v_cvt_pk_bf16_f32 %0, %1, %2" : "=v"(r) : "v"(lo), "v"(hi)); return r; }
__device__ __forceinline__ float bf2f(unsigned short u) { return __uint_as_float((unsigned)u << 16); }
__device__ __forceinline__ float bflo(unsigned w) { return __uint_as_float(w << 16); }
__device__ __forceinline__ float bfhi(unsigned w) { return __uint_as_float(w & 0xffff0000u); }
__device__ __forceinline__ unsigned short f2bf(float f) { return (unsigned short)(cvtpk(f, 0.f) & 0xffffu); }
__device__ __forceinline__ float silu_f(float x) { return x / (1.f + __expf(-x)); }
__device__ __forceinline__ float wave_sum(float v) {
#pragma unroll
    for (int o = 1; o < 64; o <<= 1) v += __shfl_xor(v, o);
    return v;
}
__device__ __forceinline__ int crow(int r, int hi) { return (r & 3) + 8 * (r >> 2) + 4 * hi; }
#define SBAR() __builtin_amdgcn_sched_barrier(0)

#define XLAS __attribute__((address_space(3)))
#define XB_TMO      128
#define XB_XCNT(j)  (256  + 64 * (j))
#define XB_XSUB(j)  (1280 + 64 * (j))
#define XB_XGEN(j)  (2304 + 64 * (j))
#define XB_TOP      3328
#define XB_TOPGEN   3392
#define XCD_BAR_WORDS 3456
#define XB_SPIN_CAP (1u << 18)

__device__ __forceinline__ unsigned xb_ld(unsigned* p)              { return __hip_atomic_load(p, __ATOMIC_RELAXED, __HIP_MEMORY_SCOPE_AGENT); }
__device__ __forceinline__ unsigned xb_add(unsigned* p, unsigned v) { return __hip_atomic_fetch_add(p, v, __ATOMIC_RELAXED, __HIP_MEMORY_SCOPE_AGENT); }
__device__ __forceinline__ unsigned xb_xcc_id() { return (unsigned)__builtin_amdgcn_s_getreg((3 << 11) | 20) & 0xFu; }
#define XB_SPIN(cond, bar) do { unsigned _sp = 0; while (cond) { __builtin_amdgcn_s_sleep(1); \
    if ((++_sp & 255u) == 0u) { if (xb_ld(&(bar)[XB_TMO])) break; if (_sp > XB_SPIN_CAP) { atomicAdd(&(bar)[XB_TMO], 1u); break; } } } } while (0)

struct XcdBarrier {
    unsigned* bar; unsigned x;
    volatile XLAS unsigned* st;
};

__device__ __forceinline__ XcdBarrier xcd_barrier_post(unsigned* bar, volatile XLAS unsigned* st) {
    XcdBarrier b; b.bar = bar; b.x = xb_xcc_id(); b.st = st;
    if (threadIdx.x == 0) (void)xb_add(&bar[XB_XCNT(b.x)], 1u);
    return b;
}
__device__ __forceinline__ void xcd_barrier_complete(unsigned* bar, unsigned x, unsigned& nloc, unsigned& nx) {
    const unsigned G = gridDim.x * gridDim.y * gridDim.z;
    unsigned sum, cnt, mine, sp = 0u;
    for (;;) {
        sum = 0u; cnt = 0u; mine = 0u;
#pragma unroll
        for (unsigned j = 0; j < 16; ++j) { const unsigned c = xb_ld(&bar[XB_XCNT(j)]); sum += c; cnt += (c > 0u) ? 1u : 0u; mine = (j == x) ? c : mine; }
        if (sum == G) break;
        __builtin_amdgcn_s_sleep(1);
        if ((++sp & 255u) == 0u) { if (xb_ld(&bar[XB_TMO])) break; if (sp > XB_SPIN_CAP) { atomicAdd(&bar[XB_TMO], 1u); break; } }
    }
    nloc = mine > 0u ? mine : 1u; nx = cnt > 0u ? cnt : 1u;
}

__device__ __forceinline__ void xcd_barrier(const XcdBarrier& b) {
    asm volatile("s_waitcnt vmcnt(0)" ::: "memory");
    __syncthreads();
    if (threadIdx.x == 0) {
        unsigned* bar = b.bar;
        __builtin_amdgcn_s_waitcnt(0);
        unsigned nloc = b.st[0], nx = b.st[1];
        if (nloc == 0u) { xcd_barrier_complete(bar, b.x, nloc, nx); b.st[0] = nloc; b.st[1] = nx; }
        const unsigned old = xb_add(&bar[XB_XSUB(b.x)], 1u);
        const unsigned gen = old / nloc;
        if (old + 1u == (gen + 1u) * nloc) {
            __builtin_amdgcn_fence(__ATOMIC_RELEASE, "agent");
            asm volatile("s_waitcnt vmcnt(0)" ::: "memory");
            const unsigned og = xb_add(&bar[XB_TOP], 1u);
            const unsigned tg = og / nx;
            if (og + 1u == (tg + 1u) * nx) xb_add(&bar[XB_TOPGEN], 1u);
            else XB_SPIN(xb_ld(&bar[XB_TOPGEN]) == tg, bar);
            __builtin_amdgcn_fence(__ATOMIC_ACQUIRE, "agent");
            xb_add(&bar[XB_XGEN(b.x)], 1u);
            asm volatile("s_waitcnt vmcnt(0)" ::: "memory");
        } else {
            XB_SPIN(xb_ld(&bar[XB_XGEN(b.x)]) == gen, bar);
            __builtin_amdgcn_fence(__ATOMIC_ACQUIRE, "agent");
            asm volatile("s_waitcnt vmcnt(0)" ::: "memory");
        }
    }
    __syncthreads();
}
namespace pg8 {
#define PG8_LAS __attribute__((address_space(3)))
typedef unsigned short bf16_t;
typedef short bf16x8 __attribute__((ext_vector_type(8)));
typedef float f32x4 __attribute__((ext_vector_type(4)));
typedef unsigned u32x4 __attribute__((ext_vector_type(4)));
constexpr int BM = 256, BK = 64, HALF = 128, HTB = HALF * BK * 2  , STAGE_BYTES = 8 * HTB, NXCD = 8, WGM = 8;

__host__ __device__ __forceinline__ int lds_byte(int r, int c) { const int st = (r >> 4) * 2 + (c >> 5), rr = r & 15, cc = c & 31, ob = rr * 64 + cc * 2; return st * 1024 + (ob ^ (((ob >> 9) & 1) << 5)); }
__host__ __device__ __forceinline__ void stage_rc(int b, int& R, int& C) { const int st = b / 1024, sb = b % 1024, swz = sb ^ (((sb >> 9) & 1) << 5); R = (st >> 1) * 16 + swz / 64; C = (st & 1) * 32 + (swz % 64) / 2; }
__host__ __device__ __forceinline__ int perm32(int rho) { const int n = rho >> 4, i = rho & 15; return 8 * (i >> 2) + 4 * n + (i & 3); }

struct Unit { int pm, pn; };
struct Gemm { const bf16_t* A; const bf16_t* Bt; int M, N, K, lda; };

struct StaticOrder {
    int nM, nN, nwg, G, c;
    __host__ __device__ void init(int M, int N, int G_, int c_) { nM = M / BM; nN = N / BM; nwg = nM * nN; G = G_; c = c_; }
    __host__ __device__ bool next(int i, Unit& u) const {
        const long L = (long)i * G + c; if (L >= nwg) return false;
        int wgid = (int)L; { const int q = nwg / NXCD, r = nwg % NXCD, xcd = wgid % NXCD, off = wgid / NXCD; wgid = (xcd < r ? xcd * (q + 1) : r * (q + 1) + (xcd - r) * q) + off; }
        const int nig = WGM * nN, gid = wgid / nig, fm = gid * WGM, gsz = (nM - fm) < WGM ? (nM - fm) : WGM;
        u.pm = fm + ((wgid % nig) % gsz); u.pn = (wgid % nig) / gsz; return true;
    }
    __device__ __forceinline__ void a_ready(const Unit&) const {}
    __device__ __forceinline__ void done(const Unit&) const {}
};

struct EpiBf16 {
    static constexpr bool PERM = true, AFTER_DRAIN = false;
    bf16_t* O; int ldc;
    __device__ __forceinline__ void operator()(const f32x4 (&acc)[2][2][4][2], const Unit& u, int wr, int wc, int fr, int fq) const {
        asm volatile("s_nop 7\n\ts_nop 7\n\ts_nop 7" ::: "memory");
        const int row0 = u.pm * BM + wr * 64 + fr, col0 = u.pn * BM + wc * 32 + 8 * fq;
#pragma unroll
        for (int ai = 0; ai < 2; ++ai)
#pragma unroll
            for (int m = 0; m < 4; ++m) { bf16_t* rowp = O + (size_t)(row0 + ai * HALF + m * 16) * ldc + col0;
#pragma unroll
                for (int bj = 0; bj < 2; ++bj) { const f32x4 v0 = acc[ai][bj][m][0], v1 = acc[ai][bj][m][1];
                    u32x4 w; w.x = cvtpk(v0[0], v0[1]); w.y = cvtpk(v0[2], v0[3]); w.z = cvtpk(v1[0], v1[1]); w.w = cvtpk(v1[2], v1[3]);
                    *(u32x4*)(rowp + bj * HALF) = w; } }
    }
};
struct EpiGnorm {
    static constexpr bool PERM = true, AFTER_DRAIN = false;
    bf16_t* Y; const float* nw; PG8_LAS float* tab;
    __device__ __forceinline__ void operator()(f32x4 (&acc)[2][2][4][2], const Unit& u, int wr, int wc, int fr, int fq) const {
        const int row0 = u.pm * BM + wr * 64 + fr, col0 = u.pn * BM + wc * 32 + 8 * fq;
#pragma unroll
        for (int ai = 0; ai < 2; ++ai)
#pragma unroll
            for (int m = 0; m < 4; ++m) { const bf16_t* yp = Y + (size_t)(row0 + ai * HALF + m * 16) * DI + col0; float ssq = 0.f;
#pragma unroll
                for (int bj = 0; bj < 2; ++bj) { const u32x4 yv = *(const u32x4*)(yp + bj * HALF); f32x4& z0 = acc[ai][bj][m][0]; f32x4& z1 = acc[ai][bj][m][1];
                    z0[0] = bflo(yv.x) * silu_f(z0[0]); z0[1] = bfhi(yv.x) * silu_f(z0[1]); z0[2] = bflo(yv.y) * silu_f(z0[2]); z0[3] = bfhi(yv.y) * silu_f(z0[3]);
                    z1[0] = bflo(yv.z) * silu_f(z1[0]); z1[1] = bfhi(yv.z) * silu_f(z1[1]); z1[2] = bflo(yv.w) * silu_f(z1[2]); z1[3] = bfhi(yv.w) * silu_f(z1[3]);
                    ssq += (z0[0] * z0[0] + z0[1] * z0[1]) + (z0[2] * z0[2] + z0[3] * z0[3]) + (z1[0] * z1[0] + z1[1] * z1[1]) + (z1[2] * z1[2] + z1[3] * z1[3]); }
                ssq += __shfl_xor(ssq, 16); ssq += __shfl_xor(ssq, 32);
                if (fq == 0) tab[(ai * HALF + wr * 64 + m * 16 + fr) * 4 + wc] = ssq; }
        asm volatile("s_waitcnt lgkmcnt(0)" ::: "memory"); __builtin_amdgcn_s_barrier(); asm volatile("" ::: "memory");
        f32x4 w[2][2];
#pragma unroll
        for (int bj = 0; bj < 2; ++bj) { w[bj][0] = *(const f32x4*)(nw + col0 + bj * HALF); w[bj][1] = *(const f32x4*)(nw + col0 + bj * HALF + 4); }
#pragma unroll
        for (int ai = 0; ai < 2; ++ai)
#pragma unroll
            for (int m = 0; m < 4; ++m) { const f32x4 t = *(const PG8_LAS f32x4*)(tab + (ai * HALF + wr * 64 + m * 16 + fr) * 4);
                const float rs = rsqrtf(((t[0] + t[1]) + (t[2] + t[3])) * (1.f / 256.f) + EPS_);
                bf16_t* yp = Y + (size_t)(row0 + ai * HALF + m * 16) * DI + col0;
#pragma unroll
                for (int bj = 0; bj < 2; ++bj) { const f32x4 v0 = acc[ai][bj][m][0] * rs * w[bj][0], v1 = acc[ai][bj][m][1] * rs * w[bj][1];
                    u32x4 o; o.x = cvtpk(v0[0], v0[1]); o.y = cvtpk(v0[2], v0[3]); o.z = cvtpk(v1[0], v1[1]); o.w = cvtpk(v1[2], v1[3]);
                    *(u32x4*)(yp + bj * HALF) = o; } }
    }
};
struct EpiAttnIn {
    static constexpr bool PERM = true, AFTER_DRAIN = false;
    bf16_t* O; const float* knw; const f32x2* rope; PG8_LAS float* tab;
    __device__ __forceinline__ void operator()(f32x4 (&acc)[2][2][4][2], const Unit& u, int wr, int wc, int fr, int fq) const {
        asm volatile("s_nop 7\n\ts_nop 7\n\ts_nop 7" ::: "memory");
        const int row0 = u.pm * BM + wr * 64 + fr, col0 = u.pn * BM + wc * 32 + 8 * fq;
        const bool isK = u.pn == 8 || u.pn == 10, isB = u.pn == 10;
        if (isB) {
#pragma unroll
            for (int ai = 0; ai < 2; ++ai)
#pragma unroll
                for (int m = 0; m < 4; ++m)
#pragma unroll
                    for (int bj = 0; bj < 2; ++bj) { const f32x4 a = acc[ai][bj][m][0], b = acc[ai][bj][m][1];
                        float ssq = (a[0] * a[0] + a[1] * a[1]) + (a[2] * a[2] + a[3] * a[3]) + (b[0] * b[0] + b[1] * b[1]) + (b[2] * b[2] + b[3] * b[3]);
                        ssq += __shfl_xor(ssq, 16); ssq += __shfl_xor(ssq, 32);
                        if (fq == 0) tab[((ai * HALF + wr * 64 + m * 16 + fr) * 2 + bj) * 4 + wc] = ssq; }
            asm volatile("s_waitcnt lgkmcnt(0)" ::: "memory"); __builtin_amdgcn_s_barrier(); asm volatile("" ::: "memory");
        }
        f32x4 kw0 = {1.f, 1.f, 1.f, 1.f}, kw1 = kw0;
        if (isB) { kw0 = *(const f32x4*)(knw + wc * 32 + 8 * fq); kw1 = *(const f32x4*)(knw + wc * 32 + 8 * fq + 4); }
        const int i0 = wc * 16 + 4 * fq;
#pragma unroll
        for (int ai = 0; ai < 2; ++ai)
#pragma unroll
            for (int m = 0; m < 4; ++m) { const int row = row0 + ai * HALF + m * 16; bf16_t* rowp = O + (size_t)row * AIN + col0;
                f32x4 c01 = {1.f, 0.f, 1.f, 0.f}, c23 = c01;
                const bool rot = isK && row < MLAT;
                if (rot) { const int pos = row & (T_ - 1); const int tb = i0 < 32 ? (pos >> 6) : (pos & 63); const f32x4* tp = (const f32x4*)(rope + tb * 32 + (i0 & 31)); c01 = tp[0]; c23 = tp[1]; }
#pragma unroll
                for (int bj = 0; bj < 2; ++bj) { f32x4 v0 = acc[ai][bj][m][0], v1 = acc[ai][bj][m][1];
                    if (isB) { const f32x4 t = *(const PG8_LAS f32x4*)(tab + ((ai * HALF + wr * 64 + m * 16 + fr) * 2 + bj) * 4);
                        const float rs = rsqrtf(((t[0] + t[1]) + (t[2] + t[3])) * (1.f / 128.f) + EPS_); v0 = v0 * rs * kw0; v1 = v1 * rs * kw1; }
                    if (rot) { float x0, x1;
                        x0 = v0[0]; x1 = v0[1]; v0[0] = x0 * c01[0] - x1 * c01[1]; v0[1] = x0 * c01[1] + x1 * c01[0];
                        x0 = v0[2]; x1 = v0[3]; v0[2] = x0 * c01[2] - x1 * c01[3]; v0[3] = x0 * c01[3] + x1 * c01[2];
                        x0 = v1[0]; x1 = v1[1]; v1[0] = x0 * c23[0] - x1 * c23[1]; v1[1] = x0 * c23[1] + x1 * c23[0];
                        x0 = v1[2]; x1 = v1[3]; v1[2] = x0 * c23[2] - x1 * c23[3]; v1[3] = x0 * c23[3] + x1 * c23[2]; }
                    u32x4 w; w.x = cvtpk(v0[0], v0[1]); w.y = cvtpk(v0[2], v0[3]); w.z = cvtpk(v1[0], v1[1]); w.w = cvtpk(v1[2], v1[3]);
                    *(u32x4*)(rowp + bj * HALF) = w; } }
    }
};
struct EpiXbc {
    static constexpr bool PERM = true, AFTER_DRAIN = false;
    bf16_t* O; bf16_t* halo; float* dt; const float* dtb;
    __device__ __forceinline__ void operator()(const f32x4 (&acc)[2][2][4][2], const Unit& u, int wr, int wc, int fr, int fq) const {
        asm volatile("s_nop 7\n\ts_nop 7\n\ts_nop 7" ::: "memory");
        const int row0 = u.pm * BM + wr * 64 + fr;
        if (u.pn < 16) {
            const int col0 = u.pn * BM + wc * 32 + 8 * fq;
#pragma unroll
            for (int ai = 0; ai < 2; ++ai)
#pragma unroll
                for (int m = 0; m < 4; ++m) { const int row = row0 + ai * HALF + m * 16; bf16_t* rowp = O + (size_t)row * CONVD + col0;
                    const int rl = row & 127;
#pragma unroll
                    for (int bj = 0; bj < 2; ++bj) { const f32x4 v0 = acc[ai][bj][m][0], v1 = acc[ai][bj][m][1];
                        u32x4 w; w.x = cvtpk(v0[0], v0[1]); w.y = cvtpk(v0[2], v0[3]); w.z = cvtpk(v1[0], v1[1]); w.w = cvtpk(v1[2], v1[3]);
                        *(u32x4*)(rowp + bj * HALF) = w;
                        if (rl == 0) *(u32x4*)(halo + ((size_t)(row >> 7) * 2 + 0) * CONVD + col0 + bj * HALF) = w;
                        if (rl == 127) *(u32x4*)(halo + ((size_t)(row >> 7) * 2 + 1) * CONVD + col0 + bj * HALF) = w; } }
        } else {
            const int lc = wc * 32 + 8 * fq;
            if (wc < 2) {
                const f32x4 b0 = *(const f32x4*)(dtb + lc), b1 = *(const f32x4*)(dtb + lc + 4);
#pragma unroll
                for (int ai = 0; ai < 2; ++ai)
#pragma unroll
                    for (int m = 0; m < 4; ++m) { const int row = row0 + ai * HALF + m * 16;
                        f32x4 v0 = acc[ai][0][m][0] + b0, v1 = acc[ai][0][m][1] + b1;
#pragma unroll
                        for (int j = 0; j < 4; ++j) { v0[j] = v0[j] > 20.f ? v0[j] : log1pf(__expf(v0[j])); v1[j] = v1[j] > 20.f ? v1[j] : log1pf(__expf(v1[j])); }
#pragma unroll
                        for (int j = 0; j < 4; ++j) { dt[(size_t)(lc + j) * MTOT + row] = v0[j]; dt[(size_t)(lc + 4 + j) * MTOT + row] = v1[j]; } }
            }
        }
    }
};
template <class Epi, class Sched, bool ALIGN_EPI = false, bool SP2 = false>
__device__ __forceinline__ void gemm_phase(PG8_LAS unsigned char* lds, const Gemm g, const Sched& S, const Epi& E, const int tid) {
    const int wid = __builtin_amdgcn_readfirstlane(tid >> 6), lane = tid & 63, wr = wid >> 2, wc = wid & 3, fr = lane & 15, fq = lane >> 4;
    const int K = g.K, nt = K / BK;
    unsigned voffA[2], voffB[2];
#pragma unroll
    for (int i = 0; i < 2; ++i) { int R, C; stage_rc(tid * 16 + i * 8192, R, C); const int Rb = Epi::PERM ? ((R & ~31) + perm32(R & 31)) : R;
        voffA[i] = (unsigned)(R * g.lda + C) * 2u; voffB[i] = (unsigned)(Rb * K + C) * 2u; }
    const size_t kstep = (size_t)(BK * 2);
    const size_t hstepA = (size_t)HALF * g.lda * 2, hstepB = (size_t)HALF * K * 2;
    const size_t tstepA = 2 * hstepA, tstepB = 2 * hstepB;
    const unsigned ldsw = (unsigned)wid * 1024u;
    const int aoff = lds_byte(wr * 64 + fr, fq * 8), boff = lds_byte(wc * 32 + fr, fq * 8);
#define PG8_SA(b, h) (((b) * 2 + (h)) * HTB)
#define PG8_SB(b, h) ((4 + (b) * 2 + (h)) * HTB)
#define PG8_STAGE(bufoff, gbase, voff) do { _Pragma("unroll") for (int _i = 0; _i < 2; ++_i) \
        __builtin_amdgcn_global_load_lds((const unsigned*)((const char*)(gbase) + (voff)[_i]), (PG8_LAS unsigned*)(lds + (bufoff) + ldsw + _i * 8192), 16, 0, 0); } while (0)
#define PG8_LDA(dst, b, h) do { _Pragma("unroll") for (int m = 0; m < 4; ++m) _Pragma("unroll") for (int k = 0; k < 2; ++k) dst[m][k] = *(const PG8_LAS bf16x8*)(lds + PG8_SA(b, h) + aoff + m * 2048 + k * 1024); } while (0)
#define PG8_LDB(dst, b, h) do { _Pragma("unroll") for (int n = 0; n < 2; ++n) _Pragma("unroll") for (int k = 0; k < 2; ++k) dst[n][k] = *(const PG8_LAS bf16x8*)(lds + PG8_SB(b, h) + boff + n * 2048 + k * 1024); } while (0)
#define PG8_MMA(ai, bj, At, Bt) do { __builtin_amdgcn_s_setprio(1); _Pragma("unroll") for (int m = 0; m < 4; ++m) _Pragma("unroll") for (int n = 0; n < 2; ++n) _Pragma("unroll") for (int k = 0; k < 2; ++k) \
        acc[ai][bj][m][n] = __builtin_amdgcn_mfma_f32_16x16x32_bf16(Bt[n][k], At[m][k], acc[ai][bj][m][n], 0, 0, 0); __builtin_amdgcn_s_setprio(0); } while (0)
#define PG8_WAIT_V(n) asm volatile("s_waitcnt vmcnt(" #n ")" ::: "memory")
#define PG8_WAIT_L(n) asm volatile("s_waitcnt lgkmcnt(" #n ")" ::: "memory")
#define PG8_BAR __builtin_amdgcn_s_barrier()
#define PG8_SCHED __builtin_amdgcn_sched_barrier(0)
    Unit cur, nxt; int ui = 0;
    if (!S.next(0, cur)) return;
    f32x4 acc[2][2][4][2];
#pragma unroll
    for (int a = 0; a < 2; ++a)
#pragma unroll
        for (int b = 0; b < 2; ++b)
#pragma unroll
            for (int m = 0; m < 4; ++m)
#pragma unroll
                for (int n = 0; n < 2; ++n) acc[a][b][m][n] = (f32x4){0.f, 0.f, 0.f, 0.f};
    bf16x8 At[4][2], B0[2][2], B1[2][2];
    const char* cA = (const char*)g.A + (size_t)cur.pm * tstepA; const char* cB = (const char*)g.Bt + (size_t)cur.pn * tstepB;
    S.a_ready(cur);
    if constexpr (SP2) {
        PG8_STAGE(PG8_SB(0, 0), cB, voffB); PG8_STAGE(PG8_SB(0, 1), cB + hstepB, voffB); PG8_STAGE(PG8_SA(0, 0), cA, voffA); PG8_STAGE(PG8_SA(0, 1), cA + hstepA, voffA);
        if (wr == 1) PG8_BAR;
        PG8_WAIT_V(2); PG8_BAR;
        PG8_STAGE(PG8_SB(1, 0), cB + kstep, voffB); PG8_STAGE(PG8_SA(1, 0), cA + kstep, voffA); PG8_STAGE(PG8_SB(1, 1), cB + hstepB + kstep, voffB);
        PG8_WAIT_V(6); PG8_BAR;
    } else {
        PG8_STAGE(PG8_SB(0, 0), cB, voffB); PG8_STAGE(PG8_SA(0, 0), cA, voffA); PG8_STAGE(PG8_SB(0, 1), cB + hstepB, voffB); PG8_STAGE(PG8_SA(0, 1), cA + hstepA, voffA);
        if (wr == 1) PG8_BAR;
        PG8_WAIT_V(4); PG8_BAR;
        PG8_STAGE(PG8_SB(1, 0), cB + kstep, voffB); PG8_STAGE(PG8_SA(1, 0), cA + kstep, voffA); PG8_STAGE(PG8_SB(1, 1), cB + hstepB + kstep, voffB);
        PG8_WAIT_V(6); PG8_BAR;
    }
    for (;;) {
        const bool has_next = S.next(ui + 1, nxt);
        const char* nA = has_next ? (const char*)g.A + (size_t)nxt.pm * tstepA : cA; const char* nB = has_next ? (const char*)g.Bt + (size_t)nxt.pn * tstepB : cB;
        for (int t = 0; t < nt; t += 2) {
            const bool last = (t == nt - 2);
            const char* a1 = cA + (size_t)(t + 1) * kstep;
            const char* a2 = last ? nA : cA + (size_t)(t + 2) * kstep; const char* b2 = last ? nB : cB + (size_t)(t + 2) * kstep;
            const char* a3 = a2 + kstep; const char* b3 = b2 + kstep;
            if (last && has_next) S.a_ready(nxt);
            if constexpr (SP2) {
            PG8_LDB(B0, 0, 0); PG8_LDB(B1, 0, 1); PG8_SCHED; PG8_LDA(At, 0, 0); PG8_STAGE(PG8_SA(1, 1), a1 + hstepA, voffA);
            PG8_WAIT_V(8); PG8_WAIT_L(0); PG8_BAR; PG8_MMA(0, 0, At, B0); PG8_MMA(0, 1, At, B1); PG8_BAR; PG8_SCHED;
            PG8_LDA(At, 0, 1); PG8_STAGE(PG8_SB(0, 0), b2, voffB); PG8_STAGE(PG8_SB(0, 1), b2 + hstepB, voffB); PG8_STAGE(PG8_SA(0, 0), a2, voffA);
            PG8_WAIT_V(8); PG8_WAIT_L(0); PG8_BAR; PG8_MMA(1, 0, At, B0); PG8_MMA(1, 1, At, B1); PG8_BAR; PG8_SCHED;
            PG8_LDB(B0, 1, 0); PG8_LDB(B1, 1, 1); PG8_SCHED; PG8_LDA(At, 1, 0); PG8_STAGE(PG8_SA(0, 1), a2 + hstepA, voffA);
            PG8_WAIT_V(8); PG8_WAIT_L(0); PG8_BAR; PG8_MMA(0, 0, At, B0); PG8_MMA(0, 1, At, B1); PG8_BAR; PG8_SCHED;
            PG8_LDA(At, 1, 1); PG8_STAGE(PG8_SB(1, 0), b3, voffB); PG8_STAGE(PG8_SB(1, 1), b3 + hstepB, voffB); PG8_STAGE(PG8_SA(1, 0), a3, voffA);
            PG8_WAIT_V(8); PG8_WAIT_L(0); PG8_BAR; PG8_MMA(1, 0, At, B0); PG8_MMA(1, 1, At, B1); PG8_BAR; PG8_SCHED;
            } else {
            PG8_LDB(B0, 0, 0); PG8_SCHED; PG8_LDA(At, 0, 0); PG8_STAGE(PG8_SA(1, 1), a1 + hstepA, voffA);
            PG8_WAIT_L(8); PG8_BAR; PG8_WAIT_L(0); PG8_MMA(0, 0, At, B0); PG8_BAR; PG8_SCHED;
            PG8_LDB(B1, 0, 1); PG8_STAGE(PG8_SB(0, 0), b2, voffB);
            PG8_BAR; PG8_WAIT_L(0); PG8_MMA(0, 1, At, B1); PG8_BAR;
            PG8_LDA(At, 0, 1); PG8_STAGE(PG8_SA(0, 0), a2, voffA);
            PG8_BAR; PG8_WAIT_L(0); PG8_MMA(1, 0, At, B0); PG8_BAR; PG8_SCHED;
            PG8_STAGE(PG8_SB(0, 1), b2 + hstepB, voffB);
            PG8_WAIT_V(6); PG8_BAR; PG8_MMA(1, 1, At, B1); PG8_BAR;
            PG8_LDB(B0, 1, 0); PG8_SCHED; PG8_LDA(At, 1, 0); PG8_STAGE(PG8_SA(0, 1), a2 + hstepA, voffA);
            PG8_WAIT_L(8); PG8_BAR; PG8_WAIT_L(0); PG8_MMA(0, 0, At, B0); PG8_BAR; PG8_SCHED;
            PG8_LDB(B1, 1, 1); PG8_STAGE(PG8_SB(1, 0), b3, voffB);
            PG8_BAR; PG8_WAIT_L(0); PG8_MMA(0, 1, At, B1); PG8_BAR;
            PG8_LDA(At, 1, 1); PG8_STAGE(PG8_SA(1, 0), a3, voffA);
            PG8_BAR; PG8_WAIT_L(0); PG8_MMA(1, 0, At, B0); PG8_BAR; PG8_SCHED;
            PG8_STAGE(PG8_SB(1, 1), b3 + hstepB, voffB);
            PG8_WAIT_V(6); PG8_BAR; PG8_MMA(1, 1, At, B1); PG8_BAR;
            }
        }
        if constexpr (ALIGN_EPI) { if (wr == 0) PG8_BAR; }
        if constexpr (!Epi::AFTER_DRAIN) { E(acc, cur, wr, wc, fr, fq); S.done(cur); }
        if (!has_next) break;
#pragma unroll
        for (int a = 0; a < 2; ++a)
#pragma unroll
            for (int b = 0; b < 2; ++b)
#pragma unroll
                for (int m = 0; m < 4; ++m)
#pragma unroll
                    for (int n = 0; n < 2; ++n) acc[a][b][m][n] = (f32x4){0.f, 0.f, 0.f, 0.f};
        cur = nxt; cA = nA; cB = nB; ++ui;
        if constexpr (ALIGN_EPI) { if (wr == 1) PG8_BAR; }
    }
    PG8_WAIT_V(0);
    if constexpr (!ALIGN_EPI) { if (wr == 0) PG8_BAR; }
    PG8_BAR;
    if constexpr (Epi::AFTER_DRAIN) { E.fused(acc, cur, wr, wc, fr, fq, lds, wid, lane); S.done(cur); }
#undef PG8_SA
#undef PG8_SB
#undef PG8_STAGE
#undef PG8_LDA
#undef PG8_LDB
#undef PG8_MMA
#undef PG8_WAIT_V
#undef PG8_WAIT_L
#undef PG8_BAR
#undef PG8_SCHED
}
}
namespace att {
constexpr int D = 128, NW = 8, QBLK = 32, KVBLK = 64, LDP = AIN;
constexpr float SCALE = 0.088388347648318440f, THR = 8.f;
#ifndef ATT_NQR
#define ATT_NQR 5
#endif
#ifndef ATT_NQR_U
#define ATT_NQR_U 8
#endif
constexpr int NQR = ATT_NQR, NQR_U = ATT_NQR_U;
constexpr size_t SHM_V = KVBLK * D * 2, SHM_K = KVBLK * D * 2, SHM_ATTN = 2 * SHM_V + 2 * SHM_K + NW * 64 * 4, SHM_Q = (8 - NQR) * 8192;
#define KSWZ(row, colB) ((row) * 256 + ((colB) ^ (((row) & 7) << 4)))
__device__ __forceinline__ void partialSM(f32x16& p0, f32x16& p1, float& m_reg, float& mn, float& alpha) {
  constexpr float C = SCALE * 1.4426950408889634f;
  float pmax = p0[0];
#pragma unroll
  for (int r = 1; r < 16; ++r) pmax = fmaxf(pmax, p0[r]);
#pragma unroll
  for (int r = 0; r < 16; ++r) pmax = fmaxf(pmax, p1[r]);
  { auto rr = __builtin_amdgcn_permlane32_swap(__float_as_uint(pmax), __float_as_uint(pmax), false, false);
    pmax = fmaxf(__uint_as_float(rr[0]), __uint_as_float(rr[1])); }
  if (__builtin_expect(__all(pmax - m_reg <= THR / SCALE), 1)) { mn = m_reg; alpha = 1.f; }
  else { mn = fmaxf(m_reg, pmax); alpha = __builtin_amdgcn_exp2f((m_reg - mn) * C); m_reg = mn; }
  float mnC = -mn * C;
#pragma unroll
  for (int r = 0; r < 16; ++r) p0[r] = fmaf(p0[r], C, mnC);
#pragma unroll
  for (int r = 0; r < 16; ++r) p1[r] = fmaf(p1[r], C, mnC);
#pragma unroll
  for (int r = 0; r < 16; ++r) p0[r] = __builtin_amdgcn_exp2f(p0[r]);
}
__device__ __forceinline__ void finishSM(f32x16& p0, f32x16& p1, float alpha, float& l_reg, bf16x8& pa0, bf16x8& pa1, bf16x8& pa2, bf16x8& pa3) {
#pragma unroll
  for (int r = 0; r < 16; ++r) p1[r] = __builtin_amdgcn_exp2f(p1[r]);
  float ps = 0;
#pragma unroll
  for (int r = 0; r < 16; ++r) ps += p0[r];
#pragma unroll
  for (int r = 0; r < 16; ++r) ps += p1[r];
  { auto rr = __builtin_amdgcn_permlane32_swap(__float_as_uint(ps), __float_as_uint(ps), false, false);
    ps = __uint_as_float(rr[0]) + __uint_as_float(rr[1]); }
  l_reg = l_reg * alpha + ps;
#define PK4(P, BASE, OUT) do { unsigned a0 = cvtpk(P[BASE + 0], P[BASE + 1]), a1 = cvtpk(P[BASE + 2], P[BASE + 3]);   \
    unsigned b0 = cvtpk(P[BASE + 4], P[BASE + 5]), b1 = cvtpk(P[BASE + 6], P[BASE + 7]);                              \
    auto r0 = __builtin_amdgcn_permlane32_swap(a0, b0, false, false); auto r1 = __builtin_amdgcn_permlane32_swap(a1, b1, false, false); \
    u32x4 w = {r0[0], r1[0], r0[1], r1[1]}; OUT = *reinterpret_cast<bf16x8*>(&w); } while (0)
  PK4(p0, 0, pa0); PK4(p0, 8, pa1); PK4(p1, 0, pa2); PK4(p1, 8, pa3);
#undef PK4
}
template <int NQ>
__device__ __forceinline__ void qkt(f32x16& p0, f32x16& p1, const char* Ks, const bf16x8* qr, const char* ql, int r32, int hi) {
  p0 = f32x16{}; p1 = f32x16{};
  const int x = (r32 & 7) << 4, kb = r32 * 256;
  const char* a0 = Ks + kb + ((hi * 16) ^ x); const char* a1 = Ks + kb + ((32 + hi * 16) ^ x); const char* a2 = Ks + kb + ((64 + hi * 16) ^ x); const char* a3 = Ks + kb + ((96 + hi * 16) ^ x);
#define QK1(QV, AP, IMM) { const bf16x8 b0 = *reinterpret_cast<const bf16x8*>(AP + IMM); const bf16x8 b1 = *reinterpret_cast<const bf16x8*>(AP + IMM + 8192); const bf16x8 qv = QV; \
    p0 = __builtin_amdgcn_mfma_f32_32x32x16_bf16(b0, qv, p0, 0, 0, 0); p1 = __builtin_amdgcn_mfma_f32_32x32x16_bf16(b1, qv, p1, 0, 0, 0); }
#define QLD(I) (*reinterpret_cast<const bf16x8*>(ql + (I) * 8192))
  #define QSEL(I) ((I) < NQ ? qr[(I) < NQ ? (I) : 0] : QLD((I) - NQ))
  QK1(QSEL(0), a0, 0) QK1(QSEL(1), a1, 0) QK1(QSEL(2), a2, 0) QK1(QSEL(3), a3, 0) QK1(QSEL(4), a0, 128) QK1(QSEL(5), a1, 128) QK1(QSEL(6), a2, 128) QK1(QSEL(7), a3, 128)
#undef QSEL
#undef QK1
#undef QLD
}
__device__ __forceinline__ void wmask(f32x16& p0, f32x16& p1, int kp, int qp, int hi) {
#pragma unroll
  for (int r = 0; r < 16; ++r) { const int d = qp - (kp + crow(r, hi));
    if (d > 128 || d < -128) p0[r] = -INFINITY;
    if (d - 32 > 128 || d - 32 < -128) p1[r] = -INFINITY; }
}
__device__ __forceinline__ int v_st(int k, int c) { const int kk = (k & ~0xC) | ((k & 4) << 1) | ((k & 8) >> 1); return ((kk >> 3) * 4 + (c >> 5)) * 512 + ((kk & 7) * 32 + (c & 31)) * 2; }
__device__ __forceinline__ int v_rd_base(int lane) { return ((lane & 3) << 3) | (((lane >> 2) & 3) << 6) | (((lane >> 4) & 1) << 5) | (((lane >> 5) & 1) << 8); }
constexpr int v_rd_off(int d0, int ks, int half) { return d0 * 512 + ks * 4096 + half * 2048; }
template <int OFF> __device__ __forceinline__ s16x4 tr_read(int vb) {
  s16x4 r; asm volatile("ds_read_b64_tr_b16 %0, %1 offset:%2" : "=&v"(r) : "v"(vb), "i"(OFF) : "memory"); return r;
}
template <int D0> __device__ __forceinline__ void pv_one(f32x16& od, int vb, bf16x8 pa0, bf16x8 pa1, bf16x8 pa2, bf16x8 pa3) {
  const s16x4 l0 = tr_read<v_rd_off(D0, 0, 0)>(vb), h0 = tr_read<v_rd_off(D0, 0, 1)>(vb), l1 = tr_read<v_rd_off(D0, 1, 0)>(vb), h1 = tr_read<v_rd_off(D0, 1, 1)>(vb);
  const s16x4 l2 = tr_read<v_rd_off(D0, 2, 0)>(vb), h2 = tr_read<v_rd_off(D0, 2, 1)>(vb), l3 = tr_read<v_rd_off(D0, 3, 0)>(vb), h3 = tr_read<v_rd_off(D0, 3, 1)>(vb);
  asm volatile("s_waitcnt lgkmcnt(0)" ::: "memory"); SBAR();
#define PK(L, H) (bf16x8){L[0], L[1], L[2], L[3], H[0], H[1], H[2], H[3]}
  od = __builtin_amdgcn_mfma_f32_32x32x16_bf16(pa0, PK(l0, h0), od, 0, 0, 0);
  od = __builtin_amdgcn_mfma_f32_32x32x16_bf16(pa1, PK(l1, h1), od, 0, 0, 0);
  od = __builtin_amdgcn_mfma_f32_32x32x16_bf16(pa2, PK(l2, h2), od, 0, 0, 0);
  od = __builtin_amdgcn_mfma_f32_32x32x16_bf16(pa3, PK(l3, h3), od, 0, 0, 0);
#undef PK
}
__device__ __forceinline__ void pv_d0(f32x16* o, int vb, bf16x8 pa0, bf16x8 pa1, bf16x8 pa2, bf16x8 pa3) {
  pv_one<0>(o[0], vb, pa0, pa1, pa2, pa3); pv_one<1>(o[1], vb, pa0, pa1, pa2, pa3); pv_one<2>(o[2], vb, pa0, pa1, pa2, pa3); pv_one<3>(o[3], vb, pa0, pa1, pa2, pa3);
}

struct Item { int qrow0, qpos0, qcol, gcol, kcol, vcol, n0, r0, r1, NT, kp1, masked, normq, has_sink; float sinkv; };

template <bool MASKED>
__device__ __forceinline__ void attn_item(bf16_t* __restrict__ P, const Item it, const float* __restrict__ qnw, const f32x2* __restrict__ rope, char* lds, const int tid, const bool dry) {
  const int wid = tid >> 6, lane = tid & 63, r32 = lane & 31, hi = lane >> 5;
  constexpr int NBUF = MASKED ? 3 : 4;
  char* V_lds = lds; char* K_lds = lds + NBUF * SHM_V;
  float* ws = (float*)(lds + NBUF * (SHM_V + SHM_K)) + wid * 64; float* li_l = ws; float* al_l = ws + 32;
  float m_reg = -1e30f, l_reg = 0; constexpr int NQ = MASKED ? NQR : NQR_U;
  f32x16 o[4] = {}; bf16x8 qr[NQ > 0 ? NQ : 1]; char* ql = lds + NBUF * (SHM_V + SHM_K) + 2048 + tid * 16;
  const int qrow = it.qrow0 + wid * QBLK + r32;
  const int vb0 = (int)(uintptr_t)V_lds + v_rd_base(lane);
  const int widu = __builtin_amdgcn_readfirstlane(wid);
  unsigned koffs[2], voffs[2];
#pragma unroll
  for (int i = 0; i < 2; ++i) { const int ci = (wid * 2 + i) * 64 + lane;
    { const int row = ci >> 4, cc = (ci & 15) ^ (row & 7); koffs[i] = (unsigned)(row * LDP + cc * 8); }
    { const int sub = ci >> 5, kk = (sub >> 2) * 8 + ((ci & 31) >> 2), k = (kk & ~0xC) | ((kk & 4) << 1) | ((kk & 8) >> 1), cv = (sub & 3) * 32 + (ci & 3) * 8; voffs[i] = (unsigned)(k * LDP + cv); } }
#define ALAS __attribute__((address_space(3)))
#define TROW(t) ((size_t)((t) < it.n0 ? it.r0 + 64 * (t) : it.r1 + 64 * ((t) - it.n0)))
#define DMA(t, b) do { const bf16_t* gb_ = P + TROW(t) * LDP; _Pragma("unroll") for (int i_ = 0; i_ < 2; ++i_) {                                  \
    __builtin_amdgcn_global_load_lds((const unsigned*)(gb_ + it.kcol + koffs[i_]), (ALAS unsigned*)(K_lds + (b) * SHM_K + (widu * 2 + i_) * 1024), 16, 0, 0); \
    __builtin_amdgcn_global_load_lds((const unsigned*)(gb_ + it.vcol + voffs[i_]), (ALAS unsigned*)(V_lds + (b) * SHM_V + (widu * 2 + i_) * 1024), 16, 0, 0); } } while (0)
#define LANDED() do { asm volatile("s_waitcnt vmcnt(0)" ::: "memory"); __builtin_amdgcn_s_barrier(); asm volatile("" ::: "memory"); } while (0)
#define RESC(a) do { if (__any((a) < 1.f)) { if (hi == 0) al_l[r32] = (a); asm volatile("s_waitcnt lgkmcnt(0)" ::: "memory"); \
    _Pragma("unroll") for (int d = 0; d < 4; ++d) _Pragma("unroll") for (int r = 0; r < 16; ++r) o[d][r] *= al_l[crow(r, hi)]; } } while (0)
#define WMASK(pa, pb, t) do { if constexpr (MASKED) { if ((t) >= it.n0) wmask(pa, pb, it.kp1 + 64 * ((t) - it.n0), pos_q, hi); } } while (0)
  const int pos_q = it.qpos0 + wid * QBLK + r32;
  f32x16 pA0, pA1, pB0, pB1; float mnA, mnB, alA, alB; bf16x8 pa0, pa1, pa2, pa3; const int NT = it.NT;
  DMA(0, 0); DMA(1, 1);
  {
    const bf16_t* Qw = P + (size_t)qrow * LDP + it.qcol + hi * 8;
    bf16x8 raw[8];
#pragma unroll
    for (int d0 = 0; d0 < 8; ++d0) raw[d0] = *reinterpret_cast<const bf16x8*>(Qw + d0 * 16);
    float rs = 1.f;
    if (it.normq) { float ssq = 0.f;
#pragma unroll
      for (int d0 = 0; d0 < 8; ++d0)
#pragma unroll
        for (int j = 0; j < 8; ++j) { const float v = bf2f((unsigned short)raw[d0][j]); ssq += v * v; }
      ssq += __shfl_xor(ssq, 32);
      rs = rsqrtf(ssq * (1.f / 128.f) + EPS_); }
    const int pos = it.qpos0 + wid * QBLK + r32;
#pragma unroll
    for (int d0 = 0; d0 < 8; ++d0) {
      float v[8];
#pragma unroll
      for (int j = 0; j < 8; ++j) v[j] = bf2f((unsigned short)raw[d0][j]);
      if (it.normq) { const f32x4 w0 = *(const f32x4*)(qnw + d0 * 16 + hi * 8), w1 = *(const f32x4*)(qnw + d0 * 16 + hi * 8 + 4);
#pragma unroll
        for (int j = 0; j < 4; ++j) { v[j] *= rs * w0[j]; v[4 + j] *= rs * w1[j]; } }
      if (it.qpos0 >= 0) { const int tab = d0 < 4 ? (pos >> 6) : (pos & 63); const f32x4* tp = (const f32x4*)(rope + tab * 32 + (d0 & 3) * 8 + hi * 4);
        const f32x4 c01 = tp[0], c23 = tp[1];
        float x0, x1;
        x0 = v[0]; x1 = v[1]; v[0] = x0 * c01[0] - x1 * c01[1]; v[1] = x0 * c01[1] + x1 * c01[0];
        x0 = v[2]; x1 = v[3]; v[2] = x0 * c01[2] - x1 * c01[3]; v[3] = x0 * c01[3] + x1 * c01[2];
        x0 = v[4]; x1 = v[5]; v[4] = x0 * c23[0] - x1 * c23[1]; v[5] = x0 * c23[1] + x1 * c23[0];
        x0 = v[6]; x1 = v[7]; v[6] = x0 * c23[2] - x1 * c23[3]; v[7] = x0 * c23[3] + x1 * c23[2]; }
      u32x4 w = {cvtpk(v[0], v[1]), cvtpk(v[2], v[3]), cvtpk(v[4], v[5]), cvtpk(v[6], v[7])};
      if (d0 < NQ) qr[d0 < NQ ? d0 : 0] = *reinterpret_cast<bf16x8*>(&w); else *reinterpret_cast<u32x4*>(ql + (d0 - NQ) * 8192) = w;
    }
  }
  if constexpr (!MASKED) {
#define LANDED2(more) do { if (more) asm volatile("s_waitcnt vmcnt(4)" ::: "memory"); else asm volatile("s_waitcnt vmcnt(0)" ::: "memory"); __builtin_amdgcn_s_barrier(); asm volatile("" ::: "memory"); } while (0)
    DMA(2, 2);
    LANDED2(true);
    qkt<NQ>(pA0, pA1, K_lds, qr, ql, r32, hi); partialSM(pA0, pA1, m_reg, mnA, alA);
    for (int t = 1; t + 1 < NT; t += 2) {
      { const bool more = t + 2 < NT; if (more) DMA(t + 2, (t + 2) & 3);
        SBAR(); qkt<NQ>(pB0, pB1, K_lds + (t & 3) * SHM_K, qr, ql, r32, hi);
        finishSM(pA0, pA1, alA, l_reg, pa0, pa1, pa2, pa3); SBAR();
        pv_d0(o, vb0 + ((t - 1) & 3) * (int)SHM_V, pa0, pa1, pa2, pa3); partialSM(pB0, pB1, m_reg, mnB, alB);
        RESC(alB); LANDED2(more); }
      { const bool more = t + 3 < NT; if (more) DMA(t + 3, (t + 3) & 3);
        SBAR(); qkt<NQ>(pA0, pA1, K_lds + ((t + 1) & 3) * SHM_K, qr, ql, r32, hi);
        finishSM(pB0, pB1, alB, l_reg, pa0, pa1, pa2, pa3); SBAR();
        pv_d0(o, vb0 + (t & 3) * (int)SHM_V, pa0, pa1, pa2, pa3); partialSM(pA0, pA1, m_reg, mnA, alA);
        RESC(alA); LANDED2(more); }
    }
    SBAR(); qkt<NQ>(pB0, pB1, K_lds + ((NT - 1) & 3) * SHM_K, qr, ql, r32, hi);
    finishSM(pA0, pA1, alA, l_reg, pa0, pa1, pa2, pa3); SBAR();
    pv_d0(o, vb0 + ((NT - 2) & 3) * (int)SHM_V, pa0, pa1, pa2, pa3); partialSM(pB0, pB1, m_reg, mnB, alB);
    RESC(alB);
    finishSM(pB0, pB1, alB, l_reg, pa0, pa1, pa2, pa3); SBAR();
    pv_d0(o, vb0 + ((NT - 1) & 3) * (int)SHM_V, pa0, pa1, pa2, pa3);
#undef LANDED2
  } else {
  LANDED();
  qkt<NQ>(pA0, pA1, K_lds, qr, ql, r32, hi); WMASK(pA0, pA1, 0); partialSM(pA0, pA1, m_reg, mnA, alA);
  int b = 1, bp = 0, bn = 2;
  for (int t = 1; t + 1 < NT; t += 2) {
    DMA(t + 1, bn);
    SBAR(); qkt<NQ>(pB0, pB1, K_lds + b * SHM_K, qr, ql, r32, hi); WMASK(pB0, pB1, t);
    finishSM(pA0, pA1, alA, l_reg, pa0, pa1, pa2, pa3); SBAR();
    pv_d0(o, vb0 + bp * (int)SHM_V, pa0, pa1, pa2, pa3); partialSM(pB0, pB1, m_reg, mnB, alB);
    RESC(alB); LANDED();
    bp = b; b = bn; bn = bn == 2 ? 0 : bn + 1;
    DMA(t + 2, bn);
    SBAR(); qkt<NQ>(pA0, pA1, K_lds + b * SHM_K, qr, ql, r32, hi); WMASK(pA0, pA1, t + 1);
    finishSM(pB0, pB1, alB, l_reg, pa0, pa1, pa2, pa3); SBAR();
    pv_d0(o, vb0 + bp * (int)SHM_V, pa0, pa1, pa2, pa3); partialSM(pA0, pA1, m_reg, mnA, alA);
    RESC(alA); LANDED();
    bp = b; b = bn; bn = bn == 2 ? 0 : bn + 1;
  }
  SBAR(); qkt<NQ>(pB0, pB1, K_lds + b * SHM_K, qr, ql, r32, hi); WMASK(pB0, pB1, NT - 1);
  finishSM(pA0, pA1, alA, l_reg, pa0, pa1, pa2, pa3); SBAR();
  pv_d0(o, vb0 + bp * (int)SHM_V, pa0, pa1, pa2, pa3); partialSM(pB0, pB1, m_reg, mnB, alB);
  RESC(alB);
  finishSM(pB0, pB1, alB, l_reg, pa0, pa1, pa2, pa3); SBAR();
  pv_d0(o, vb0 + b * (int)SHM_V, pa0, pa1, pa2, pa3);
  }
  if (it.has_sink) { constexpr float C = SCALE * 1.4426950408889634f; l_reg += __builtin_amdgcn_exp2f(it.sinkv * 1.4426950408889634f - m_reg * C); }
  if (hi == 0) li_l[r32] = l_reg; asm volatile("s_waitcnt lgkmcnt(0)" ::: "memory");
  float rli[16];
#pragma unroll
  for (int r = 0; r < 16; ++r) rli[r] = __builtin_amdgcn_rcpf(li_l[crow(r, hi)]);
  bf16_t* Ow = P + (size_t)(it.qrow0 + wid * QBLK) * LDP;
  __syncthreads();
  {
    char* T = lds + wid * 12288;
#pragma unroll
    for (int r = 0; r < 16; ++r) { const int orow = crow(r, hi);
#pragma unroll
      for (int d0 = 0; d0 < 4; ++d0) *(unsigned short*)(T + orow * 272 + (d0 * 32 + r32) * 2) = f2bf(o[d0][r] * rli[r]); }
    asm volatile("s_waitcnt lgkmcnt(0)" ::: "memory");
    u32x4 gv[8];
#pragma unroll
    for (int k = 0; k < 8; ++k) { const int ci = k * 64 + lane; gv[k] = *(const u32x4*)(Ow + (size_t)(ci >> 4) * LDP + it.gcol + (ci & 15) * 8); }
#pragma unroll
    for (int k = 0; k < 8; ++k) { const int ci = k * 64 + lane; const u32x4 tv = *(const u32x4*)(T + (ci >> 4) * 272 + (ci & 15) * 16); const u32x4 g = gv[k];
      u32x4 w;
      w.x = cvtpk(bflo(tv.x) * silu_f(bflo(g.x)), bfhi(tv.x) * silu_f(bfhi(g.x))); w.y = cvtpk(bflo(tv.y) * silu_f(bflo(g.y)), bfhi(tv.y) * silu_f(bfhi(g.y)));
      w.z = cvtpk(bflo(tv.z) * silu_f(bflo(g.z)), bfhi(tv.z) * silu_f(bfhi(g.z))); w.w = cvtpk(bflo(tv.w) * silu_f(bflo(g.w)), bfhi(tv.w) * silu_f(bfhi(g.w)));
      if (!dry) *(u32x4*)(Ow + (size_t)(ci >> 4) * LDP + it.qcol + (ci & 15) * 8) = w; }
  }
  __syncthreads();
#undef TROW
#undef DMA
#undef LANDED
#undef RESC
#undef WMASK
}
}

struct Ctx {
    int tid, lane, wave, gw, ngw;
    char* lds;
};
#define LDS_WAIT() asm volatile("s_waitcnt lgkmcnt(0)" ::: "memory")

__device__ __forceinline__ void transpose_item(const float* __restrict__ W, int K, int Ntot, int src0, bf16_t* __restrict__ WT, int dst0, int ncols, float* scr, int item, int lane) {
    const int nblk = ncols / 32, kb = item / nblk, nb = item % nblk, k0 = 64 * kb, n0 = 32 * nb;
#pragma unroll 8
    for (int i = 0; i < 32; ++i) { const int kk = 2 * i + (lane >> 5); scr[kk * 33 + (lane & 31)] = __builtin_nontemporal_load(W + (size_t)(k0 + kk) * Ntot + src0 + n0 + (lane & 31)); }
    LDS_WAIT(); asm volatile("" ::: "memory");
    const int c = lane & 7;
#pragma unroll
    for (int j = 0; j < 4; ++j) { const int n = (lane >> 3) + 8 * j; const float* s = scr + (8 * c) * 33 + n;
        u32x4 o; o.x = cvtpk(s[0 * 33], s[1 * 33]); o.y = cvtpk(s[2 * 33], s[3 * 33]); o.z = cvtpk(s[4 * 33], s[5 * 33]); o.w = cvtpk(s[6 * 33], s[7 * 33]);
        *(u32x4*)(WT + (size_t)(dst0 + n0 + n) * K + k0 + 8 * c) = o; }
    LDS_WAIT(); asm volatile("" ::: "memory");
}
__device__ __forceinline__ void convert_weights(const Ctx& c, int l, const float* attn_w_in, const float* attn_w_out, const float* ssm_w_in, const float* ssm_w_out, bf16_t* W1, bf16_t* W2) {
    float* scr = (float*)(c.lds + c.wave * 16384);
    const int i = l >> 1;
    if ((l & 1) == 0) {
        const float* Wi = attn_w_in + (size_t)i * DM * AIN; const float* Wo = attn_w_out + (size_t)i * AW * DM;
        constexpr int I_IN = (DM / 64) * (AIN / 32), I_OUT = (AW / 64) * (DM / 32);
        for (int it = c.gw; it < I_IN + I_OUT; it += c.ngw) {
            if (it < I_IN) {
                const int kb = it / (AIN / 32), nbg = it % (AIN / 32), scol = nbg * 32;
                int src0, ncols, dst0;
                if (scol < 1024) { src0 = 0; ncols = 1024; dst0 = PC_QA; }
                else if (scol < 1280) { src0 = 1024; ncols = 256; dst0 = PC_KA; }
                else if (scol < 1536) { src0 = 1280; ncols = 256; dst0 = PC_VA; }
                else if (scol < 2560) { src0 = 1536; ncols = 1024; dst0 = PC_GA; }
                else if (scol < 3584) { src0 = 2560; ncols = 1024; dst0 = PC_QB; }
                else if (scol < 3840) { src0 = 3584; ncols = 256; dst0 = PC_KB; }
                else if (scol < 4096) { src0 = 3840; ncols = 256; dst0 = PC_VB; }
                else { src0 = 4096; ncols = 1024; dst0 = PC_GB; }
                const int nb = (scol - src0) / 32;
                transpose_item(Wi, DM, AIN, src0, W1, dst0, ncols, scr, kb * (ncols / 32) + nb, c.lane);
            } else transpose_item(Wo, AW, DM, 0, W2, 0, DM, scr, it - I_IN, c.lane);
        }
    } else {
        constexpr int SIN = 6208;
        const float* Wi = ssm_w_in + (size_t)i * DM * SIN; const float* Wo = ssm_w_out + (size_t)i * DI * DM;
        constexpr int I_IN = (DM / 64) * (SIN / 32), I_OUT = (DI / 64) * (DM / 32);
        for (int it = c.gw; it < I_IN + I_OUT; it += c.ngw) {
            if (it < I_IN) {
                const int kb = it / (SIN / 32), nbg = it % (SIN / 32), scol = nbg * 32;
                int src0, ncols, dst0;
                if (scol < 2048) { src0 = 0; ncols = 2048; dst0 = NXB; }
                else if (scol < 6144) { src0 = 2048; ncols = 4096; dst0 = 0; }
                else { src0 = 6144; ncols = 64; dst0 = 4096; }
                const int nb = (scol - src0) / 32;
                transpose_item(Wi, DM, SIN, src0, W1, dst0, ncols, scr, kb * (ncols / 32) + nb, c.lane);
            } else transpose_item(Wo, DI, DM, 0, W2, 0, DM, scr, it - I_IN, c.lane);
        }
    }
}

__device__ __forceinline__ void adaln_phase(const Ctx& c, const float* cvec, const float* cctx, const float* w_ada, const float* b_ada, float* MOD) {
    float* sv = (float*)c.lds;
    float* red = (float*)(c.lds + 5 * 1024 * 4);
    bool have = false;
    for (int it = blockIdx.x; it < DEPTH_ * 48; it += gridDim.x) {
        if (!have) { for (int e = c.tid; e < 5 * 1024; e += 512) { const float v = e < 4096 ? cvec[e] : cctx[e - 4096]; sv[e] = silu_f(v); } have = true; __syncthreads(); }
        const int l = it / 48, col = (it % 48) * 64 + c.lane;
        const float* wp = w_ada + ((size_t)l * DM + c.wave * 128) * 3072 + col;
        float a0 = 0, a1 = 0, a2 = 0, a3 = 0, a4 = 0;
#pragma unroll 8
        for (int k = 0; k < 128; ++k) { const float w = __builtin_nontemporal_load(wp + (size_t)k * 3072); const int kk = c.wave * 128 + k;
            a0 += sv[kk] * w; a1 += sv[1024 + kk] * w; a2 += sv[2048 + kk] * w; a3 += sv[3072 + kk] * w; a4 += sv[4096 + kk] * w; }
        float* rp = red + (c.wave * 5) * 64 + c.lane;
        rp[0] = a0; rp[64] = a1; rp[128] = a2; rp[192] = a3; rp[256] = a4;
        __syncthreads();
        if (c.tid < 320) { const int who = c.tid >> 6, ln = c.tid & 63; float s = b_ada[(size_t)l * 3072 + (it % 48) * 64 + ln];
#pragma unroll
            for (int w = 0; w < 8; ++w) s += red[(w * 5 + who) * 64 + ln];
            MOD[((size_t)l * 5 + who) * 3072 + (it % 48) * 64 + ln] = s; }
        __syncthreads();
    }
}
__device__ __forceinline__ void rope_phase(const Ctx& c, f32x2* rope) {
    for (int e = blockIdx.x * 512 + c.tid; e < 128 * 32; e += gridDim.x * 512) { const int pos = e >> 5, f = e & 31;
        const float inv = 1.0f / powf(10000.0f, (float)f / 32.0f); const float ang = (float)pos * inv;
        rope[e] = (f32x2){cosf(ang), sinf(ang)}; }
}

__device__ __forceinline__ void norm_pass(const Ctx& c, int l, const float* xin, float* xout, const float* cin, float* cout, bf16_t* HY, const float* MOD, const float* norm_pre, const float* norm_post, bool do_ctx, const bool dry) {
    const bool have_y = l >= 0, have_h = l + 1 < DEPTH_;
    const int nchunks = MLAT / 16 + (do_ctx ? MCTX : 0);
    for (int ch = c.gw; ch < nchunks; ch += c.ngw) {
        const bool isctx = ch >= MLAT / 16; const int row0 = isctx ? (ch - MLAT / 16) : ch * 16; const int who = isctx ? 4 : (row0 / T_); const int nrow = isctx ? 1 : 16;
        const float* xi = isctx ? cin : xin; float* xo = isctx ? cout : xout; const int hrow0 = isctx ? MLAT + row0 : row0;
        f32x4 A1[4], A2[4], A3[4];
#pragma unroll
        for (int j = 0; j < 4; ++j) { const int col = 4 * c.lane + 256 * j;
            if (have_y) { const f32x4 gt = *(const f32x4*)(MOD + ((size_t)l * 5 + who) * 3072 + 2048 + col); const f32x4 pw = *(const f32x4*)(norm_post + (size_t)l * DM + col); A1[j] = gt * pw; }
            if (have_h) { const f32x4 sh = *(const f32x4*)(MOD + ((size_t)(l + 1) * 5 + who) * 3072 + col), sc = *(const f32x4*)(MOD + ((size_t)(l + 1) * 5 + who) * 3072 + 1024 + col);
                const f32x4 pw = *(const f32x4*)(norm_pre + (size_t)(l + 1) * DM + col); A2[j] = pw * (sc + 1.0f); A3[j] = sh; } }
        f32x4 nx[4]; u32x2 ny[4];
#pragma unroll
        for (int j = 0; j < 4; ++j) { nx[j] = __builtin_nontemporal_load((const f32x4*)(xi + (size_t)row0 * DM + 4 * c.lane + 256 * j)); if (have_y) ny[j] = __builtin_nontemporal_load((const u32x2*)(HY + (size_t)hrow0 * DM + 4 * c.lane + 256 * j)); }
        for (int r = 0; r < nrow; ++r) {
            const size_t xoff = (size_t)(row0 + r) * DM, hoff = (size_t)(hrow0 + r) * DM;
            f32x4 x[4]; u32x2 yw[4];
#pragma unroll
            for (int j = 0; j < 4; ++j) { x[j] = nx[j]; yw[j] = ny[j]; }
            if (r + 1 < nrow) {
#pragma unroll
                for (int j = 0; j < 4; ++j) { nx[j] = __builtin_nontemporal_load((const f32x4*)(xi + xoff + DM + 4 * c.lane + 256 * j)); if (have_y) ny[j] = __builtin_nontemporal_load((const u32x2*)(HY + hoff + DM + 4 * c.lane + 256 * j)); } }
            if (have_y) {
                f32x4 y[4]; float ssq = 0.f;
#pragma unroll
                for (int j = 0; j < 4; ++j) { const u32x2 w = yw[j]; y[j] = (f32x4){bflo(w.x), bfhi(w.x), bflo(w.y), bfhi(w.y)};
                    ssq += (y[j][0] * y[j][0] + y[j][1] * y[j][1]) + (y[j][2] * y[j][2] + y[j][3] * y[j][3]); }
                const float rs = rsqrtf(wave_sum(ssq) * (1.f / DM) + EPS_);
#pragma unroll
                for (int j = 0; j < 4; ++j) { x[j] = x[j] + A1[j] * (y[j] * rs); if (!dry) __builtin_nontemporal_store(x[j], (f32x4*)(xo + xoff + 4 * c.lane + 256 * j)); }
            }
            if (have_h) {
                float ssq = 0.f;
#pragma unroll
                for (int j = 0; j < 4; ++j) ssq += (x[j][0] * x[j][0] + x[j][1] * x[j][1]) + (x[j][2] * x[j][2] + x[j][3] * x[j][3]);
                const float rs = rsqrtf(wave_sum(ssq) * (1.f / DM) + EPS_);
#pragma unroll
                for (int j = 0; j < 4; ++j) { const f32x4 h = x[j] * rs * A2[j] + A3[j]; u32x2 w; w.x = cvtpk(h[0], h[1]); w.y = cvtpk(h[2], h[3]); if (!dry) *(u32x2*)(HY + hoff + 4 * c.lane + 256 * j) = w; }
            }
        }
    }
}

__device__ __forceinline__ void kprep_pass(const Ctx& c, bf16_t* P, const float* knw, const f32x2* rope, const bool dry) {
    const int hsel = c.lane >> 4, e0 = (c.lane & 15) * 8;
    const int col = (hsel < 2 ? PC_KA + hsel * 128 : PC_KB + (hsel - 2) * 128) + e0;
    const f32x4 w0 = *(const f32x4*)(knw + e0), w1 = *(const f32x4*)(knw + e0 + 4);
    for (int row0 = c.gw; row0 < MTOT; row0 += 2 * c.ngw) {
        const int row1 = row0 + c.ngw; const bool two = row1 < MTOT;
        const u32x4 rawA = *(const u32x4*)(P + (size_t)row0 * AIN + col);
        const u32x4 rawB = two ? *(const u32x4*)(P + (size_t)row1 * AIN + col) : (u32x4){0u, 0u, 0u, 0u};
#pragma unroll
        for (int half = 0; half < 2; ++half) {
        if (half == 1 && !two) break;
        const int row = half ? row1 : row0; const u32x4 raw = half ? rawB : rawA;
        bf16_t* p = P + (size_t)row * AIN + col;
        float v[8] = {bflo(raw.x), bfhi(raw.x), bflo(raw.y), bfhi(raw.y), bflo(raw.z), bfhi(raw.z), bflo(raw.w), bfhi(raw.w)};
        if (hsel >= 2) { float ssq = 0.f;
#pragma unroll
            for (int j = 0; j < 8; ++j) ssq += v[j] * v[j];
            ssq += __shfl_xor(ssq, 1); ssq += __shfl_xor(ssq, 2); ssq += __shfl_xor(ssq, 4); ssq += __shfl_xor(ssq, 8);
            const float rs = rsqrtf(ssq * (1.f / 128.f) + EPS_);
#pragma unroll
            for (int j = 0; j < 4; ++j) { v[j] *= rs * w0[j]; v[4 + j] *= rs * w1[j]; } }
        if (row < MLAT) { const int pos = row & (T_ - 1), i0 = e0 >> 1; const int tab = i0 < 32 ? (pos >> 6) : (pos & 63);
            const f32x4* tp = (const f32x4*)(rope + tab * 32 + (i0 & 31)); const f32x4 c01 = tp[0], c23 = tp[1];
            float x0, x1;
            x0 = v[0]; x1 = v[1]; v[0] = x0 * c01[0] - x1 * c01[1]; v[1] = x0 * c01[1] + x1 * c01[0];
            x0 = v[2]; x1 = v[3]; v[2] = x0 * c01[2] - x1 * c01[3]; v[3] = x0 * c01[3] + x1 * c01[2];
            x0 = v[4]; x1 = v[5]; v[4] = x0 * c23[0] - x1 * c23[1]; v[5] = x0 * c23[1] + x1 * c23[0];
            x0 = v[6]; x1 = v[7]; v[6] = x0 * c23[2] - x1 * c23[3]; v[7] = x0 * c23[3] + x1 * c23[2]; }
        if (!dry && (hsel >= 2 || row < MLAT)) { u32x4 w = {cvtpk(v[0], v[1]), cvtpk(v[2], v[3]), cvtpk(v[4], v[5]), cvtpk(v[6], v[7])}; *(u32x4*)p = w; }
        }
    }
}

__device__ __forceinline__ void conv_pass(const Ctx& c, bf16_t* X, const bf16_t* halo, const float* cw, const float* cb, const bool dry) {
    for (int u = blockIdx.x; u < (MTOT / 128) * 4; u += gridDim.x) {
        const int ck = u >> 2, q = u & 3, strip = c.tid & 127, rg = c.tid >> 7, col = q * 1024 + strip * 8, row0 = ck * 128 + rg * 32;
        const bool seq_start = ck < 256 ? (ck & 63) == 0 : ((ck - 256) & 1) == 0, seq_end = ck < 256 ? (ck & 63) == 63 : ((ck - 256) & 1) == 1;
        float w0[8], w1[8], w2[8], bs[8];
#pragma unroll
        for (int j = 0; j < 8; ++j) { w0[j] = cw[col + j]; w1[j] = cw[CONVD + col + j]; w2[j] = cw[2 * CONVD + col + j]; bs[j] = cb[col + j]; }
        u32x4 prev = {0u, 0u, 0u, 0u}, last = {0u, 0u, 0u, 0u};
        if (rg == 0) { if (!seq_start) prev = *(const u32x4*)(halo + ((size_t)(ck - 1) * 2 + 1) * CONVD + col); } else prev = *(const u32x4*)(X + (size_t)(row0 - 1) * CONVD + col);
        if (rg == 3) { if (!seq_end) last = *(const u32x4*)(halo + ((size_t)(ck + 1) * 2 + 0) * CONVD + col); } else last = *(const u32x4*)(X + (size_t)(row0 + 32) * CONVD + col);
        u32x4 cur = *(const u32x4*)(X + (size_t)row0 * CONVD + col);
        asm volatile("s_waitcnt vmcnt(0)" ::: "memory");
        __syncthreads();
        for (int ib = 0; ib < 4; ++ib) {
            u32x4 nx[8];
#pragma unroll
            for (int i = 0; i < 8; ++i) { const int r = ib * 8 + i + 1; nx[i] = (r < 32) ? *(const u32x4*)(X + (size_t)(row0 + r) * CONVD + col) : last; }
#pragma unroll
            for (int i = 0; i < 8; ++i) {
                const u32x4 n = nx[i];
                const float pv[8] = {bflo(prev.x), bfhi(prev.x), bflo(prev.y), bfhi(prev.y), bflo(prev.z), bfhi(prev.z), bflo(prev.w), bfhi(prev.w)};
                const float cv[8] = {bflo(cur.x), bfhi(cur.x), bflo(cur.y), bfhi(cur.y), bflo(cur.z), bfhi(cur.z), bflo(cur.w), bfhi(cur.w)};
                const float nv[8] = {bflo(n.x), bfhi(n.x), bflo(n.y), bfhi(n.y), bflo(n.z), bfhi(n.z), bflo(n.w), bfhi(n.w)};
                float o[8];
#pragma unroll
                for (int j = 0; j < 8; ++j) o[j] = silu_f(bs[j] + w0[j] * pv[j] + w1[j] * cv[j] + w2[j] * nv[j]);
                u32x4 w = {cvtpk(o[0], o[1]), cvtpk(o[2], o[3]), cvtpk(o[4], o[5]), cvtpk(o[6], o[7])};
                if (!dry) *(u32x4*)(X + (size_t)(row0 + ib * 8 + i) * CONVD + col) = w;
                prev = cur; cur = n;
            }
        }
        asm volatile("s_waitcnt vmcnt(0)" ::: "memory");
        __syncthreads();
    }
}

__device__ __forceinline__ void gnorm_pass(const Ctx& c, bf16_t* Y, const bf16_t* Z, const float* nw, const int nrows, const bool dry) {
    f32x4 w[8];
#pragma unroll
    for (int j = 0; j < 8; ++j) w[j] = *(const f32x4*)(nw + 256 * j + 4 * c.lane);
    for (int row = c.gw; row < nrows; row += c.ngw) {
        const size_t off = (size_t)row * DI + 4 * c.lane;
        u32x2 yv[8], zv[8];
#pragma unroll
        for (int j = 0; j < 8; ++j) { yv[j] = *(const u32x2*)(Y + off + 256 * j); zv[j] = *(const u32x2*)(Z + off + 256 * j); }
#pragma unroll
        for (int j = 0; j < 8; ++j) {
            f32x4 g = {bflo(yv[j].x) * silu_f(bflo(zv[j].x)), bfhi(yv[j].x) * silu_f(bfhi(zv[j].x)), bflo(yv[j].y) * silu_f(bflo(zv[j].y)), bfhi(yv[j].y) * silu_f(bfhi(zv[j].y))};
            const float ssq = wave_sum((g[0] * g[0] + g[1] * g[1]) + (g[2] * g[2] + g[3] * g[3]));
            const float rs = rsqrtf(ssq * (1.f / 256.f) + EPS_);
            g = g * rs * w[j];
            u32x2 o; o.x = cvtpk(g[0], g[1]); o.y = cvtpk(g[2], g[3]); if (!dry) *(u32x2*)(Y + off + 256 * j) = o;
        }
    }
}

namespace ssd {
constexpr int RS = 272;
constexpr int O_CN = 0, O_BN = 34816, O_GP = 69632, O_XDT = 104448, O_XW = 112640, O_XN = 120832, O_HS = 129024, O_CUM = 137728, LDS_SSD = O_CUM + 1024;
#define MF32(a, b, c) __builtin_amdgcn_mfma_f32_32x32x16_bf16(a, b, c, 0, 0, 0)
#define PK8(L, H) (bf16x8){L[0], L[1], L[2], L[3], H[0], H[1], H[2], H[3]}
__device__ __forceinline__ u32x2 pack4(float a, float b, float c, float d) { u32x2 w; w.x = cvtpk(a, b); w.y = cvtpk(c, d); return w; }


#define RDL(x, n) __uint_as_float((unsigned)__builtin_amdgcn_readlane((int)__float_as_uint(x), (n)))
__device__ __forceinline__ float wave_scan_incl(float v, int lane) {
#define DPP_SHR(x, n) __uint_as_float((unsigned)__builtin_amdgcn_update_dpp(0, (int)__float_as_uint(x), 0x110 + (n), 0xf, 0xf, true))
    v += DPP_SHR(v, 1); v += DPP_SHR(v, 2); v += DPP_SHR(v, 4); v += DPP_SHR(v, 8);
#undef DPP_SHR
    const float t0 = RDL(v, 15), t1 = RDL(v, 31), t2 = RDL(v, 47);
    const int row = lane >> 4;
    v += row == 1 ? t0 : row == 2 ? t0 + t1 : row == 3 ? (t0 + t1) + t2 : 0.f;
    return v;
}
template <int KK0> __device__ __forceinline__ void state_steps(f32x16& S, int base_b, int base_w) {
    using att::tr_read;
    const s16x4 a0l = tr_read<(KK0 + 0) * 16 * RS>(base_b), a0h = tr_read<(KK0 + 0) * 16 * RS + 4 * RS>(base_b), a1l = tr_read<(KK0 + 1) * 16 * RS>(base_b), a1h = tr_read<(KK0 + 1) * 16 * RS + 4 * RS>(base_b);
    const s16x4 a2l = tr_read<(KK0 + 2) * 16 * RS>(base_b), a2h = tr_read<(KK0 + 2) * 16 * RS + 4 * RS>(base_b), a3l = tr_read<(KK0 + 3) * 16 * RS>(base_b), a3h = tr_read<(KK0 + 3) * 16 * RS + 4 * RS>(base_b);
    const s16x4 b0l = tr_read<(KK0 + 0) * 1024>(base_w), b0h = tr_read<(KK0 + 0) * 1024 + 256>(base_w), b1l = tr_read<(KK0 + 1) * 1024>(base_w), b1h = tr_read<(KK0 + 1) * 1024 + 256>(base_w);
    const s16x4 b2l = tr_read<(KK0 + 2) * 1024>(base_w), b2h = tr_read<(KK0 + 2) * 1024 + 256>(base_w), b3l = tr_read<(KK0 + 3) * 1024>(base_w), b3h = tr_read<(KK0 + 3) * 1024 + 256>(base_w);
    asm volatile("s_waitcnt lgkmcnt(0)" ::: "memory"); SBAR();
    S = MF32(PK8(a0l, a0h), PK8(b0l, b0h), S); S = MF32(PK8(a1l, a1h), PK8(b1l, b1h), S);
    S = MF32(PK8(a2l, a2h), PK8(b2l, b2h), S); S = MF32(PK8(a3l, a3h), PK8(b3l, b3h), S);
}
template <int KK0> __device__ __forceinline__ void ydiag_steps(f32x16& acc, int base_x, const char* gp_row) {
    using att::tr_read;
    const s16x4 a0l = tr_read<(KK0 + 0) * 1024>(base_x), a0h = tr_read<(KK0 + 0) * 1024 + 256>(base_x), a1l = tr_read<(KK0 + 1) * 1024>(base_x), a1h = tr_read<(KK0 + 1) * 1024 + 256>(base_x);
    const s16x4 a2l = tr_read<(KK0 + 2) * 1024>(base_x), a2h = tr_read<(KK0 + 2) * 1024 + 256>(base_x), a3l = tr_read<(KK0 + 3) * 1024>(base_x), a3h = tr_read<(KK0 + 3) * 1024 + 256>(base_x);
    asm volatile("s_waitcnt lgkmcnt(0)" ::: "memory"); SBAR();
    const bf16x8 b0 = *(const bf16x8*)(gp_row + (KK0 + 0) * 32), b1 = *(const bf16x8*)(gp_row + (KK0 + 1) * 32), b2 = *(const bf16x8*)(gp_row + (KK0 + 2) * 32), b3 = *(const bf16x8*)(gp_row + (KK0 + 3) * 32);
    acc = MF32(PK8(a0l, a0h), b0, acc); acc = MF32(PK8(a1l, a1h), b1, acc); acc = MF32(PK8(a2l, a2h), b2, acc); acc = MF32(PK8(a3l, a3h), b3, acc);
}

__device__ __forceinline__ void scan_phase(const Ctx& c, const int dir, const bf16_t* __restrict__ X, const float* __restrict__ DT, bf16_t* __restrict__ Y, const float* __restrict__ a_log, const float* __restrict__ dskip, const bool dry, const int pvar) {
    char* L = c.lds; float* cumL = (float*)(L + O_CUM);
    const int tid = c.tid, lane = c.lane, wave = c.wave, r32 = lane & 31, hi = lane >> 5;
    const int blk = (lane >> 4) & 1, qq = (lane & 15) >> 2, pp = lane & 3;
    for (int item = blockIdx.x; item < 256; item += gridDim.x) {
        const int xcd_ = item & 7, slot_ = item >> 3, grp_ = xcd_ + 8 * (slot_ >> 3), mem_ = slot_ & 7;
        const int ph = mem_ & 1, b = grp_ >> 3, g = grp_ & 7, h = 4 * g + (mem_ >> 1);
        const float Acoef = -__expf(a_log[dir * 32 + h]), Dh = dskip[h];
        const int xcol = h * 64 + ph * 32, bcol = 2048 + g * 128, ccol = 3072 + g * 128, dtcol = dir * 32 + h;
        f32x16 S = {};
        bf16x8 rc[4], rb[4], rx; float d0r, d1r;
#define CHUNK_ROW(q) ((q) < 2 ? MLAT + b * CL + (dir == 0 ? (q) : 1 - (q)) * 128 : b * T_ + (dir == 0 ? (q) - 2 : 65 - (q)) * 128)
#define LOADCHUNK(q) do { const int R_ = CHUNK_ROW(q);                                                                         \
        _Pragma("unroll") for (int i = 0; i < 4; ++i) { const size_t ro = (size_t)(R_ + (tid >> 4) + 32 * i) * CONVD + (tid & 15) * 8;     \
            rc[i] = *(const bf16x8*)(X + ro + ccol); rb[i] = *(const bf16x8*)(X + ro + bcol); }                                \
        rx = *(const bf16x8*)(X + (size_t)(R_ + (tid >> 2)) * CONVD + xcol + (tid & 3) * 8);                                    \
        d0r = DT[(size_t)dtcol * MTOT + R_ + lane]; d1r = DT[(size_t)dtcol * MTOT + R_ + 64 + lane]; } while (0)
        LOADCHUNK(0);
        for (int q = 0; q < 66; ++q) {
            const int R0 = CHUNK_ROW(q);
            const float a0 = d0r * Acoef, a1 = d1r * Acoef;
            float p0 = wave_scan_incl(a0, lane), p1 = wave_scan_incl(a1, lane);
            p1 += RDL(p0, 63);
            const float tot = RDL(p1, 63);
            float c0, c1;
            if (dir == 0) { c0 = p0; c1 = p1; } else { c0 = tot - p0 + a0; c1 = tot - p1 + a1; }
            if (wave == 0) { cumL[lane] = c0; cumL[64 + lane] = c1; }
#pragma unroll
            for (int i = 0; i < 4; ++i) { const int off = ((tid >> 4) + 32 * i) * RS + (tid & 15) * 16;
                *(bf16x8*)(L + O_CN + off) = rc[i]; *(bf16x8*)(L + O_BN + off) = rb[i]; }
            {
                const int sl = (tid >> 2) & 63;
                const float dts = __shfl(wave < 4 ? d0r : d1r, sl), cums = __shfl(wave < 4 ? c0 : c1, sl);
                const float wend = dts * __expf(tot - cums);
                float xv[8];
#pragma unroll
                for (int j = 0; j < 8; ++j) xv[j] = bf2f((unsigned short)rx[j]);
                const int xo = (tid >> 2) * 64 + (tid & 3) * 16;
                *(bf16x8*)(L + O_XN + xo) = rx;
                u32x4 w1 = {cvtpk(xv[0] * dts, xv[1] * dts), cvtpk(xv[2] * dts, xv[3] * dts), cvtpk(xv[4] * dts, xv[5] * dts), cvtpk(xv[6] * dts, xv[7] * dts)};
                u32x4 w2 = {cvtpk(xv[0] * wend, xv[1] * wend), cvtpk(xv[2] * wend, xv[3] * wend), cvtpk(xv[4] * wend, xv[5] * wend), cvtpk(xv[6] * wend, xv[7] * wend)};
                *(u32x4*)(L + O_XDT + xo) = w1; *(u32x4*)(L + O_XW + xo) = w2;
            }
            if (q + 1 < 66) LOADCHUNK(q + 1);
            __syncthreads();
            if (!(dry && pvar == 1)) {
            if (wave >= 4) { const int nb = (wave - 4) * 32;
#pragma unroll
                for (int qd = 0; qd < 4; ++qd) *(u32x2*)(L + O_HS + r32 * RS + (nb + 8 * qd + 4 * hi) * 2) = pack4(S[4 * qd], S[4 * qd + 1], S[4 * qd + 2], S[4 * qd + 3]); }
            {
                const int sb = wave >> 1, lb0 = 2 * (wave & 1);
                const char* ap = L + O_BN + (sb * 32 + r32) * RS + hi * 16; const char* bp0 = L + O_CN + (lb0 * 32 + r32) * RS + hi * 16; const char* bp1 = bp0 + 32 * RS;
                bf16x8 fa[8], fb0[8], fb1[8];
#pragma unroll
                for (int kk = 0; kk < 8; ++kk) { fa[kk] = *(const bf16x8*)(ap + kk * 32); fb0[kk] = *(const bf16x8*)(bp0 + kk * 32); fb1[kk] = *(const bf16x8*)(bp1 + kk * 32); }
                f32x16 acc0 = {}, acc1 = {};
#pragma unroll
                for (int kk = 0; kk < 8; ++kk) { acc0 = MF32(fa[kk], fb0[kk], acc0); acc1 = MF32(fa[kk], fb1[kk], acc1); }
#pragma unroll
                for (int tt = 0; tt < 2; ++tt) {
                    const int lb = lb0 + tt, l = lb * 32 + r32; const float cl = cumL[l];
#pragma unroll
                    for (int qd = 0; qd < 4; ++qd) { float v[4];
#pragma unroll
                        for (int e = 0; e < 4; ++e) { const int s_ = sb * 32 + 8 * qd + 4 * hi + e; const float cs = cumL[s_];
                            const float av = tt == 0 ? acc0[4 * qd + e] : acc1[4 * qd + e];
                            const bool valid = dir == 0 ? (s_ <= l) : (s_ >= l); v[e] = valid ? av * __expf(cl - cs) : 0.f; }
                        *(u32x2*)(L + O_GP + l * RS + (sb * 32 + 8 * qd + 4 * hi) * 2) = pack4(v[0], v[1], v[2], v[3]); }
                }
            }
            }
            __syncthreads();
            if (dry && pvar >= 1) { } else
            if (wave < 4) {
                const int l = wave * 32 + r32;
                f32x16 aoff = {}, adg = {};
                bf16_t* yp = Y + (size_t)(R0 + l) * DI + xcol;
                u32x2 pvv[4] = {};
                if (dir == 0) {
#pragma unroll
                    for (int qd = 0; qd < 4; ++qd) pvv[qd] = *(const u32x2*)(yp + 8 * qd + 4 * hi); }
                const char* hp = L + O_HS + r32 * RS + hi * 16; const char* cp = L + O_CN + l * RS + hi * 16;
                {
                    bf16x8 fh[8], fc[8];
#pragma unroll
                    for (int kk = 0; kk < 8; ++kk) { fh[kk] = *(const bf16x8*)(hp + kk * 32); fc[kk] = *(const bf16x8*)(cp + kk * 32); }
#pragma unroll
                    for (int kk = 0; kk < 8; ++kk) aoff = MF32(fh[kk], fc[kk], aoff);
                }
                const int base_x = (int)(uintptr_t)(L + O_XDT) + (8 * hi + qq) * 64 + (16 * blk + 4 * pp) * 2;
                const char* gp_row = L + O_GP + l * RS + hi * 16;
                ydiag_steps<0>(adg, base_x, gp_row); ydiag_steps<4>(adg, base_x, gp_row);
                const float ec = __expf(cumL[l]);
#pragma unroll
                for (int qd = 0; qd < 4; ++qd) { const int pc = 8 * qd + 4 * hi; float v[4];
#pragma unroll
                    for (int e = 0; e < 4; ++e) v[e] = aoff[4 * qd + e] * ec + adg[4 * qd + e];
                    if (dir == 0) { const u32x2 xn = *(const u32x2*)(L + O_XN + l * 64 + pc * 2); const u32x2 pv = pvv[qd];
                        v[0] += Dh * bflo(xn.x) + bflo(pv.x); v[1] += Dh * bfhi(xn.x) + bfhi(pv.x); v[2] += Dh * bflo(xn.y) + bflo(pv.y); v[3] += Dh * bfhi(xn.y) + bfhi(pv.y); }
                    if (!dry) *(u32x2*)(yp + pc) = pack4(v[0], v[1], v[2], v[3]); }
            } else {
                const int nb = (wave - 4) * 32; const float dec = __expf(tot);
#pragma unroll
                for (int r = 0; r < 16; ++r) S[r] *= dec;
                const int base_b = (int)(uintptr_t)(L + O_BN) + (8 * hi + qq) * RS + (nb + 16 * blk + 4 * pp) * 2;
                const int base_w = (int)(uintptr_t)(L + O_XW) + (8 * hi + qq) * 64 + (16 * blk + 4 * pp) * 2;
                state_steps<0>(S, base_b, base_w); state_steps<4>(S, base_b, base_w);
            }
            __syncthreads();
        }
#undef CHUNK_ROW
#undef LOADCHUNK
    }
}
}

constexpr int LDS_BYTES = 163840;
#ifndef PROBE_OP
#define PROBE_OP -1
#endif
struct Args { const float* in[21]; float* out; unsigned char* ws; long probe; };

enum Op { OP_GEMM_BF16 = 0, OP_GEMM_XBC, OP_GEMM_IN, OP_ATTN, OP_CONV, OP_SCAN, OP_GEMM_Z, OP_NORM, OP_PROLOGUE };

__device__ __forceinline__ void attn_phase(const Ctx& c, int li, bf16_t* P, const float* sink, const float* qnw, const f32x2* rope, const bool dry, const int pvar) {
    for (int i = blockIdx.x; i < 2112; i += gridDim.x) {
        att::Item it;
        if (i < 2048) {
            const int ii = i & 1023, x = ii & 7, wi = (ii >> 3) & 31, k = ii >> 8, b = x >> 1, kvh = x & 1, head = kvh * 4 + k, i0 = wi * 256;
            const bool mixB = i < 1024;
            it.qrow0 = b * T_ + i0; it.qpos0 = i0;
            if (mixB) { it.qcol = PC_QB + head * 128; it.gcol = PC_GB + head * 128; it.kcol = PC_KB + kvh * 128; it.vcol = PC_VB + kvh * 128;
                it.n0 = T_ / 64; it.r0 = b * T_; it.r1 = MLAT + b * CL; it.NT = T_ / 64 + CL / 64; it.kp1 = 0; it.masked = 0; it.normq = 1; it.has_sink = 0; it.sinkv = 0.f; }
            else { const int ks = i0 >= 128 ? i0 - 128 : 0, ke = i0 + 384 <= T_ ? i0 + 384 : T_;
                it.qcol = PC_QA + head * 128; it.gcol = PC_GA + head * 128; it.kcol = PC_KA + kvh * 128; it.vcol = PC_VA + kvh * 128;
                it.n0 = CL / 64; it.r0 = MLAT + b * CL; it.r1 = b * T_ + ks; it.NT = CL / 64 + (ke - ks) / 64; it.kp1 = ks; it.masked = 1; it.normq = 0; it.has_sink = 1; it.sinkv = sink[head]; }
        } else {
            const int j = i - 2048, head = j & 7, mixB = (j >> 3) & 1, b = j >> 4, kvh = head >> 2;
            it.qrow0 = MLAT + b * CL; it.qpos0 = -1; it.n0 = CL / 64; it.r0 = MLAT + b * CL; it.r1 = 0; it.NT = CL / 64; it.kp1 = 0; it.masked = 0;
            if (mixB) { it.qcol = PC_QB + head * 128; it.gcol = PC_GB + head * 128; it.kcol = PC_KB + kvh * 128; it.vcol = PC_VB + kvh * 128; it.normq = 1; it.has_sink = 0; it.sinkv = 0.f; }
            else { it.qcol = PC_QA + head * 128; it.gcol = PC_GA + head * 128; it.kcol = PC_KA + kvh * 128; it.vcol = PC_VA + kvh * 128; it.normq = 0; it.has_sink = 1; it.sinkv = sink[head]; }
        }
        if (it.masked) att::attn_item<true>(P, it, qnw, rope, c.lds, c.tid, dry); else att::attn_item<false>(P, it, qnw, rope, c.lds, c.tid, dry);
    }
}

__global__ void __launch_bounds__(512) mega(Args a) {
    extern __shared__ __attribute__((aligned(16))) unsigned char lds_[];
    cg::grid_group grid = cg::this_grid();
    volatile XLAS unsigned* bst = (volatile XLAS unsigned*)((XLAS unsigned char*)lds_ + (LDS_BYTES - 16));
    if (threadIdx.x < 4) bst[threadIdx.x] = 0u;
    __syncthreads();
    XcdBarrier xbar = xcd_barrier_post((unsigned*)a.ws, bst);
    int nsync = 0;
    unsigned char* ws = a.ws;
    float* MOD = (float*)(ws + WS_MOD); f32x2* ROPE = (f32x2*)(ws + WS_ROPE); float* CTXR = (float*)(ws + WS_CTX);
    bf16_t* W1 = (bf16_t*)(ws + WS_W1); bf16_t* W2 = (bf16_t*)(ws + WS_W2); bf16_t* HY = (bf16_t*)(ws + WS_HY);
    float* DTB = (float*)(ws + WS_DT); bf16_t* HALO = (bf16_t*)(ws + WS_HALO); bf16_t* BIG = (bf16_t*)(ws + WS_BIG); bf16_t* YB = (bf16_t*)(ws + WS_Y);
    const float* x_in = a.in[0]; const float* cvec = a.in[1]; const float* ctx_in = a.in[2]; const float* c_ctx = a.in[3]; const float* w_ada = a.in[4]; const float* b_ada = a.in[5];
    const float* norm_pre = a.in[6]; const float* norm_post = a.in[7]; const float* attn_w_in = a.in[8]; const float* attn_w_out = a.in[9]; const float* attn_sink = a.in[10];
    const float* attn_qn = a.in[11]; const float* attn_kn = a.in[12]; const float* ssm_w_in = a.in[13]; const float* conv_w = a.in[14]; const float* conv_b = a.in[15];
    const float* dt_bias = a.in[16]; const float* a_log = a.in[17]; const float* ssm_d = a.in[18]; const float* ssm_norm = a.in[19]; const float* ssm_w_out = a.in[20];

    int l = -1, st = 0;
    for (;;) {
        int op; const bool ssm = (l & 1) != 0 && l >= 0;
        if (l < 0) op = st == 0 ? OP_PROLOGUE : OP_NORM;
        else if (!ssm) op = st == 0 ? OP_GEMM_IN : st == 1 ? OP_ATTN : st == 2 ? OP_GEMM_BF16 : OP_NORM;
        else op = st == 0 ? OP_GEMM_XBC : st == 1 ? OP_CONV : (st == 2 || st == 3) ? OP_SCAN : st == 4 ? OP_GEMM_Z : st == 5 ? OP_GEMM_BF16 : OP_NORM;
        const int li = l >> 1;
        {
        constexpr bool dry = false;
        int tid_ = threadIdx.x; asm volatile("" : "+v"(tid_));
        Ctx c; c.tid = tid_; c.lane = c.tid & 63; c.wave = __builtin_amdgcn_readfirstlane(c.tid >> 6); c.gw = blockIdx.x * 8 + c.wave; c.ngw = gridDim.x * 8; c.lds = (char*)lds_;
        switch (op) {
#ifndef DIS_PRO
        case OP_PROLOGUE: {
            convert_weights(c, 0, attn_w_in, attn_w_out, ssm_w_in, ssm_w_out, W1, W2);
            __syncthreads();
            adaln_phase(c, cvec, c_ctx, w_ada, b_ada, MOD);
            rope_phase(c, ROPE);
        } break;
#endif
#ifndef DIS_NORM
        case OP_NORM: {
            const bool first = l <= 0;
            norm_pass(c, l, first ? x_in : a.out, a.out, first ? ctx_in : CTXR, CTXR, HY, MOD, norm_pre, norm_post, l < DEPTH_ - 1, dry);
            if (!dry && l >= 0 && l + 1 < DEPTH_) { __syncthreads(); convert_weights(c, l + 1, attn_w_in, attn_w_out, ssm_w_in, ssm_w_out, W1, W2); }
        } break;
#endif
#ifndef DIS_GEMM
        case OP_GEMM_BF16: {
            pg8::Gemm g; pg8::EpiBf16 E;
            if (!ssm) { g = pg8::Gemm{BIG, W2, MTOT, DM, AW, AIN}; E = pg8::EpiBf16{HY, DM}; }
            else { g = pg8::Gemm{YB, W2, MTOT, DM, DI, DI}; E = pg8::EpiBf16{HY, DM}; }
            if (l == DEPTH_ - 1) g.M = MLAT;
            pg8::StaticOrder S; S.init(g.M, g.N, (int)gridDim.x, (int)blockIdx.x);
            pg8::gemm_phase<pg8::EpiBf16, pg8::StaticOrder, true, true>((PG8_LAS unsigned char*)lds_, g, S, E, c.tid);
        } break;
#endif
#ifndef DIS_GEMMX
        case OP_GEMM_XBC: {
            pg8::Gemm g{HY, W1, MTOT, NXB, DM, DM}; pg8::EpiXbc E{BIG, HALO, DTB, dt_bias + (size_t)li * 64};
            pg8::StaticOrder S; S.init(g.M, g.N, (int)gridDim.x, (int)blockIdx.x);
            pg8::gemm_phase<pg8::EpiXbc, pg8::StaticOrder, true, true>((PG8_LAS unsigned char*)lds_, g, S, E, c.tid);
        } break;
#endif
#ifndef DIS_KPREP
        case OP_GEMM_IN: {
            pg8::Gemm g{HY, W1, MTOT, AIN, DM, DM};
            pg8::EpiAttnIn E{BIG, attn_kn + (size_t)li * 128, ROPE, (PG8_LAS float*)((PG8_LAS unsigned char*)lds_ + 131072)};
            pg8::StaticOrder S; S.init(g.M, g.N, (int)gridDim.x, (int)blockIdx.x);
            pg8::gemm_phase<pg8::EpiAttnIn, pg8::StaticOrder, true, true>((PG8_LAS unsigned char*)lds_, g, S, E, c.tid);
        } break;
#endif
#ifndef DIS_ATTN
        case OP_ATTN: attn_phase(c, li, BIG, attn_sink + (size_t)li * 8, attn_qn + (size_t)li * 128, ROPE, dry, 0); break;
#endif
#ifndef DIS_CONV
        case OP_CONV: conv_pass(c, BIG, HALO, conv_w + (size_t)li * 3 * CONVD, conv_b + (size_t)li * CONVD, dry); break;
#endif
#ifndef DIS_SCAN
        case OP_SCAN: ssd::scan_phase(c, st == 2 ? 1 : 0, BIG, DTB, YB, a_log + (size_t)li * 64, ssm_d + (size_t)li * 32, dry, 0); break;
#endif
#ifndef DIS_GNORM
        case OP_GEMM_Z: {
            pg8::Gemm g{HY, W1 + (size_t)NXB * DM, l == DEPTH_ - 1 ? MLAT : MTOT, DI, DM, DM};
            pg8::EpiGnorm E{YB, ssm_norm + (size_t)li * DI, (PG8_LAS float*)((PG8_LAS unsigned char*)lds_ + 131072)};
            pg8::StaticOrder S; S.init(g.M, g.N, (int)gridDim.x, (int)blockIdx.x);
            pg8::gemm_phase<pg8::EpiGnorm, pg8::StaticOrder, true, true>((PG8_LAS unsigned char*)lds_, g, S, E, c.tid);
        } break;
#endif
        default: break;
        }
        }
        const int nst = l < 0 ? 2 : (ssm ? 7 : 4);
        if (++st == nst) { st = 0; ++l; if (l == DEPTH_) break; }
        if (nsync++ == 0) grid.sync(); else xcd_barrier(xbar);
    }
}

extern "C" void kernel_launch(void* const* d_in, const int* in_sizes, int n_in, void* d_out, int out_size, void* d_ws, size_t ws_size, hipStream_t stream) {
    static int grid = 0;
    if (grid == 0) {
        if (n_in != 21 || in_sizes[0] != MLAT * DM || out_size != MLAT * DM || ws_size < WS_END) {
            fprintf(stderr, "kernel_launch: unexpected shapes (n_in %d, in0 %d, out %d, ws %zu < %zu?)\n", n_in, n_in > 0 ? in_sizes[0] : -1, out_size, ws_size, (size_t)WS_END); grid = -1; return; }
        int dev = 0, cus = 0, per_cu = 0;
        if (hipGetDevice(&dev) != hipSuccess || hipDeviceGetAttribute(&cus, hipDeviceAttributeMultiprocessorCount, dev) != hipSuccess) { grid = -1; return; }
        if (hipFuncSetAttribute((const void*)mega, hipFuncAttributeMaxDynamicSharedMemorySize, LDS_BYTES) != hipSuccess) { fprintf(stderr, "kernel_launch: hipFuncSetAttribute failed\n"); grid = -1; return; }
        if (hipOccupancyMaxActiveBlocksPerMultiprocessor(&per_cu, (const void*)mega, 512, LDS_BYTES) != hipSuccess || per_cu < 1) { fprintf(stderr, "kernel_launch: occupancy query says %d\n", per_cu); per_cu = 1; }
        (void)hipGetLastError();
        grid = cus * per_cu;
    }
    if (grid < 0) return;
    Args a{};
    for (int i = 0; i < 21; ++i) a.in[i] = (const float*)d_in[i];
    a.out = (float*)d_out; a.ws = (unsigned char*)d_ws; a.probe = PROBE_OP;
    if (hipMemsetAsync(d_ws, 0, 16384, stream) != hipSuccess) { fprintf(stderr, "kernel_launch: memset failed\n"); return; }
    void* args[] = {&a};
    hipError_t e = hipLaunchCooperativeKernel((const void*)mega, dim3(grid), dim3(512), args, LDS_BYTES, stream);
    if (e != hipSuccess) fprintf(stderr, "kernel_launch: cooperative launch failed: %s (grid %d)\n", hipGetErrorString(e), grid);
}
```

```cpp
#include <hip/hip_runtime.h>
#include <hip/hip_bf16.h>
#include <hip/hip_cooperative_groups.h>
#include <cstdio>
#include <cstdint>
namespace cg = cooperative_groups;

constexpr int T_ = 8192, NB = 4, CL = 256, DM = 1024, MLAT = NB * T_, MCTX = NB * CL, MTOT = MLAT + MCTX;
constexpr int DEPTH_ = 4;
constexpr int AIN = 5120, AW = 2048, PLD = AIN + 64;
constexpr int DI = 2048, CONVD = 4096, SSMH = 32, NXB = 4352;
constexpr float EPS_ = 1e-6f;
constexpr int PC_QA = 0, PC_QB = 1024, PC_KA = 2048, PC_VA = 2304, PC_KB = 2560, PC_VB = 2816, PC_GA = 3072, PC_GB = 4096;

constexpr size_t MiB = 1u << 20;
constexpr size_t WS_MOD = 1 * MiB;
constexpr size_t WS_ROPE = WS_MOD + 512 * 1024;
constexpr size_t WS_CTX = 2 * MiB;
constexpr size_t WS_W1 = 6 * MiB;
constexpr size_t WS_W2 = 19 * MiB;
constexpr size_t WS_HY = 26 * MiB;
constexpr size_t WS_DT = 92 * MiB;
constexpr size_t WS_HALO = 101 * MiB;
constexpr size_t WS_BIG = 106 * MiB;
constexpr size_t WS_Y = 370 * MiB;
constexpr size_t WS_END = 502 * MiB;

typedef unsigned short bf16_t;
typedef short bf16x8 __attribute__((ext_vector_type(8)));
typedef short s16x4 __attribute__((ext_vector_type(4)));
typedef float f32x4 __attribute__((ext_vector_type(4)));
typedef float f32x2 __attribute__((ext_vector_type(2)));
typedef float f32x16 __attribute__((ext_vector_type(16)));
typedef unsigned u32x4 __attribute__((ext_vector_type(4)));
typedef unsigned u32x2 __attribute__((ext_vector_type(2)));

__device__ __forceinline__ unsigned cvtpk(float lo, float hi) { unsigned r; asm volatile("v_cvt_pk_bf16_f32 %0, %1, %2" : "=v"(r) : "v"(lo), "v"(hi)); return r; }
__device__ __forceinline__ float bf2f(unsigned short u) { return __uint_as_float((unsigned)u << 16); }
__device__ __forceinline__ float bflo(unsigned w) { return __uint_as_float(w << 16); }
__device__ __forceinline__ float bfhi(unsigned w) { return __uint_as_float(w & 0xffff0000u); }
__device__ __forceinline__ unsigned short f2bf(float f) { return (unsigned short)(cvtpk(f, 0.f) & 0xffffu); }
__device__ __forceinline__ float silu_f(float x) { return x / (1.f + __expf(-x)); }
__device__ __forceinline__ float wave_sum(float v) {
#pragma unroll
    for (int o = 1; o < 64; o <<= 1) v += __shfl_xor(v, o);
    return v;
}
__device__ __forceinline__ int crow(int r, int hi) { return (r & 3) + 8 * (r >> 2) + 4 * hi; }
#define SBAR() __builtin_amdgcn_sched_barrier(0)

#define XLAS __attribute__((address_space(3)))
#define XB_TMO      128
#define XB_XCNT(j)  (256  + 64 * (j))
#define XB_XSUB(j)  (1280 + 64 * (j))
#define XB_XGEN(j)  (2304 + 64 * (j))
#define XB_TOP      3328
#define XB_TOPGEN   3392
#define XCD_BAR_WORDS 3456
#define XB_SPIN_CAP (1u << 18)

__device__ __forceinline__ unsigned xb_ld(unsigned* p)              { return __hip_atomic_load(p, __ATOMIC_RELAXED, __HIP_MEMORY_SCOPE_AGENT); }
__device__ __forceinline__ unsigned xb_add(unsigned* p, unsigned v) { return __hip_atomic_fetch_add(p, v, __ATOMIC_RELAXED, __HIP_MEMORY_SCOPE_AGENT); }
__device__ __forceinline__ unsigned xb_xcc_id() { return (unsigned)__builtin_amdgcn_s_getreg((3 << 11) | 20) & 0xFu; }
#define XB_SPIN(cond, bar) do { unsigned _sp = 0; while (cond) { __builtin_amdgcn_s_sleep(1); \
    if ((++_sp & 255u) == 0u) { if (xb_ld(&(bar)[XB_TMO])) break; if (_sp > XB_SPIN_CAP) { atomicAdd(&(bar)[XB_TMO], 1u); break; } } } } while (0)

struct XcdBarrier {
    unsigned* bar; unsigned x;
    volatile XLAS unsigned* st;
};

__device__ __forceinline__ XcdBarrier xcd_barrier_post(unsigned* bar, volatile XLAS unsigned* st) {
    XcdBarrier b; b.bar = bar; b.x = xb_xcc_id(); b.st = st;
    if (threadIdx.x == 0) (void)xb_add(&bar[XB_XCNT(b.x)], 1u);
    return b;
}
__device__ __forceinline__ void xcd_barrier_complete(unsigned* bar, unsigned x, unsigned& nloc, unsigned& nx) {
    const unsigned G = gridDim.x * gridDim.y * gridDim.z;
    unsigned sum, cnt, mine, sp = 0u;
    for (;;) {
        sum = 0u; cnt = 0u; mine = 0u;
#pragma unroll
        for (unsigned j = 0; j < 16; ++j) { const unsigned c = xb_ld(&bar[XB_XCNT(j)]); sum += c; cnt += (c > 0u) ? 1u : 0u; mine = (j == x) ? c : mine; }
        if (sum == G) break;
        __builtin_amdgcn_s_sleep(1);
        if ((++sp & 255u) == 0u) { if (xb_ld(&bar[XB_TMO])) break; if (sp > XB_SPIN_CAP) { atomicAdd(&bar[XB_TMO], 1u); break; } }
    }
    nloc = mine > 0u ? mine : 1u; nx = cnt > 0u ? cnt : 1u;
}

__device__ __forceinline__ void xcd_barrier(const XcdBarrier& b) {
    asm volatile("s_waitcnt vmcnt(0)" ::: "memory");
    __syncthreads();
    if (threadIdx.x == 0) {
        unsigned* bar = b.bar;
        __builtin_amdgcn_s_waitcnt(0);
        unsigned nloc = b.st[0], nx = b.st[1];
        if (nloc == 0u) { xcd_barrier_complete(bar, b.x, nloc, nx); b.st[0] = nloc; b.st[1] = nx; }
        const unsigned old = xb_add(&bar[XB_XSUB(b.x)], 1u);
        const unsigned gen = old / nloc;
        if (old + 1u == (gen + 1u) * nloc) {
            __builtin_amdgcn_fence(__ATOMIC_RELEASE, "agent");
            asm volatile("s_waitcnt vmcnt(0)" ::: "memory");
            const unsigned og = xb_add(&bar[XB_TOP], 1u);
            const unsigned tg = og / nx;
            if (og + 1u == (tg + 1u) * nx) xb_add(&bar[XB_TOPGEN], 1u);
            else XB_SPIN(xb_ld(&bar[XB_TOPGEN]) == tg, bar);
            __builtin_amdgcn_fence(__ATOMIC_ACQUIRE, "agent");
            xb_add(&bar[XB_XGEN(b.x)], 1u);
            asm volatile("s_waitcnt vmcnt(0)" ::: "memory");
        } else {
            XB_SPIN(xb_ld(&bar[XB_XGEN(b.x)]) == gen, bar);
            __builtin_amdgcn_fence(__ATOMIC_ACQUIRE, "agent");
            asm volatile("s_waitcnt vmcnt(0)" ::: "memory");
        }
    }
    __syncthreads();
}
namespace pg8 {
#define PG8_LAS __attribute__((address_space(3)))
typedef unsigned short bf16_t;
typedef short bf16x8 __attribute__((ext_vector_type(8)));
typedef float f32x4 __attribute__((ext_vector_type(4)));
typedef unsigned u32x4 __attribute__((ext_vector_type(4)));
constexpr int BM = 256, BK = 64, HALF = 128, HTB = HALF * BK * 2  , STAGE_BYTES = 8 * HTB, NXCD = 8, WGM = 8;

__host__ __device__ __forceinline__ int lds_byte(int r, int c) { const int st = (r >> 4) * 2 + (c >> 5), rr = r & 15, cc = c & 31, ob = rr * 64 + cc * 2; return st * 1024 + (ob ^ (((ob >> 9) & 1) << 5)); }
__host__ __device__ __forceinline__ void stage_rc(int b, int& R, int& C) { const int st = b / 1024, sb = b % 1024, swz = sb ^ (((sb >> 9) & 1) << 5); R = (st >> 1) * 16 + swz / 64; C = (st & 1) * 32 + (swz % 64) / 2; }
__host__ __device__ __forceinline__ int perm32(int rho) { const int n = rho >> 4, i = rho & 15; return 8 * (i >> 2) + 4 * n + (i & 3); }

struct Unit { int pm, pn; };
struct Gemm { const bf16_t* A; const bf16_t* Bt; int M, N, K, lda; };

struct StaticOrder {
    int nM, nN, nwg, G, c;
    __host__ __device__ void init(int M, int N, int G_, int c_) { nM = M / BM; nN = N / BM; nwg = nM * nN; G = G_; c = c_; }
    __host__ __device__ bool next(int i, Unit& u) const {
        const long L = (long)i * G + c; if (L >= nwg) return false;
        int wgid = (int)L; { const int q = nwg / NXCD, r = nwg % NXCD, xcd = wgid % NXCD, off = wgid / NXCD; wgid = (xcd < r ? xcd * (q + 1) : r * (q + 1) + (xcd - r) * q) + off; }
        const int nig = WGM * nN, gid = wgid / nig, fm = gid * WGM, gsz = (nM - fm) < WGM ? (nM - fm) : WGM;
        u.pm = fm + ((wgid % nig) % gsz); u.pn = (wgid % nig) / gsz; return true;
    }
    __device__ __forceinline__ void a_ready(const Unit&) const {}
    __device__ __forceinline__ void done(const Unit&) const {}
};

struct EpiBf16 {
    static constexpr bool PERM = true, AFTER_DRAIN = false;
    bf16_t* O; int ldc;
    __device__ __forceinline__ void operator()(const f32x4 (&acc)[2][2][4][2], const Unit& u, int wr, int wc, int fr, int fq) const {
        asm volatile("s_nop 7\n\ts_nop 7\n\ts_nop 7" ::: "memory");
        const int row0 = u.pm * BM + wr * 64 + fr, col0 = u.pn * BM + wc * 32 + 8 * fq;
#pragma unroll
        for (int ai = 0; ai < 2; ++ai)
#pragma unroll
            for (int m = 0; m < 4; ++m) { bf16_t* rowp = O + (size_t)(row0 + ai * HALF + m * 16) * ldc + col0;
#pragma unroll
                for (int bj = 0; bj < 2; ++bj) { const f32x4 v0 = acc[ai][bj][m][0], v1 = acc[ai][bj][m][1];
                    u32x4 w; w.x = cvtpk(v0[0], v0[1]); w.y = cvtpk(v0[2], v0[3]); w.z = cvtpk(v1[0], v1[1]); w.w = cvtpk(v1[2], v1[3]);
                    *(u32x4*)(rowp + bj * HALF) = w; } }
    }
};
struct EpiGnorm {
    static constexpr bool PERM = true, AFTER_DRAIN = false;
    bf16_t* Y; const float* nw; PG8_LAS float* tab;
    __device__ __forceinline__ void operator()(f32x4 (&acc)[2][2][4][2], const Unit& u, int wr, int wc, int fr, int fq) const {
        const int row0 = u.pm * BM + wr * 64 + fr, col0 = u.pn * BM + wc * 32 + 8 * fq;
#pragma unroll
        for (int ai = 0; ai < 2; ++ai)
#pragma unroll
            for (int m = 0; m < 4; ++m) { const bf16_t* yp = Y + (size_t)(row0 + ai * HALF + m * 16) * DI + col0; float ssq = 0.f;
#pragma unroll
                for (int bj = 0; bj < 2; ++bj) { const u32x4 yv = *(const u32x4*)(yp + bj * HALF); f32x4& z0 = acc[ai][bj][m][0]; f32x4& z1 = acc[ai][bj][m][1];
                    z0[0] = bflo(yv.x) * silu_f(z0[0]); z0[1] = bfhi(yv.x) * silu_f(z0[1]); z0[2] = bflo(yv.y) * silu_f(z0[2]); z0[3] = bfhi(yv.y) * silu_f(z0[3]);
                    z1[0] = bflo(yv.z) * silu_f(z1[0]); z1[1] = bfhi(yv.z) * silu_f(z1[1]); z1[2] = bflo(yv.w) * silu_f(z1[2]); z1[3] = bfhi(yv.w) * silu_f(z1[3]);
                    ssq += (z0[0] * z0[0] + z0[1] * z0[1]) + (z0[2] * z0[2] + z0[3] * z0[3]) + (z1[0] * z1[0] + z1[1] * z1[1]) + (z1[2] * z1[2] + z1[3] * z1[3]); }
                ssq += __shfl_xor(ssq, 16); ssq += __shfl_xor(ssq, 32);
                if (fq == 0) tab[(ai * HALF + wr * 64 + m * 16 + fr) * 4 + wc] = ssq; }
        asm volatile("s_waitcnt lgkmcnt(0)" ::: "memory"); __builtin_amdgcn_s_barrier(); asm volatile("" ::: "memory");
        f32x4 w[2][2];
#pragma unroll
        for (int bj = 0; bj < 2; ++bj) { w[bj][0] = *(const f32x4*)(nw + col0 + bj * HALF); w[bj][1] = *(const f32x4*)(nw + col0 + bj * HALF + 4); }
#pragma unroll
        for (int ai = 0; ai < 2; ++ai)
#pragma unroll
            for (int m = 0; m < 4; ++m) { const f32x4 t = *(const PG8_LAS f32x4*)(tab + (ai * HALF + wr * 64 + m * 16 + fr) * 4);
                const float rs = rsqrtf(((t[0] + t[1]) + (t[2] + t[3])) * (1.f / 256.f) + EPS_);
                bf16_t* yp = Y + (size_t)(row0 + ai * HALF + m * 16) * DI + col0;
#pragma unroll
                for (int bj = 0; bj < 2; ++bj) { const f32x4 v0 = acc[ai][bj][m][0] * rs * w[bj][0], v1 = acc[ai][bj][m][1] * rs * w[bj][1];
                    u32x4 o; o.x = cvtpk(v0[0], v0[1]); o.y = cvtpk(v0[2], v0[3]); o.z = cvtpk(v1[0], v1[1]); o.w = cvtpk(v1[2], v1[3]);
                    *(u32x4*)(yp + bj * HALF) = o; } }
    }
};
struct EpiAttnIn {
    static constexpr bool PERM = true, AFTER_DRAIN = false;
    bf16_t* O; const float* knw; const f32x2* rope; PG8_LAS float* tab;
    __device__ __forceinline__ void operator()(f32x4 (&acc)[2][2][4][2], const Unit& u, int wr, int wc, int fr, int fq) const {
        asm volatile("s_nop 7\n\ts_nop 7\n\ts_nop 7" ::: "memory");
        const int row0 = u.pm * BM + wr * 64 + fr, col0 = u.pn * BM + wc * 32 + 8 * fq;
        const bool isK = u.pn == 8 || u.pn == 10, isB = u.pn == 10;
        if (isB) {
#pragma unroll
            for (int ai = 0; ai < 2; ++ai)
#pragma unroll
                for (int m = 0; m < 4; ++m)
#pragma unroll
                    for (int bj = 0; bj < 2; ++bj) { const f32x4 a = acc[ai][bj][m][0], b = acc[ai][bj][m][1];
                        float ssq = (a[0] * a[0] + a[1] * a[1]) + (a[2] * a[2] + a[3] * a[3]) + (b[0] * b[0] + b[1] * b[1]) + (b[2] * b[2] + b[3] * b[3]);
                        ssq += __shfl_xor(ssq, 16); ssq += __shfl_xor(ssq, 32);
                        if (fq == 0) tab[((ai * HALF + wr * 64 + m * 16 + fr) * 2 + bj) * 4 + wc] = ssq; }
            asm volatile("s_waitcnt lgkmcnt(0)" ::: "memory"); __builtin_amdgcn_s_barrier(); asm volatile("" ::: "memory");
        }
        f32x4 kw0 = {1.f, 1.f, 1.f, 1.f}, kw1 = kw0;
        if (isB) { kw0 = *(const f32x4*)(knw + wc * 32 + 8 * fq); kw1 = *(const f32x4*)(knw + wc * 32 + 8 * fq + 4); }
        const int i0 = wc * 16 + 4 * fq;
#pragma unroll
        for (int ai = 0; ai < 2; ++ai)
#pragma unroll
            for (int m = 0; m < 4; ++m) { const int row = row0 + ai * HALF + m * 16; bf16_t* rowp = O + (size_t)row * PLD + col0;
                f32x4 c01 = {1.f, 0.f, 1.f, 0.f}, c23 = c01;
                const bool rot = isK && row < MLAT;
                if (rot) { const int pos = row & (T_ - 1); const int tb = i0 < 32 ? (pos >> 6) : (pos & 63); const f32x4* tp = (const f32x4*)(rope + tb * 32 + (i0 & 31)); c01 = tp[0]; c23 = tp[1]; }
#pragma unroll
                for (int bj = 0; bj < 2; ++bj) { f32x4 v0 = acc[ai][bj][m][0], v1 = acc[ai][bj][m][1];
                    if (isB) { const f32x4 t = *(const PG8_LAS f32x4*)(tab + ((ai * HALF + wr * 64 + m * 16 + fr) * 2 + bj) * 4);
                        const float rs = rsqrtf(((t[0] + t[1]) + (t[2] + t[3])) * (1.f / 128.f) + EPS_); v0 = v0 * rs * kw0; v1 = v1 * rs * kw1; }
                    if (rot) { float x0, x1;
                        x0 = v0[0]; x1 = v0[1]; v0[0] = x0 * c01[0] - x1 * c01[1]; v0[1] = x0 * c01[1] + x1 * c01[0];
                        x0 = v0[2]; x1 = v0[3]; v0[2] = x0 * c01[2] - x1 * c01[3]; v0[3] = x0 * c01[3] + x1 * c01[2];
                        x0 = v1[0]; x1 = v1[1]; v1[0] = x0 * c23[0] - x1 * c23[1]; v1[1] = x0 * c23[1] + x1 * c23[0];
                        x0 = v1[2]; x1 = v1[3]; v1[2] = x0 * c23[2] - x1 * c23[3]; v1[3] = x0 * c23[3] + x1 * c23[2]; }
                    u32x4 w; w.x = cvtpk(v0[0], v0[1]); w.y = cvtpk(v0[2], v0[3]); w.z = cvtpk(v1[0], v1[1]); w.w = cvtpk(v1[2], v1[3]);
                    *(u32x4*)(rowp + bj * HALF) = w; } }
    }
};
struct EpiXbc {
    static constexpr bool PERM = true, AFTER_DRAIN = false;
    bf16_t* O; bf16_t* halo; float* dt; const float* dtb;
    __device__ __forceinline__ void operator()(const f32x4 (&acc)[2][2][4][2], const Unit& u, int wr, int wc, int fr, int fq) const {
        asm volatile("s_nop 7\n\ts_nop 7\n\ts_nop 7" ::: "memory");
        const int row0 = u.pm * BM + wr * 64 + fr;
        if (u.pn < 16) {
            const int col0 = u.pn * BM + wc * 32 + 8 * fq;
#pragma unroll
            for (int ai = 0; ai < 2; ++ai)
#pragma unroll
                for (int m = 0; m < 4; ++m) { const int row = row0 + ai * HALF + m * 16; bf16_t* rowp = O + (size_t)row * CONVD + col0;
                    const int rl = row & 127;
#pragma unroll
                    for (int bj = 0; bj < 2; ++bj) { const f32x4 v0 = acc[ai][bj][m][0], v1 = acc[ai][bj][m][1];
                        u32x4 w; w.x = cvtpk(v0[0], v0[1]); w.y = cvtpk(v0[2], v0[3]); w.z = cvtpk(v1[0], v1[1]); w.w = cvtpk(v1[2], v1[3]);
                        *(u32x4*)(rowp + bj * HALF) = w;
                        if (rl == 0) *(u32x4*)(halo + ((size_t)(row >> 7) * 2 + 0) * CONVD + col0 + bj * HALF) = w;
                        if (rl == 127) *(u32x4*)(halo + ((size_t)(row >> 7) * 2 + 1) * CONVD + col0 + bj * HALF) = w; } }
        } else {
            const int lc = wc * 32 + 8 * fq;
            if (wc < 2) {
                const f32x4 b0 = *(const f32x4*)(dtb + lc), b1 = *(const f32x4*)(dtb + lc + 4);
#pragma unroll
                for (int ai = 0; ai < 2; ++ai)
#pragma unroll
                    for (int m = 0; m < 4; ++m) { const int row = row0 + ai * HALF + m * 16;
                        f32x4 v0 = acc[ai][0][m][0] + b0, v1 = acc[ai][0][m][1] + b1;
#pragma unroll
                        for (int j = 0; j < 4; ++j) { v0[j] = v0[j] > 20.f ? v0[j] : log1pf(__expf(v0[j])); v1[j] = v1[j] > 20.f ? v1[j] : log1pf(__expf(v1[j])); }
#pragma unroll
                        for (int j = 0; j < 4; ++j) { dt[(size_t)(lc + j) * MTOT + row] = v0[j]; dt[(size_t)(lc + 4 + j) * MTOT + row] = v1[j]; } }
            }
        }
    }
};
template <class Epi, class Sched, bool ALIGN_EPI = false, bool SP2 = false>
__device__ __forceinline__ void gemm_phase(PG8_LAS unsigned char* lds, const Gemm g, const Sched& S, const Epi& E, const int tid) {
    const int wid = __builtin_amdgcn_readfirstlane(tid >> 6), lane = tid & 63, wr = wid >> 2, wc = wid & 3, fr = lane & 15, fq = lane >> 4;
    const int K = g.K, nt = K / BK;
    unsigned voffA[2], voffB[2];
#pragma unroll
    for (int i = 0; i < 2; ++i) { int R, C; stage_rc(tid * 16 + i * 8192, R, C); const int Rb = Epi::PERM ? ((R & ~31) + perm32(R & 31)) : R;
        voffA[i] = (unsigned)(R * g.lda + C) * 2u; voffB[i] = (unsigned)(Rb * K + C) * 2u; }
    const size_t kstep = (size_t)(BK * 2);
    const size_t hstepA = (size_t)HALF * g.lda * 2, hstepB = (size_t)HALF * K * 2;
    const size_t tstepA = 2 * hstepA, tstepB = 2 * hstepB;
    const unsigned ldsw = (unsigned)wid * 1024u;
    const int aoff = lds_byte(wr * 64 + fr, fq * 8), boff = lds_byte(wc * 32 + fr, fq * 8);
#define PG8_SA(b, h) (((b) * 2 + (h)) * HTB)
#define PG8_SB(b, h) ((4 + (b) * 2 + (h)) * HTB)
#define PG8_STAGE(bufoff, gbase, voff) do { _Pragma("unroll") for (int _i = 0; _i < 2; ++_i) \
        __builtin_amdgcn_global_load_lds((const unsigned*)((const char*)(gbase) + (voff)[_i]), (PG8_LAS unsigned*)(lds + (bufoff) + ldsw + _i * 8192), 16, 0, 0); } while (0)
#define PG8_LDA(dst, b, h) do { _Pragma("unroll") for (int m = 0; m < 4; ++m) _Pragma("unroll") for (int k = 0; k < 2; ++k) dst[m][k] = *(const PG8_LAS bf16x8*)(lds + PG8_SA(b, h) + aoff + m * 2048 + k * 1024); } while (0)
#define PG8_LDB(dst, b, h) do { _Pragma("unroll") for (int n = 0; n < 2; ++n) _Pragma("unroll") for (int k = 0; k < 2; ++k) dst[n][k] = *(const PG8_LAS bf16x8*)(lds + PG8_SB(b, h) + boff + n * 2048 + k * 1024); } while (0)
#define PG8_MMA(ai, bj, At, Bt) do { __builtin_amdgcn_s_setprio(1); _Pragma("unroll") for (int m = 0; m < 4; ++m) _Pragma("unroll") for (int n = 0; n < 2; ++n) _Pragma("unroll") for (int k = 0; k < 2; ++k) \
        acc[ai][bj][m][n] = __builtin_amdgcn_mfma_f32_16x16x32_bf16(Bt[n][k], At[m][k], acc[ai][bj][m][n], 0, 0, 0); __builtin_amdgcn_s_setprio(0); } while (0)
#define PG8_WAIT_V(n) asm volatile("s_waitcnt vmcnt(" #n ")" ::: "memory")
#define PG8_WAIT_L(n) asm volatile("s_waitcnt lgkmcnt(" #n ")" ::: "memory")
#define PG8_BAR __builtin_amdgcn_s_barrier()
#define PG8_SCHED __builtin_amdgcn_sched_barrier(0)
    Unit cur, nxt; int ui = 0;
    if (!S.next(0, cur)) return;
    f32x4 acc[2][2][4][2];
#pragma unroll
    for (int a = 0; a < 2; ++a)
#pragma unroll
        for (int b = 0; b < 2; ++b)
#pragma unroll
            for (int m = 0; m < 4; ++m)
#pragma unroll
                for (int n = 0; n < 2; ++n) acc[a][b][m][n] = (f32x4){0.f, 0.f, 0.f, 0.f};
    bf16x8 At[4][2], B0[2][2], B1[2][2];
    const char* cA = (const char*)g.A + (size_t)cur.pm * tstepA; const char* cB = (const char*)g.Bt + (size_t)cur.pn * tstepB;
    S.a_ready(cur);
    if constexpr (SP2) {
        PG8_STAGE(PG8_SB(0, 0), cB, voffB); PG8_STAGE(PG8_SB(0, 1), cB + hstepB, voffB); PG8_STAGE(PG8_SA(0, 0), cA, voffA); PG8_STAGE(PG8_SA(0, 1), cA + hstepA, voffA);
        if (wr == 1) PG8_BAR;
        PG8_WAIT_V(2); PG8_BAR;
        PG8_STAGE(PG8_SB(1, 0), cB + kstep, voffB); PG8_STAGE(PG8_SA(1, 0), cA + kstep, voffA); PG8_STAGE(PG8_SB(1, 1), cB + hstepB + kstep, voffB);
        PG8_WAIT_V(6); PG8_BAR;
    } else {
        PG8_STAGE(PG8_SB(0, 0), cB, voffB); PG8_STAGE(PG8_SA(0, 0), cA, voffA); PG8_STAGE(PG8_SB(0, 1), cB + hstepB, voffB); PG8_STAGE(PG8_SA(0, 1), cA + hstepA, voffA);
        if (wr == 1) PG8_BAR;
        PG8_WAIT_V(4); PG8_BAR;
        PG8_STAGE(PG8_SB(1, 0), cB + kstep, voffB); PG8_STAGE(PG8_SA(1, 0), cA + kstep, voffA); PG8_STAGE(PG8_SB(1, 1), cB + hstepB + kstep, voffB);
        PG8_WAIT_V(6); PG8_BAR;
    }
    for (;;) {
        const bool has_next = S.next(ui + 1, nxt);
        const char* nA = has_next ? (const char*)g.A + (size_t)nxt.pm * tstepA : cA; const char* nB = has_next ? (const char*)g.Bt + (size_t)nxt.pn * tstepB : cB;
        for (int t = 0; t < nt; t += 2) {
            const bool last = (t == nt - 2);
            const char* a1 = cA + (size_t)(t + 1) * kstep;
            const char* a2 = last ? nA : cA + (size_t)(t + 2) * kstep; const char* b2 = last ? nB : cB + (size_t)(t + 2) * kstep;
            const char* a3 = a2 + kstep; const char* b3 = b2 + kstep;
            if (last && has_next) S.a_ready(nxt);
            if constexpr (SP2) {
            PG8_LDB(B0, 0, 0); PG8_LDB(B1, 0, 1); PG8_SCHED; PG8_LDA(At, 0, 0); PG8_STAGE(PG8_SA(1, 1), a1 + hstepA, voffA);
            PG8_WAIT_V(8); PG8_WAIT_L(0); PG8_BAR; PG8_MMA(0, 0, At, B0); PG8_MMA(0, 1, At, B1); PG8_BAR; PG8_SCHED;
            PG8_LDA(At, 0, 1); PG8_STAGE(PG8_SB(0, 0), b2, voffB); PG8_STAGE(PG8_SB(0, 1), b2 + hstepB, voffB); PG8_STAGE(PG8_SA(0, 0), a2, voffA);
            PG8_WAIT_V(8); PG8_WAIT_L(0); PG8_BAR; PG8_MMA(1, 0, At, B0); PG8_MMA(1, 1, At, B1); PG8_BAR; PG8_SCHED;
            PG8_LDB(B0, 1, 0); PG8_LDB(B1, 1, 1); PG8_SCHED; PG8_LDA(At, 1, 0); PG8_STAGE(PG8_SA(0, 1), a2 + hstepA, voffA);
            PG8_WAIT_V(8); PG8_WAIT_L(0); PG8_BAR; PG8_MMA(0, 0, At, B0); PG8_MMA(0, 1, At, B1); PG8_BAR; PG8_SCHED;
            PG8_LDA(At, 1, 1); PG8_STAGE(PG8_SB(1, 0), b3, voffB); PG8_STAGE(PG8_SB(1, 1), b3 + hstepB, voffB); PG8_STAGE(PG8_SA(1, 0), a3, voffA);
            PG8_WAIT_V(8); PG8_WAIT_L(0); PG8_BAR; PG8_MMA(1, 0, At, B0); PG8_MMA(1, 1, At, B1); PG8_BAR; PG8_SCHED;
            } else {
            PG8_LDB(B0, 0, 0); PG8_SCHED; PG8_LDA(At, 0, 0); PG8_STAGE(PG8_SA(1, 1), a1 + hstepA, voffA);
            PG8_WAIT_L(8); PG8_BAR; PG8_WAIT_L(0); PG8_MMA(0, 0, At, B0); PG8_BAR; PG8_SCHED;
            PG8_LDB(B1, 0, 1); PG8_STAGE(PG8_SB(0, 0), b2, voffB);
            PG8_BAR; PG8_WAIT_L(0); PG8_MMA(0, 1, At, B1); PG8_BAR;
            PG8_LDA(At, 0, 1); PG8_STAGE(PG8_SA(0, 0), a2, voffA);
            PG8_BAR; PG8_WAIT_L(0); PG8_MMA(1, 0, At, B0); PG8_BAR; PG8_SCHED;
            PG8_STAGE(PG8_SB(0, 1), b2 + hstepB, voffB);
            PG8_WAIT_V(6); PG8_BAR; PG8_MMA(1, 1, At, B1); PG8_BAR;
            PG8_LDB(B0, 1, 0); PG8_SCHED; PG8_LDA(At, 1, 0); PG8_STAGE(PG8_SA(0, 1), a2 + hstepA, voffA);
            PG8_WAIT_L(8); PG8_BAR; PG8_WAIT_L(0); PG8_MMA(0, 0, At, B0); PG8_BAR; PG8_SCHED;
            PG8_LDB(B1, 1, 1); PG8_STAGE(PG8_SB(1, 0), b3, voffB);
            PG8_BAR; PG8_WAIT_L(0); PG8_MMA(0, 1, At, B1); PG8_BAR;
            PG8_LDA(At, 1, 1); PG8_STAGE(PG8_SA(1, 0), a3, voffA);
            PG8_BAR; PG8_WAIT_L(0); PG8_MMA(1, 0, At, B0); PG8_BAR; PG8_SCHED;
            PG8_STAGE(PG8_SB(1, 1), b3 + hstepB, voffB);
            PG8_WAIT_V(6); PG8_BAR; PG8_MMA(1, 1, At, B1); PG8_BAR;
            }
        }
        if constexpr (ALIGN_EPI) { if (wr == 0) PG8_BAR; }
        if constexpr (!Epi::AFTER_DRAIN) { E(acc, cur, wr, wc, fr, fq); S.done(cur); }
        if (!has_next) break;
#pragma unroll
        for (int a = 0; a < 2; ++a)
#pragma unroll
            for (int b = 0; b < 2; ++b)
#pragma unroll
                for (int m = 0; m < 4; ++m)
#pragma unroll
                    for (int n = 0; n < 2; ++n) acc[a][b][m][n] = (f32x4){0.f, 0.f, 0.f, 0.f};
        cur = nxt; cA = nA; cB = nB; ++ui;
        if constexpr (ALIGN_EPI) { if (wr == 1) PG8_BAR; }
    }
    PG8_WAIT_V(0);
    if constexpr (!ALIGN_EPI) { if (wr == 0) PG8_BAR; }
    PG8_BAR;
    if constexpr (Epi::AFTER_DRAIN) { E.fused(acc, cur, wr, wc, fr, fq, lds, wid, lane); S.done(cur); }
#undef PG8_SA
#undef PG8_SB
#undef PG8_STAGE
#undef PG8_LDA
#undef PG8_LDB
#undef PG8_MMA
#undef PG8_WAIT_V
#undef PG8_WAIT_L
#undef PG8_BAR
#undef PG8_SCHED
}
}
namespace att {
constexpr int D = 128, NW = 8, QBLK = 32, KVBLK = 64, LDP = PLD;
constexpr float SCALE = 0.088388347648318440f, THR = 8.f;
#ifndef ATT_NQR
#define ATT_NQR 5
#endif
#ifndef ATT_NQR_U
#define ATT_NQR_U 8
#endif
constexpr int NQR = ATT_NQR, NQR_U = ATT_NQR_U;
constexpr size_t SHM_V = KVBLK * D * 2, SHM_K = KVBLK * D * 2, SHM_ATTN = 2 * SHM_V + 2 * SHM_K + NW * 64 * 4, SHM_Q = (8 - NQR) * 8192;
#define KSWZ(row, colB) ((row) * 256 + ((colB) ^ (((row) & 7) << 4)))
__device__ __forceinline__ void partialSM(f32x16& p0, f32x16& p1, float& m_reg, float& mn, float& alpha) {
  constexpr float C = SCALE * 1.4426950408889634f;
  float pmax = p0[0];
#pragma unroll
  for (int r = 1; r < 16; ++r) pmax = fmaxf(pmax, p0[r]);
#pragma unroll
  for (int r = 0; r < 16; ++r) pmax = fmaxf(pmax, p1[r]);
  { auto rr = __builtin_amdgcn_permlane32_swap(__float_as_uint(pmax), __float_as_uint(pmax), false, false);
    pmax = fmaxf(__uint_as_float(rr[0]), __uint_as_float(rr[1])); }
  if (__builtin_expect(__all(pmax - m_reg <= THR / SCALE), 1)) { mn = m_reg; alpha = 1.f; }
  else { mn = fmaxf(m_reg, pmax); alpha = __builtin_amdgcn_exp2f((m_reg - mn) * C); m_reg = mn; }
  float mnC = -mn * C;
#pragma unroll
  for (int r = 0; r < 16; ++r) p0[r] = fmaf(p0[r], C, mnC);
#pragma unroll
  for (int r = 0; r < 16; ++r) p1[r] = fmaf(p1[r], C, mnC);
#pragma unroll
  for (int r = 0; r < 16; ++r) p0[r] = __builtin_amdgcn_exp2f(p0[r]);
}
__device__ __forceinline__ void finishSM(f32x16& p0, f32x16& p1, float alpha, float& l_reg, bf16x8& pa0, bf16x8& pa1, bf16x8& pa2, bf16x8& pa3) {
#pragma unroll
  for (int r = 0; r < 16; ++r) p1[r] = __builtin_amdgcn_exp2f(p1[r]);
  float ps = 0;
#pragma unroll
  for (int r = 0; r < 16; ++r) ps += p0[r];
#pragma unroll
  for (int r = 0; r < 16; ++r) ps += p1[r];
  { auto rr = __builtin_amdgcn_permlane32_swap(__float_as_uint(ps), __float_as_uint(ps), false, false);
    ps = __uint_as_float(rr[0]) + __uint_as_float(rr[1]); }
  l_reg = l_reg * alpha + ps;
#define PK4(P, BASE, OUT) do { unsigned a0 = cvtpk(P[BASE + 0], P[BASE + 1]), a1 = cvtpk(P[BASE + 2], P[BASE + 3]);   \
    unsigned b0 = cvtpk(P[BASE + 4], P[BASE + 5]), b1 = cvtpk(P[BASE + 6], P[BASE + 7]);                              \
    auto r0 = __builtin_amdgcn_permlane32_swap(a0, b0, false, false); auto r1 = __builtin_amdgcn_permlane32_swap(a1, b1, false, false); \
    u32x4 w = {r0[0], r1[0], r0[1], r1[1]}; OUT = *reinterpret_cast<bf16x8*>(&w); } while (0)
  PK4(p0, 0, pa0); PK4(p0, 8, pa1); PK4(p1, 0, pa2); PK4(p1, 8, pa3);
#undef PK4
}
template <int NQ>
__device__ __forceinline__ void qkt(f32x16& p0, f32x16& p1, const char* Ks, const bf16x8* qr, const char* ql, int r32, int hi) {
  p0 = f32x16{}; p1 = f32x16{};
  const int x = (r32 & 7) << 4, kb = r32 * 256;
  const char* a0 = Ks + kb + ((hi * 16) ^ x); const char* a1 = Ks + kb + ((32 + hi * 16) ^ x); const char* a2 = Ks + kb + ((64 + hi * 16) ^ x); const char* a3 = Ks + kb + ((96 + hi * 16) ^ x);
#define QK1(QV, AP, IMM) { const bf16x8 b0 = *reinterpret_cast<const bf16x8*>(AP + IMM); const bf16x8 b1 = *reinterpret_cast<const bf16x8*>(AP + IMM + 8192); const bf16x8 qv = QV; \
    p0 = __builtin_amdgcn_mfma_f32_32x32x16_bf16(b0, qv, p0, 0, 0, 0); p1 = __builtin_amdgcn_mfma_f32_32x32x16_bf16(b1, qv, p1, 0, 0, 0); }
#define QLD(I) (*reinterpret_cast<const bf16x8*>(ql + (I) * 8192))
  #define QSEL(I) ((I) < NQ ? qr[(I) < NQ ? (I) : 0] : QLD((I) - NQ))
  QK1(QSEL(0), a0, 0) QK1(QSEL(1), a1, 0) QK1(QSEL(2), a2, 0) QK1(QSEL(3), a3, 0) QK1(QSEL(4), a0, 128) QK1(QSEL(5), a1, 128) QK1(QSEL(6), a2, 128) QK1(QSEL(7), a3, 128)
#undef QSEL
#undef QK1
#undef QLD
}
__device__ __forceinline__ void wmask(f32x16& p0, f32x16& p1, int kp, int qp, int hi) {
#pragma unroll
  for (int r = 0; r < 16; ++r) { const int d = qp - (kp + crow(r, hi));
    if (d > 128 || d < -128) p0[r] = -INFINITY;
    if (d - 32 > 128 || d - 32 < -128) p1[r] = -INFINITY; }
}
__device__ __forceinline__ int v_st(int k, int c) { const int kk = (k & ~0xC) | ((k & 4) << 1) | ((k & 8) >> 1); return ((kk >> 3) * 4 + (c >> 5)) * 512 + ((kk & 7) * 32 + (c & 31)) * 2; }
__device__ __forceinline__ int v_rd_base(int lane) { return ((lane & 3) << 3) | (((lane >> 2) & 3) << 6) | (((lane >> 4) & 1) << 5) | (((lane >> 5) & 1) << 8); }
constexpr int v_rd_off(int d0, int ks, int half) { return d0 * 512 + ks * 4096 + half * 2048; }
template <int OFF> __device__ __forceinline__ s16x4 tr_read(int vb) {
  s16x4 r; asm volatile("ds_read_b64_tr_b16 %0, %1 offset:%2" : "=&v"(r) : "v"(vb), "i"(OFF) : "memory"); return r;
}
template <int D0> __device__ __forceinline__ void pv_one(f32x16& od, int vb, bf16x8 pa0, bf16x8 pa1, bf16x8 pa2, bf16x8 pa3) {
  const s16x4 l0 = tr_read<v_rd_off(D0, 0, 0)>(vb), h0 = tr_read<v_rd_off(D0, 0, 1)>(vb), l1 = tr_read<v_rd_off(D0, 1, 0)>(vb), h1 = tr_read<v_rd_off(D0, 1, 1)>(vb);
  const s16x4 l2 = tr_read<v_rd_off(D0, 2, 0)>(vb), h2 = tr_read<v_rd_off(D0, 2, 1)>(vb), l3 = tr_read<v_rd_off(D0, 3, 0)>(vb), h3 = tr_read<v_rd_off(D0, 3, 1)>(vb);
  asm volatile("s_waitcnt lgkmcnt(0)" ::: "memory"); SBAR();
#define PK(L, H) (bf16x8){L[0], L[1], L[2], L[3], H[0], H[1], H[2], H[3]}
  od = __builtin_amdgcn_mfma_f32_32x32x16_bf16(pa0, PK(l0, h0), od, 0, 0, 0);
  od = __builtin_amdgcn_mfma_f32_32x32x16_bf16(pa1, PK(l1, h1), od, 0, 0, 0);
  od = __builtin_amdgcn_mfma_f32_32x32x16_bf16(pa2, PK(l2, h2), od, 0, 0, 0);
  od = __builtin_amdgcn_mfma_f32_32x32x16_bf16(pa3, PK(l3, h3), od, 0, 0, 0);
#undef PK
}
__device__ __forceinline__ void pv_d0(f32x16* o, int vb, bf16x8 pa0, bf16x8 pa1, bf16x8 pa2, bf16x8 pa3) {
  pv_one<0>(o[0], vb, pa0, pa1, pa2, pa3); pv_one<1>(o[1], vb, pa0, pa1, pa2, pa3); pv_one<2>(o[2], vb, pa0, pa1, pa2, pa3); pv_one<3>(o[3], vb, pa0, pa1, pa2, pa3);
}

struct Item { int qrow0, qpos0, qcol, gcol, kcol, vcol, n0, r0, r1, NT, kp1, masked, normq, has_sink; float sinkv; };

template <bool MASKED>
__device__ __forceinline__ void attn_item(bf16_t* __restrict__ P, const Item it, const float* __restrict__ qnw, const f32x2* __restrict__ rope, char* lds, const int tid, const bool dry) {
  const int wid = tid >> 6, lane = tid & 63, r32 = lane & 31, hi = lane >> 5;
  constexpr int NBUF = 3;
  char* V_lds = lds; char* K_lds = lds + NBUF * SHM_V;
  float* ws = (float*)(lds + NBUF * (SHM_V + SHM_K)) + wid * 64; float* li_l = ws; float* al_l = ws + 32;
  float m_reg = -1e30f, l_reg = 0; constexpr int NQ = MASKED ? NQR : NQR_U;
  f32x16 o[4] = {}; bf16x8 qr[NQ > 0 ? NQ : 1]; char* ql = lds + NBUF * (SHM_V + SHM_K) + 2048 + tid * 16;
  const int qrow = it.qrow0 + wid * QBLK + r32;
  const int vb0 = (int)(uintptr_t)V_lds + v_rd_base(lane);
  const int widu = __builtin_amdgcn_readfirstlane(wid);
  unsigned koffs[2], voffs[2];
#pragma unroll
  for (int i = 0; i < 2; ++i) { const int ci = (wid * 2 + i) * 64 + lane;
    { const int row = ci >> 4, cc = (ci & 15) ^ (row & 7); koffs[i] = (unsigned)(row * LDP + cc * 8); }
    { const int sub = ci >> 5, kk = (sub >> 2) * 8 + ((ci & 31) >> 2), k = (kk & ~0xC) | ((kk & 4) << 1) | ((kk & 8) >> 1), cv = (sub & 3) * 32 + (ci & 3) * 8; voffs[i] = (unsigned)(k * LDP + cv); } }
#define ALAS __attribute__((address_space(3)))
#define TROW(t) ((size_t)((t) < it.n0 ? it.r0 + 64 * (t) : it.r1 + 64 * ((t) - it.n0)))
#define DMA(t, b) do { const bf16_t* gb_ = P + TROW(t) * LDP; _Pragma("unroll") for (int i_ = 0; i_ < 2; ++i_) {                                  \
    __builtin_amdgcn_global_load_lds((const unsigned*)(gb_ + it.kcol + koffs[i_]), (ALAS unsigned*)(K_lds + (b) * SHM_K + (widu * 2 + i_) * 1024), 16, 0, 0); \
    __builtin_amdgcn_global_load_lds((const unsigned*)(gb_ + it.vcol + voffs[i_]), (ALAS unsigned*)(V_lds + (b) * SHM_V + (widu * 2 + i_) * 1024), 16, 0, 0); } } while (0)
#define LANDED() do { asm volatile("s_waitcnt vmcnt(0)" ::: "memory"); __builtin_amdgcn_s_barrier(); asm volatile("" ::: "memory"); } while (0)
#define RESC(a) do { if (__any((a) < 1.f)) { if (hi == 0) al_l[r32] = (a); asm volatile("s_waitcnt lgkmcnt(0)" ::: "memory"); \
    _Pragma("unroll") for (int d = 0; d < 4; ++d) _Pragma("unroll") for (int r = 0; r < 16; ++r) o[d][r] *= al_l[crow(r, hi)]; } } while (0)
#define WMASK(pa, pb, t) do { if constexpr (MASKED) { if ((t) >= it.n0) wmask(pa, pb, it.kp1 + 64 * ((t) - it.n0), pos_q, hi); } } while (0)
  const int pos_q = it.qpos0 + wid * QBLK + r32;
  f32x16 pA0, pA1, pB0, pB1; float mnA, mnB, alA, alB; bf16x8 pa0, pa1, pa2, pa3; const int NT = it.NT;
  DMA(0, 0); DMA(1, 1);
  {
    const bf16_t* Qw = P + (size_t)qrow * LDP + it.qcol + hi * 8;
    bf16x8 raw[8];
#pragma unroll
    for (int d0 = 0; d0 < 8; ++d0) raw[d0] = *reinterpret_cast<const bf16x8*>(Qw + d0 * 16);
    float rs = 1.f;
    if (it.normq) { float ssq = 0.f;
#pragma unroll
      for (int d0 = 0; d0 < 8; ++d0)
#pragma unroll
        for (int j = 0; j < 8; ++j) { const float v = bf2f((unsigned short)raw[d0][j]); ssq += v * v; }
      ssq += __shfl_xor(ssq, 32);
      rs = rsqrtf(ssq * (1.f / 128.f) + EPS_); }
    const int pos = it.qpos0 + wid * QBLK + r32;
#pragma unroll
    for (int d0 = 0; d0 < 8; ++d0) {
      float v[8];
#pragma unroll
      for (int j = 0; j < 8; ++j) v[j] = bf2f((unsigned short)raw[d0][j]);
      if (it.normq) { const f32x4 w0 = *(const f32x4*)(qnw + d0 * 16 + hi * 8), w1 = *(const f32x4*)(qnw + d0 * 16 + hi * 8 + 4);
#pragma unroll
        for (int j = 0; j < 4; ++j) { v[j] *= rs * w0[j]; v[4 + j] *= rs * w1[j]; } }
      if (it.qpos0 >= 0) { const int tab = d0 < 4 ? (pos >> 6) : (pos & 63); const f32x4* tp = (const f32x4*)(rope + tab * 32 + (d0 & 3) * 8 + hi * 4);
        const f32x4 c01 = tp[0], c23 = tp[1];
        float x0, x1;
        x0 = v[0]; x1 = v[1]; v[0] = x0 * c01[0] - x1 * c01[1]; v[1] = x0 * c01[1] + x1 * c01[0];
        x0 = v[2]; x1 = v[3]; v[2] = x0 * c01[2] - x1 * c01[3]; v[3] = x0 * c01[3] + x1 * c01[2];
        x0 = v[4]; x1 = v[5]; v[4] = x0 * c23[0] - x1 * c23[1]; v[5] = x0 * c23[1] + x1 * c23[0];
        x0 = v[6]; x1 = v[7]; v[6] = x0 * c23[2] - x1 * c23[3]; v[7] = x0 * c23[3] + x1 * c23[2]; }
      u32x4 w = {cvtpk(v[0], v[1]), cvtpk(v[2], v[3]), cvtpk(v[4], v[5]), cvtpk(v[6], v[7])};
      if (d0 < NQ) qr[d0 < NQ ? d0 : 0] = *reinterpret_cast<bf16x8*>(&w); else *reinterpret_cast<u32x4*>(ql + (d0 - NQ) * 8192) = w;
    }
  }
  LANDED();
  qkt<NQ>(pA0, pA1, K_lds, qr, ql, r32, hi); WMASK(pA0, pA1, 0); partialSM(pA0, pA1, m_reg, mnA, alA);
  int b = 1, bp = 0, bn = 2;
  for (int t = 1; t + 1 < NT; t += 2) {
    DMA(t + 1, bn);
    SBAR(); qkt<NQ>(pB0, pB1, K_lds + b * SHM_K, qr, ql, r32, hi); WMASK(pB0, pB1, t);
    finishSM(pA0, pA1, alA, l_reg, pa0, pa1, pa2, pa3); SBAR();
    pv_d0(o, vb0 + bp * (int)SHM_V, pa0, pa1, pa2, pa3); partialSM(pB0, pB1, m_reg, mnB, alB);
    RESC(alB); LANDED();
    bp = b; b = bn; bn = bn == 2 ? 0 : bn + 1;
    DMA(t + 2, bn);
    SBAR(); qkt<NQ>(pA0, pA1, K_lds + b * SHM_K, qr, ql, r32, hi); WMASK(pA0, pA1, t + 1);
    finishSM(pB0, pB1, alB, l_reg, pa0, pa1, pa2, pa3); SBAR();
    pv_d0(o, vb0 + bp * (int)SHM_V, pa0, pa1, pa2, pa3); partialSM(pA0, pA1, m_reg, mnA, alA);
    RESC(alA); LANDED();
    bp = b; b = bn; bn = bn == 2 ? 0 : bn + 1;
  }
  SBAR(); qkt<NQ>(pB0, pB1, K_lds + b * SHM_K, qr, ql, r32, hi); WMASK(pB0, pB1, NT - 1);
  finishSM(pA0, pA1, alA, l_reg, pa0, pa1, pa2, pa3); SBAR();
  pv_d0(o, vb0 + bp * (int)SHM_V, pa0, pa1, pa2, pa3); partialSM(pB0, pB1, m_reg, mnB, alB);
  RESC(alB);
  finishSM(pB0, pB1, alB, l_reg, pa0, pa1, pa2, pa3); SBAR();
  pv_d0(o, vb0 + b * (int)SHM_V, pa0, pa1, pa2, pa3);
  if (it.has_sink) { constexpr float C = SCALE * 1.4426950408889634f; l_reg += __builtin_amdgcn_exp2f(it.sinkv * 1.4426950408889634f - m_reg * C); }
  if (hi == 0) li_l[r32] = l_reg; asm volatile("s_waitcnt lgkmcnt(0)" ::: "memory");
  float rli[16];
#pragma unroll
  for (int r = 0; r < 16; ++r) rli[r] = __builtin_amdgcn_rcpf(li_l[crow(r, hi)]);
  bf16_t* Ow = P + (size_t)(it.qrow0 + wid * QBLK) * LDP;
  __syncthreads();
  {
    char* T = lds + wid * 12288;
#pragma unroll
    for (int r = 0; r < 16; ++r) { const int orow = crow(r, hi);
#pragma unroll
      for (int d0 = 0; d0 < 4; ++d0) *(unsigned short*)(T + orow * 272 + (d0 * 32 + r32) * 2) = f2bf(o[d0][r] * rli[r]); }
    asm volatile("s_waitcnt lgkmcnt(0)" ::: "memory");
    u32x4 gv[8];
#pragma unroll
    for (int k = 0; k < 8; ++k) { const int ci = k * 64 + lane; gv[k] = *(const u32x4*)(Ow + (size_t)(ci >> 4) * LDP + it.gcol + (ci & 15) * 8); }
#pragma unroll
    for (int k = 0; k < 8; ++k) { const int ci = k * 64 + lane; const u32x4 tv = *(const u32x4*)(T + (ci >> 4) * 272 + (ci & 15) * 16); const u32x4 g = gv[k];
      u32x4 w;
      w.x = cvtpk(bflo(tv.x) * silu_f(bflo(g.x)), bfhi(tv.x) * silu_f(bfhi(g.x))); w.y = cvtpk(bflo(tv.y) * silu_f(bflo(g.y)), bfhi(tv.y) * silu_f(bfhi(g.y)));
      w.z = cvtpk(bflo(tv.z) * silu_f(bflo(g.z)), bfhi(tv.z) * silu_f(bfhi(g.z))); w.w = cvtpk(bflo(tv.w) * silu_f(bflo(g.w)), bfhi(tv.w) * silu_f(bfhi(g.w)));
      if (!dry) *(u32x4*)(Ow + (size_t)(ci >> 4) * LDP + it.qcol + (ci & 15) * 8) = w; }
  }
  __syncthreads();
#undef TROW
#undef DMA
#undef LANDED
#undef RESC
#undef WMASK
}
}

struct Ctx {
    int tid, lane, wave, gw, ngw;
    char* lds;
};
#define LDS_WAIT() asm volatile("s_waitcnt lgkmcnt(0)" ::: "memory")

__device__ __forceinline__ void transpose_item(const float* __restrict__ W, int K, int Ntot, int src0, bf16_t* __restrict__ WT, int dst0, int ncols, float* scr, int item, int lane) {
    const int nblk = ncols / 32, kb = item / nblk, nb = item % nblk, k0 = 64 * kb, n0 = 32 * nb;
#pragma unroll 8
    for (int i = 0; i < 32; ++i) { const int kk = 2 * i + (lane >> 5); scr[kk * 33 + (lane & 31)] = __builtin_nontemporal_load(W + (size_t)(k0 + kk) * Ntot + src0 + n0 + (lane & 31)); }
    LDS_WAIT(); asm volatile("" ::: "memory");
    const int c = lane & 7;
#pragma unroll
    for (int j = 0; j < 4; ++j) { const int n = (lane >> 3) + 8 * j; const float* s = scr + (8 * c) * 33 + n;
        u32x4 o; o.x = cvtpk(s[0 * 33], s[1 * 33]); o.y = cvtpk(s[2 * 33], s[3 * 33]); o.z = cvtpk(s[4 * 33], s[5 * 33]); o.w = cvtpk(s[6 * 33], s[7 * 33]);
        *(u32x4*)(WT + (size_t)(dst0 + n0 + n) * K + k0 + 8 * c) = o; }
    LDS_WAIT(); asm volatile("" ::: "memory");
}
__device__ __forceinline__ void convert_weights(const Ctx& c, int l, const float* attn_w_in, const float* attn_w_out, const float* ssm_w_in, const float* ssm_w_out, bf16_t* W1, bf16_t* W2) {
    float* scr = (float*)(c.lds + c.wave * 16384);
    const int i = l >> 1;
    if ((l & 1) == 0) {
        const float* Wi = attn_w_in + (size_t)i * DM * AIN; const float* Wo = attn_w_out + (size_t)i * AW * DM;
        constexpr int I_IN = (DM / 64) * (AIN / 32), I_OUT = (AW / 64) * (DM / 32);
        for (int it = c.gw; it < I_IN + I_OUT; it += c.ngw) {
            if (it < I_IN) {
                const int kb = it / (AIN / 32), nbg = it % (AIN / 32), scol = nbg * 32;
                int src0, ncols, dst0;
                if (scol < 1024) { src0 = 0; ncols = 1024; dst0 = PC_QA; }
                else if (scol < 1280) { src0 = 1024; ncols = 256; dst0 = PC_KA; }
                else if (scol < 1536) { src0 = 1280; ncols = 256; dst0 = PC_VA; }
                else if (scol < 2560) { src0 = 1536; ncols = 1024; dst0 = PC_GA; }
                else if (scol < 3584) { src0 = 2560; ncols = 1024; dst0 = PC_QB; }
                else if (scol < 3840) { src0 = 3584; ncols = 256; dst0 = PC_KB; }
                else if (scol < 4096) { src0 = 3840; ncols = 256; dst0 = PC_VB; }
                else { src0 = 4096; ncols = 1024; dst0 = PC_GB; }
                const int nb = (scol - src0) / 32;
                transpose_item(Wi, DM, AIN, src0, W1, dst0, ncols, scr, kb * (ncols / 32) + nb, c.lane);
            } else transpose_item(Wo, AW, DM, 0, W2, 0, DM, scr, it - I_IN, c.lane);
        }
    } else {
        constexpr int SIN = 6208;
        const float* Wi = ssm_w_in + (size_t)i * DM * SIN; const float* Wo = ssm_w_out + (size_t)i * DI * DM;
        constexpr int I_IN = (DM / 64) * (SIN / 32), I_OUT = (DI / 64) * (DM / 32);
        for (int it = c.gw; it < I_IN + I_OUT; it += c.ngw) {
            if (it < I_IN) {
                const int kb = it / (SIN / 32), nbg = it % (SIN / 32), scol = nbg * 32;
                int src0, ncols, dst0;
                if (scol < 2048) { src0 = 0; ncols = 2048; dst0 = NXB; }
                else if (scol < 6144) { src0 = 2048; ncols = 4096; dst0 = 0; }
                else { src0 = 6144; ncols = 64; dst0 = 4096; }
                const int nb = (scol - src0) / 32;
                transpose_item(Wi, DM, SIN, src0, W1, dst0, ncols, scr, kb * (ncols / 32) + nb, c.lane);
            } else transpose_item(Wo, DI, DM, 0, W2, 0, DM, scr, it - I_IN, c.lane);
        }
    }
}

__device__ __forceinline__ void adaln_phase(const Ctx& c, const float* cvec, const float* cctx, const float* w_ada, const float* b_ada, float* MOD) {
    float* sv = (float*)c.lds;
    float* red = (float*)(c.lds + 5 * 1024 * 4);
    bool have = false;
    for (int it = blockIdx.x; it < DEPTH_ * 48; it += gridDim.x) {
        if (!have) { for (int e = c.tid; e < 5 * 1024; e += 512) { const float v = e < 4096 ? cvec[e] : cctx[e - 4096]; sv[e] = silu_f(v); } have = true; __syncthreads(); }
        const int l = it / 48, col = (it % 48) * 64 + c.lane;
        const float* wp = w_ada + ((size_t)l * DM + c.wave * 128) * 3072 + col;
        float a0 = 0, a1 = 0, a2 = 0, a3 = 0, a4 = 0;
#pragma unroll 8
        for (int k = 0; k < 128; ++k) { const float w = __builtin_nontemporal_load(wp + (size_t)k * 3072); const int kk = c.wave * 128 + k;
            a0 += sv[kk] * w; a1 += sv[1024 + kk] * w; a2 += sv[2048 + kk] * w; a3 += sv[3072 + kk] * w; a4 += sv[4096 + kk] * w; }
        float* rp = red + (c.wave * 5) * 64 + c.lane;
        rp[0] = a0; rp[64] = a1; rp[128] = a2; rp[192] = a3; rp[256] = a4;
        __syncthreads();
        if (c.tid < 320) { const int who = c.tid >> 6, ln = c.tid & 63; float s = b_ada[(size_t)l * 3072 + (it % 48) * 64 + ln];
#pragma unroll
            for (int w = 0; w < 8; ++w) s += red[(w * 5 + who) * 64 + ln];
            MOD[((size_t)l * 5 + who) * 3072 + (it % 48) * 64 + ln] = s; }
        __syncthreads();
    }
}
__device__ __forceinline__ void rope_phase(const Ctx& c, f32x2* rope) {
    for (int e = blockIdx.x * 512 + c.tid; e < 128 * 32; e += gridDim.x * 512) { const int pos = e >> 5, f = e & 31;
        const float inv = 1.0f / powf(10000.0f, (float)f / 32.0f); const float ang = (float)pos * inv;
        rope[e] = (f32x2){cosf(ang), sinf(ang)}; }
}

__device__ __forceinline__ void norm_pass(const Ctx& c, int l, const float* xin, float* xout, const float* cin, float* cout, bf16_t* HY, const float* MOD, const float* norm_pre, const float* norm_post, bool do_ctx, const bool dry) {
    const bool have_y = l >= 0, have_h = l + 1 < DEPTH_;
    const int nchunks = MLAT / 16 + (do_ctx ? MCTX : 0);
    for (int ch = c.gw; ch < nchunks; ch += c.ngw) {
        const bool isctx = ch >= MLAT / 16; const int row0 = isctx ? (ch - MLAT / 16) : ch * 16; const int who = isctx ? 4 : (row0 / T_); const int nrow = isctx ? 1 : 16;
        const float* xi = isctx ? cin : xin; float* xo = isctx ? cout : xout; const int hrow0 = isctx ? MLAT + row0 : row0;
        f32x4 A1[4], A2[4], A3[4];
#pragma unroll
        for (int j = 0; j < 4; ++j) { const int col = 4 * c.lane + 256 * j;
            if (have_y) { const f32x4 gt = *(const f32x4*)(MOD + ((size_t)l * 5 + who) * 3072 + 2048 + col); const f32x4 pw = *(const f32x4*)(norm_post + (size_t)l * DM + col); A1[j] = gt * pw; }
            if (have_h) { const f32x4 sh = *(const f32x4*)(MOD + ((size_t)(l + 1) * 5 + who) * 3072 + col), sc = *(const f32x4*)(MOD + ((size_t)(l + 1) * 5 + who) * 3072 + 1024 + col);
                const f32x4 pw = *(const f32x4*)(norm_pre + (size_t)(l + 1) * DM + col); A2[j] = pw * (sc + 1.0f); A3[j] = sh; } }
        f32x4 nx[4]; u32x2 ny[4];
#pragma unroll
        for (int j = 0; j < 4; ++j) { nx[j] = __builtin_nontemporal_load((const f32x4*)(xi + (size_t)row0 * DM + 4 * c.lane + 256 * j)); if (have_y) ny[j] = __builtin_nontemporal_load((const u32x2*)(HY + (size_t)hrow0 * DM + 4 * c.lane + 256 * j)); }
        for (int r = 0; r < nrow; ++r) {
            const size_t xoff = (size_t)(row0 + r) * DM, hoff = (size_t)(hrow0 + r) * DM;
            f32x4 x[4]; u32x2 yw[4];
#pragma unroll
            for (int j = 0; j < 4; ++j) { x[j] = nx[j]; yw[j] = ny[j]; }
            if (r + 1 < nrow) {
#pragma unroll
                for (int j = 0; j < 4; ++j) { nx[j] = __builtin_nontemporal_load((const f32x4*)(xi + xoff + DM + 4 * c.lane + 256 * j)); if (have_y) ny[j] = __builtin_nontemporal_load((const u32x2*)(HY + hoff + DM + 4 * c.lane + 256 * j)); } }
            if (have_y) {
                f32x4 y[4]; float ssq = 0.f;
#pragma unroll
                for (int j = 0; j < 4; ++j) { const u32x2 w = yw[j]; y[j] = (f32x4){bflo(w.x), bfhi(w.x), bflo(w.y), bfhi(w.y)};
                    ssq += (y[j][0] * y[j][0] + y[j][1] * y[j][1]) + (y[j][2] * y[j][2] + y[j][3] * y[j][3]); }
                const float rs = rsqrtf(wave_sum(ssq) * (1.f / DM) + EPS_);
#pragma unroll
                for (int j = 0; j < 4; ++j) { x[j] = x[j] + A1[j] * (y[j] * rs); if (!dry) __builtin_nontemporal_store(x[j], (f32x4*)(xo + xoff + 4 * c.lane + 256 * j)); }
            }
            if (have_h) {
                float ssq = 0.f;
#pragma unroll
                for (int j = 0; j < 4; ++j) ssq += (x[j][0] * x[j][0] + x[j][1] * x[j][1]) + (x[j][2] * x[j][2] + x[j][3] * x[j][3]);
                const float rs = rsqrtf(wave_sum(ssq) * (1.f / DM) + EPS_);
#pragma unroll
                for (int j = 0; j < 4; ++j) { const f32x4 h = x[j] * rs * A2[j] + A3[j]; u32x2 w; w.x = cvtpk(h[0], h[1]); w.y = cvtpk(h[2], h[3]); if (!dry) *(u32x2*)(HY + hoff + 4 * c.lane + 256 * j) = w; }
            }
        }
    }
}

__device__ __forceinline__ void kprep_pass(const Ctx& c, bf16_t* P, const float* knw, const f32x2* rope, const bool dry) {
    const int hsel = c.lane >> 4, e0 = (c.lane & 15) * 8;
    const int col = (hsel < 2 ? PC_KA + hsel * 128 : PC_KB + (hsel - 2) * 128) + e0;
    const f32x4 w0 = *(const f32x4*)(knw + e0), w1 = *(const f32x4*)(knw + e0 + 4);
    for (int row0 = c.gw; row0 < MTOT; row0 += 2 * c.ngw) {
        const int row1 = row0 + c.ngw; const bool two = row1 < MTOT;
        const u32x4 rawA = *(const u32x4*)(P + (size_t)row0 * AIN + col);
        const u32x4 rawB = two ? *(const u32x4*)(P + (size_t)row1 * AIN + col) : (u32x4){0u, 0u, 0u, 0u};
#pragma unroll
        for (int half = 0; half < 2; ++half) {
        if (half == 1 && !two) break;
        const int row = half ? row1 : row0; const u32x4 raw = half ? rawB : rawA;
        bf16_t* p = P + (size_t)row * AIN + col;
        float v[8] = {bflo(raw.x), bfhi(raw.x), bflo(raw.y), bfhi(raw.y), bflo(raw.z), bfhi(raw.z), bflo(raw.w), bfhi(raw.w)};
        if (hsel >= 2) { float ssq = 0.f;
#pragma unroll
            for (int j = 0; j < 8; ++j) ssq += v[j] * v[j];
            ssq += __shfl_xor(ssq, 1); ssq += __shfl_xor(ssq, 2); ssq += __shfl_xor(ssq, 4); ssq += __shfl_xor(ssq, 8);
            const float rs = rsqrtf(ssq * (1.f / 128.f) + EPS_);
#pragma unroll
            for (int j = 0; j < 4; ++j) { v[j] *= rs * w0[j]; v[4 + j] *= rs * w1[j]; } }
        if (row < MLAT) { const int pos = row & (T_ - 1), i0 = e0 >> 1; const int tab = i0 < 32 ? (pos >> 6) : (pos & 63);
            const f32x4* tp = (const f32x4*)(rope + tab * 32 + (i0 & 31)); const f32x4 c01 = tp[0], c23 = tp[1];
            float x0, x1;
            x0 = v[0]; x1 = v[1]; v[0] = x0 * c01[0] - x1 * c01[1]; v[1] = x0 * c01[1] + x1 * c01[0];
            x0 = v[2]; x1 = v[3]; v[2] = x0 * c01[2] - x1 * c01[3]; v[3] = x0 * c01[3] + x1 * c01[2];
            x0 = v[4]; x1 = v[5]; v[4] = x0 * c23[0] - x1 * c23[1]; v[5] = x0 * c23[1] + x1 * c23[0];
            x0 = v[6]; x1 = v[7]; v[6] = x0 * c23[2] - x1 * c23[3]; v[7] = x0 * c23[3] + x1 * c23[2]; }
        if (!dry && (hsel >= 2 || row < MLAT)) { u32x4 w = {cvtpk(v[0], v[1]), cvtpk(v[2], v[3]), cvtpk(v[4], v[5]), cvtpk(v[6], v[7])}; *(u32x4*)p = w; }
        }
    }
}

__device__ __forceinline__ void conv_pass(const Ctx& c, bf16_t* X, const bf16_t* halo, const float* cw, const float* cb, const bool dry) {
    for (int u = blockIdx.x; u < (MTOT / 128) * 4; u += gridDim.x) {
        const int ck = u >> 2, q = u & 3, strip = c.tid & 127, rg = c.tid >> 7, col = q * 1024 + strip * 8, row0 = ck * 128 + rg * 32;
        const bool seq_start = ck < 256 ? (ck & 63) == 0 : ((ck - 256) & 1) == 0, seq_end = ck < 256 ? (ck & 63) == 63 : ((ck - 256) & 1) == 1;
        float w0[8], w1[8], w2[8], bs[8];
#pragma unroll
        for (int j = 0; j < 8; ++j) { w0[j] = cw[col + j]; w1[j] = cw[CONVD + col + j]; w2[j] = cw[2 * CONVD + col + j]; bs[j] = cb[col + j]; }
        u32x4 prev = {0u, 0u, 0u, 0u}, last = {0u, 0u, 0u, 0u};
        if (rg == 0) { if (!seq_start) prev = *(const u32x4*)(halo + ((size_t)(ck - 1) * 2 + 1) * CONVD + col); } else prev = *(const u32x4*)(X + (size_t)(row0 - 1) * CONVD + col);
        if (rg == 3) { if (!seq_end) last = *(const u32x4*)(halo + ((size_t)(ck + 1) * 2 + 0) * CONVD + col); } else last = *(const u32x4*)(X + (size_t)(row0 + 32) * CONVD + col);
        u32x4 cur = *(const u32x4*)(X + (size_t)row0 * CONVD + col);
        asm volatile("s_waitcnt vmcnt(0)" ::: "memory");
        __syncthreads();
        for (int ib = 0; ib < 4; ++ib) {
            u32x4 nx[8];
#pragma unroll
            for (int i = 0; i < 8; ++i) { const int r = ib * 8 + i + 1; nx[i] = (r < 32) ? *(const u32x4*)(X + (size_t)(row0 + r) * CONVD + col) : last; }
#pragma unroll
            for (int i = 0; i < 8; ++i) {
                const u32x4 n = nx[i];
                const float pv[8] = {bflo(prev.x), bfhi(prev.x), bflo(prev.y), bfhi(prev.y), bflo(prev.z), bfhi(prev.z), bflo(prev.w), bfhi(prev.w)};
                const float cv[8] = {bflo(cur.x), bfhi(cur.x), bflo(cur.y), bfhi(cur.y), bflo(cur.z), bfhi(cur.z), bflo(cur.w), bfhi(cur.w)};
                const float nv[8] = {bflo(n.x), bfhi(n.x), bflo(n.y), bfhi(n.y), bflo(n.z), bfhi(n.z), bflo(n.w), bfhi(n.w)};
                float o[8];
#pragma unroll
                for (int j = 0; j < 8; ++j) o[j] = silu_f(bs[j] + w0[j] * pv[j] + w1[j] * cv[j] + w2[j] * nv[j]);
                u32x4 w = {cvtpk(o[0], o[1]), cvtpk(o[2], o[3]), cvtpk(o[4], o[5]), cvtpk(o[6], o[7])};
                if (!dry) *(u32x4*)(X + (size_t)(row0 + ib * 8 + i) * CONVD + col) = w;
                prev = cur; cur = n;
            }
        }
        asm volatile("s_waitcnt vmcnt(0)" ::: "memory");
        __syncthreads();
    }
}

__device__ __forceinline__ void gnorm_pass(const Ctx& c, bf16_t* Y, const bf16_t* Z, const float* nw, const int nrows, const bool dry) {
    f32x4 w[8];
#pragma unroll
    for (int j = 0; j < 8; ++j) w[j] = *(const f32x4*)(nw + 256 * j + 4 * c.lane);
    for (int row = c.gw; row < nrows; row += c.ngw) {
        const size_t off = (size_t)row * DI + 4 * c.lane;
        u32x2 yv[8], zv[8];
#pragma unroll
        for (int j = 0; j < 8; ++j) { yv[j] = *(const u32x2*)(Y + off + 256 * j); zv[j] = *(const u32x2*)(Z + off + 256 * j); }
#pragma unroll
        for (int j = 0; j < 8; ++j) {
            f32x4 g = {bflo(yv[j].x) * silu_f(bflo(zv[j].x)), bfhi(yv[j].x) * silu_f(bfhi(zv[j].x)), bflo(yv[j].y) * silu_f(bflo(zv[j].y)), bfhi(yv[j].y) * silu_f(bfhi(zv[j].y))};
            const float ssq = wave_sum((g[0] * g[0] + g[1] * g[1]) + (g[2] * g[2] + g[3] * g[3]));
            const float rs = rsqrtf(ssq * (1.f / 256.f) + EPS_);
            g = g * rs * w[j];
            u32x2 o; o.x = cvtpk(g[0], g[1]); o.y = cvtpk(g[2], g[3]); if (!dry) *(u32x2*)(Y + off + 256 * j) = o;
        }
    }
}

namespace ssd {
constexpr int RS = 272;
constexpr int O_CN = 0, O_BN = 34816, O_GP = 69632, O_XDT = 104448, O_XW = 112640, O_XN = 120832, O_HS = 129024, O_CUM = 137728, LDS_SSD = O_CUM + 1024;
#define MF32(a, b, c) __builtin_amdgcn_mfma_f32_32x32x16_bf16(a, b, c, 0, 0, 0)
#define PK8(L, H) (bf16x8){L[0], L[1], L[2], L[3], H[0], H[1], H[2], H[3]}
__device__ __forceinline__ u32x2 pack4(float a, float b, float c, float d) { u32x2 w; w.x = cvtpk(a, b); w.y = cvtpk(c, d); return w; }


#define RDL(x, n) __uint_as_float((unsigned)__builtin_amdgcn_readlane((int)__float_as_uint(x), (n)))
__device__ __forceinline__ float wave_scan_incl(float v, int lane) {
#define DPP_SHR(x, n) __uint_as_float((unsigned)__builtin_amdgcn_update_dpp(0, (int)__float_as_uint(x), 0x110 + (n), 0xf, 0xf, true))
    v += DPP_SHR(v, 1); v += DPP_SHR(v, 2); v += DPP_SHR(v, 4); v += DPP_SHR(v, 8);
#undef DPP_SHR
    const float t0 = RDL(v, 15), t1 = RDL(v, 31), t2 = RDL(v, 47);
    const int row = lane >> 4;
    v += row == 1 ? t0 : row == 2 ? t0 + t1 : row == 3 ? (t0 + t1) + t2 : 0.f;
    return v;
}
template <int KK0> __device__ __forceinline__ void state_steps(f32x16& S, int base_b, int base_w) {
    using att::tr_read;
    const s16x4 a0l = tr_read<(KK0 + 0) * 16 * RS>(base_b), a0h = tr_read<(KK0 + 0) * 16 * RS + 4 * RS>(base_b), a1l = tr_read<(KK0 + 1) * 16 * RS>(base_b), a1h = tr_read<(KK0 + 1) * 16 * RS + 4 * RS>(base_b);
    const s16x4 a2l = tr_read<(KK0 + 2) * 16 * RS>(base_b), a2h = tr_read<(KK0 + 2) * 16 * RS + 4 * RS>(base_b), a3l = tr_read<(KK0 + 3) * 16 * RS>(base_b), a3h = tr_read<(KK0 + 3) * 16 * RS + 4 * RS>(base_b);
    const s16x4 b0l = tr_read<(KK0 + 0) * 1024>(base_w), b0h = tr_read<(KK0 + 0) * 1024 + 256>(base_w), b1l = tr_read<(KK0 + 1) * 1024>(base_w), b1h = tr_read<(KK0 + 1) * 1024 + 256>(base_w);
    const s16x4 b2l = tr_read<(KK0 + 2) * 1024>(base_w), b2h = tr_read<(KK0 + 2) * 1024 + 256>(base_w), b3l = tr_read<(KK0 + 3) * 1024>(base_w), b3h = tr_read<(KK0 + 3) * 1024 + 256>(base_w);
    asm volatile("s_waitcnt lgkmcnt(0)" ::: "memory"); SBAR();
    S = MF32(PK8(a0l, a0h), PK8(b0l, b0h), S); S = MF32(PK8(a1l, a1h), PK8(b1l, b1h), S);
    S = MF32(PK8(a2l, a2h), PK8(b2l, b2h), S); S = MF32(PK8(a3l, a3h), PK8(b3l, b3h), S);
}
template <int KK0> __device__ __forceinline__ void ydiag_steps(f32x16& acc, int base_x, const char* gp_row) {
    using att::tr_read;
    const s16x4 a0l = tr_read<(KK0 + 0) * 1024>(base_x), a0h = tr_read<(KK0 + 0) * 1024 + 256>(base_x), a1l = tr_read<(KK0 + 1) * 1024>(base_x), a1h = tr_read<(KK0 + 1) * 1024 + 256>(base_x);
    const s16x4 a2l = tr_read<(KK0 + 2) * 1024>(base_x), a2h = tr_read<(KK0 + 2) * 1024 + 256>(base_x), a3l = tr_read<(KK0 + 3) * 1024>(base_x), a3h = tr_read<(KK0 + 3) * 1024 + 256>(base_x);
    asm volatile("s_waitcnt lgkmcnt(0)" ::: "memory"); SBAR();
    const bf16x8 b0 = *(const bf16x8*)(gp_row + (KK0 + 0) * 32), b1 = *(const bf16x8*)(gp_row + (KK0 + 1) * 32), b2 = *(const bf16x8*)(gp_row + (KK0 + 2) * 32), b3 = *(const bf16x8*)(gp_row + (KK0 + 3) * 32);
    acc = MF32(PK8(a0l, a0h), b0, acc); acc = MF32(PK8(a1l, a1h), b1, acc); acc = MF32(PK8(a2l, a2h), b2, acc); acc = MF32(PK8(a3l, a3h), b3, acc);
}

__device__ __forceinline__ void scan_phase(const Ctx& c, const int dir, const bf16_t* __restrict__ X, const float* __restrict__ DT, bf16_t* __restrict__ Y, const float* __restrict__ a_log, const float* __restrict__ dskip, const bool dry, const int pvar) {
    char* L = c.lds; float* cumL = (float*)(L + O_CUM);
    const int tid = c.tid, lane = c.lane, wave = c.wave, r32 = lane & 31, hi = lane >> 5;
    const int blk = (lane >> 4) & 1, qq = (lane & 15) >> 2, pp = lane & 3;
    for (int item = blockIdx.x; item < 256; item += gridDim.x) {
        const int xcd_ = item & 7, slot_ = item >> 3, grp_ = xcd_ + 8 * (slot_ >> 3), mem_ = slot_ & 7;
        const int ph = mem_ & 1, b = grp_ >> 3, g = grp_ & 7, h = 4 * g + (mem_ >> 1);
        const float Acoef = -__expf(a_log[dir * 32 + h]), Dh = dskip[h];
        const int xcol = h * 64 + ph * 32, bcol = 2048 + g * 128, ccol = 3072 + g * 128, dtcol = dir * 32 + h;
        f32x16 S = {};
        bf16x8 rc[4], rb[4], rx; float d0r, d1r;
#define CHUNK_ROW(q) ((q) < 2 ? MLAT + b * CL + (dir == 0 ? (q) : 1 - (q)) * 128 : b * T_ + (dir == 0 ? (q) - 2 : 65 - (q)) * 128)
#define LOADCHUNK(q) do { const int R_ = CHUNK_ROW(q);                                                                         \
        _Pragma("unroll") for (int i = 0; i < 4; ++i) { const size_t ro = (size_t)(R_ + (tid >> 4) + 32 * i) * CONVD + (tid & 15) * 8;     \
            rc[i] = *(const bf16x8*)(X + ro + ccol); rb[i] = *(const bf16x8*)(X + ro + bcol); }                                \
        rx = *(const bf16x8*)(X + (size_t)(R_ + (tid >> 2)) * CONVD + xcol + (tid & 3) * 8);                                    \
        d0r = DT[(size_t)dtcol * MTOT + R_ + lane]; d1r = DT[(size_t)dtcol * MTOT + R_ + 64 + lane]; } while (0)
        LOADCHUNK(0);
        for (int q = 0; q < 66; ++q) {
            const int R0 = CHUNK_ROW(q);
            const float a0 = d0r * Acoef, a1 = d1r * Acoef;
            float p0 = wave_scan_incl(a0, lane), p1 = wave_scan_incl(a1, lane);
            p1 += RDL(p0, 63);
            const float tot = RDL(p1, 63);
            float c0, c1;
            if (dir == 0) { c0 = p0; c1 = p1; } else { c0 = tot - p0 + a0; c1 = tot - p1 + a1; }
            if (wave == 0) { cumL[lane] = c0; cumL[64 + lane] = c1; }
#pragma unroll
            for (int i = 0; i < 4; ++i) { const int off = ((tid >> 4) + 32 * i) * RS + (tid & 15) * 16;
                *(bf16x8*)(L + O_CN + off) = rc[i]; *(bf16x8*)(L + O_BN + off) = rb[i]; }
            {
                const int sl = (tid >> 2) & 63;
                const float dts = __shfl(wave < 4 ? d0r : d1r, sl), cums = __shfl(wave < 4 ? c0 : c1, sl);
                const float wend = dts * __expf(tot - cums);
                float xv[8];
#pragma unroll
                for (int j = 0; j < 8; ++j) xv[j] = bf2f((unsigned short)rx[j]);
                const int xo = (tid >> 2) * 64 + (tid & 3) * 16;
                *(bf16x8*)(L + O_XN + xo) = rx;
                u32x4 w1 = {cvtpk(xv[0] * dts, xv[1] * dts), cvtpk(xv[2] * dts, xv[3] * dts), cvtpk(xv[4] * dts, xv[5] * dts), cvtpk(xv[6] * dts, xv[7] * dts)};
                u32x4 w2 = {cvtpk(xv[0] * wend, xv[1] * wend), cvtpk(xv[2] * wend, xv[3] * wend), cvtpk(xv[4] * wend, xv[5] * wend), cvtpk(xv[6] * wend, xv[7] * wend)};
                *(u32x4*)(L + O_XDT + xo) = w1; *(u32x4*)(L + O_XW + xo) = w2;
            }
            if (q + 1 < 66) LOADCHUNK(q + 1);
            __syncthreads();
            if (!(dry && pvar == 1)) {
            if (wave >= 4) { const int nb = (wave - 4) * 32;
#pragma unroll
                for (int qd = 0; qd < 4; ++qd) *(u32x2*)(L + O_HS + r32 * RS + (nb + 8 * qd + 4 * hi) * 2) = pack4(S[4 * qd], S[4 * qd + 1], S[4 * qd + 2], S[4 * qd + 3]); }
            {
                const int sb = wave >> 1, lb0 = 2 * (wave & 1);
                const char* ap = L + O_BN + (sb * 32 + r32) * RS + hi * 16; const char* bp0 = L + O_CN + (lb0 * 32 + r32) * RS + hi * 16; const char* bp1 = bp0 + 32 * RS;
                bf16x8 fa[8], fb0[8], fb1[8];
#pragma unroll
                for (int kk = 0; kk < 8; ++kk) { fa[kk] = *(const bf16x8*)(ap + kk * 32); fb0[kk] = *(const bf16x8*)(bp0 + kk * 32); fb1[kk] = *(const bf16x8*)(bp1 + kk * 32); }
                f32x16 acc0 = {}, acc1 = {};
#pragma unroll
                for (int kk = 0; kk < 8; ++kk) { acc0 = MF32(fa[kk], fb0[kk], acc0); acc1 = MF32(fa[kk], fb1[kk], acc1); }
#pragma unroll
                for (int tt = 0; tt < 2; ++tt) {
                    const int lb = lb0 + tt, l = lb * 32 + r32; const float cl = cumL[l];
#pragma unroll
                    for (int qd = 0; qd < 4; ++qd) { float v[4];
#pragma unroll
                        for (int e = 0; e < 4; ++e) { const int s_ = sb * 32 + 8 * qd + 4 * hi + e; const float cs = cumL[s_];
                            const float av = tt == 0 ? acc0[4 * qd + e] : acc1[4 * qd + e];
                            const bool valid = dir == 0 ? (s_ <= l) : (s_ >= l); v[e] = valid ? av * __expf(cl - cs) : 0.f; }
                        *(u32x2*)(L + O_GP + l * RS + (sb * 32 + 8 * qd + 4 * hi) * 2) = pack4(v[0], v[1], v[2], v[3]); }
                }
            }
            }
            __syncthreads();
            if (dry && pvar >= 1) { } else
            if (wave < 4) {
                const int l = wave * 32 + r32;
                f32x16 aoff = {}, adg = {};
                bf16_t* yp = Y + (size_t)(R0 + l) * DI + xcol;
                u32x2 pvv[4] = {};
                if (dir == 0) {
#pragma unroll
                    for (int qd = 0; qd < 4; ++qd) pvv[qd] = *(const u32x2*)(yp + 8 * qd + 4 * hi); }
                const char* hp = L + O_HS + r32 * RS + hi * 16; const char* cp = L + O_CN + l * RS + hi * 16;
                {
                    bf16x8 fh[8], fc[8];
#pragma unroll
                    for (int kk = 0; kk < 8; ++kk) { fh[kk] = *(const bf16x8*)(hp + kk * 32); fc[kk] = *(const bf16x8*)(cp + kk * 32); }
#pragma unroll
                    for (int kk = 0; kk < 8; ++kk) aoff = MF32(fh[kk], fc[kk], aoff);
                }
                const int base_x = (int)(uintptr_t)(L + O_XDT) + (8 * hi + qq) * 64 + (16 * blk + 4 * pp) * 2;
                const char* gp_row = L + O_GP + l * RS + hi * 16;
                ydiag_steps<0>(adg, base_x, gp_row); ydiag_steps<4>(adg, base_x, gp_row);
                const float ec = __expf(cumL[l]);
#pragma unroll
                for (int qd = 0; qd < 4; ++qd) { const int pc = 8 * qd + 4 * hi; float v[4];
#pragma unroll
                    for (int e = 0; e < 4; ++e) v[e] = aoff[4 * qd + e] * ec + adg[4 * qd + e];
                    if (dir == 0) { const u32x2 xn = *(const u32x2*)(L + O_XN + l * 64 + pc * 2); const u32x2 pv = pvv[qd];
                        v[0] += Dh * bflo(xn.x) + bflo(pv.x); v[1] += Dh * bfhi(xn.x) + bfhi(pv.x); v[2] += Dh * bflo(xn.y) + bflo(pv.y); v[3] += Dh * bfhi(xn.y) + bfhi(pv.y); }
                    if (!dry) *(u32x2*)(yp + pc) = pack4(v[0], v[1], v[2], v[3]); }
            } else {
                const int nb = (wave - 4) * 32; const float dec = __expf(tot);
#pragma unroll
                for (int r = 0; r < 16; ++r) S[r] *= dec;
                const int base_b = (int)(uintptr_t)(L + O_BN) + (8 * hi + qq) * RS + (nb + 16 * blk + 4 * pp) * 2;
                const int base_w = (int)(uintptr_t)(L + O_XW) + (8 * hi + qq) * 64 + (16 * blk + 4 * pp) * 2;
                state_steps<0>(S, base_b, base_w); state_steps<4>(S, base_b, base_w);
            }
            __syncthreads();
        }
#undef CHUNK_ROW
#undef LOADCHUNK
    }
}
}

constexpr int LDS_BYTES = 163840;
#ifndef PROBE_OP
#define PROBE_OP -1
#endif
struct Args { const float* in[21]; float* out; unsigned char* ws; long probe; };

enum Op { OP_GEMM_BF16 = 0, OP_GEMM_XBC, OP_GEMM_IN, OP_ATTN, OP_CONV, OP_SCAN, OP_GEMM_Z, OP_NORM, OP_PROLOGUE };

__device__ __forceinline__ void attn_phase(const Ctx& c, int li, bf16_t* P, const float* sink, const float* qnw, const f32x2* rope, const bool dry, const int pvar) {
    for (int i = blockIdx.x; i < 2112; i += gridDim.x) {
        att::Item it;
        if (i < 2048) {
            const int ii = i & 1023, x = ii & 7, wi = (ii >> 3) & 31, k = ii >> 8, b = x >> 1, kvh = x & 1, head = kvh * 4 + k, i0 = wi * 256;
            const bool mixB = i < 1024;
            it.qrow0 = b * T_ + i0; it.qpos0 = i0;
            if (mixB) { it.qcol = PC_QB + head * 128; it.gcol = PC_GB + head * 128; it.kcol = PC_KB + kvh * 128; it.vcol = PC_VB + kvh * 128;
                it.n0 = T_ / 64; it.r0 = b * T_; it.r1 = MLAT + b * CL; it.NT = T_ / 64 + CL / 64; it.kp1 = 0; it.masked = 0; it.normq = 1; it.has_sink = 0; it.sinkv = 0.f; }
            else { const int ks = i0 >= 128 ? i0 - 128 : 0, ke = i0 + 384 <= T_ ? i0 + 384 : T_;
                it.qcol = PC_QA + head * 128; it.gcol = PC_GA + head * 128; it.kcol = PC_KA + kvh * 128; it.vcol = PC_VA + kvh * 128;
                it.n0 = CL / 64; it.r0 = MLAT + b * CL; it.r1 = b * T_ + ks; it.NT = CL / 64 + (ke - ks) / 64; it.kp1 = ks; it.masked = 1; it.normq = 0; it.has_sink = 1; it.sinkv = sink[head]; }
        } else {
            const int j = i - 2048, head = j & 7, mixB = (j >> 3) & 1, b = j >> 4, kvh = head >> 2;
            it.qrow0 = MLAT + b * CL; it.qpos0 = -1; it.n0 = CL / 64; it.r0 = MLAT + b * CL; it.r1 = 0; it.NT = CL / 64; it.kp1 = 0; it.masked = 0;
            if (mixB) { it.qcol = PC_QB + head * 128; it.gcol = PC_GB + head * 128; it.kcol = PC_KB + kvh * 128; it.vcol = PC_VB + kvh * 128; it.normq = 1; it.has_sink = 0; it.sinkv = 0.f; }
            else { it.qcol = PC_QA + head * 128; it.gcol = PC_GA + head * 128; it.kcol = PC_KA + kvh * 128; it.vcol = PC_VA + kvh * 128; it.normq = 0; it.has_sink = 1; it.sinkv = sink[head]; }
        }
        if (it.masked) att::attn_item<true>(P, it, qnw, rope, c.lds, c.tid, dry); else att::attn_item<false>(P, it, qnw, rope, c.lds, c.tid, dry);
    }
}

__global__ void __launch_bounds__(512) mega(Args a) {
    extern __shared__ __attribute__((aligned(16))) unsigned char lds_[];
    cg::grid_group grid = cg::this_grid();
    volatile XLAS unsigned* bst = (volatile XLAS unsigned*)((XLAS unsigned char*)lds_ + (LDS_BYTES - 16));
    if (threadIdx.x < 4) bst[threadIdx.x] = 0u;
    __syncthreads();
    XcdBarrier xbar = xcd_barrier_post((unsigned*)a.ws, bst);
    int nsync = 0;
    unsigned char* ws = a.ws;
    float* MOD = (float*)(ws + WS_MOD); f32x2* ROPE = (f32x2*)(ws + WS_ROPE); float* CTXR = (float*)(ws + WS_CTX);
    bf16_t* W1 = (bf16_t*)(ws + WS_W1); bf16_t* W2 = (bf16_t*)(ws + WS_W2); bf16_t* HY = (bf16_t*)(ws + WS_HY);
    float* DTB = (float*)(ws + WS_DT); bf16_t* HALO = (bf16_t*)(ws + WS_HALO); bf16_t* BIG = (bf16_t*)(ws + WS_BIG); bf16_t* YB = (bf16_t*)(ws + WS_Y);
    const float* x_in = a.in[0]; const float* cvec = a.in[1]; const float* ctx_in = a.in[2]; const float* c_ctx = a.in[3]; const float* w_ada = a.in[4]; const float* b_ada = a.in[5];
    const float* norm_pre = a.in[6]; const float* norm_post = a.in[7]; const float* attn_w_in = a.in[8]; const float* attn_w_out = a.in[9]; const float* attn_sink = a.in[10];
    const float* attn_qn = a.in[11]; const float* attn_kn = a.in[12]; const float* ssm_w_in = a.in[13]; const float* conv_w = a.in[14]; const float* conv_b = a.in[15];
    const float* dt_bias = a.in[16]; const float* a_log = a.in[17]; const float* ssm_d = a.in[18]; const float* ssm_norm = a.in[19]; const float* ssm_w_out = a.in[20];

    int l = -1, st = 0;
    for (;;) {
        int op; const bool ssm = (l & 1) != 0 && l >= 0;
        if (l < 0) op = st == 0 ? OP_PROLOGUE : OP_NORM;
        else if (!ssm) op = st == 0 ? OP_GEMM_IN : st == 1 ? OP_ATTN : st == 2 ? OP_GEMM_BF16 : OP_NORM;
        else op = st == 0 ? OP_GEMM_XBC : st == 1 ? OP_CONV : (st == 2 || st == 3) ? OP_SCAN : st == 4 ? OP_GEMM_Z : st == 5 ? OP_GEMM_BF16 : OP_NORM;
        const int li = l >> 1;
        {
        constexpr bool dry = false;
        int tid_ = threadIdx.x; asm volatile("" : "+v"(tid_));
        Ctx c; c.tid = tid_; c.lane = c.tid & 63; c.wave = __builtin_amdgcn_readfirstlane(c.tid >> 6); c.gw = blockIdx.x * 8 + c.wave; c.ngw = gridDim.x * 8; c.lds = (char*)lds_;
        switch (op) {
#ifndef DIS_PRO
        case OP_PROLOGUE: {
            convert_weights(c, 0, attn_w_in, attn_w_out, ssm_w_in, ssm_w_out, W1, W2);
            __syncthreads();
            adaln_phase(c, cvec, c_ctx, w_ada, b_ada, MOD);
            rope_phase(c, ROPE);
        } break;
#endif
#ifndef DIS_NORM
        case OP_NORM: {
            const bool first = l <= 0;
            norm_pass(c, l, first ? x_in : a.out, a.out, first ? ctx_in : CTXR, CTXR, HY, MOD, norm_pre, norm_post, l < DEPTH_ - 1, dry);
            if (!dry && l >= 0 && l + 1 < DEPTH_) { __syncthreads(); convert_weights(c, l + 1, attn_w_in, attn_w_out, ssm_w_in, ssm_w_out, W1, W2); }
        } break;
#endif
#ifndef DIS_GEMM
        case OP_GEMM_BF16: {
            pg8::Gemm g; pg8::EpiBf16 E;
            if (!ssm) { g = pg8::Gemm{BIG, W2, MTOT, DM, AW, PLD}; E = pg8::EpiBf16{HY, DM}; }
            else { g = pg8::Gemm{YB, W2, MTOT, DM, DI, DI}; E = pg8::EpiBf16{HY, DM}; }
            if (l == DEPTH_ - 1) g.M = MLAT;
            pg8::StaticOrder S; S.init(g.M, g.N, (int)gridDim.x, (int)blockIdx.x);
            pg8::gemm_phase<pg8::EpiBf16, pg8::StaticOrder, true, true>((PG8_LAS unsigned char*)lds_, g, S, E, c.tid);
        } break;
#endif
#ifndef DIS_GEMMX
        case OP_GEMM_XBC: {
            pg8::Gemm g{HY, W1, MTOT, NXB, DM, DM}; pg8::EpiXbc E{BIG, HALO, DTB, dt_bias + (size_t)li * 64};
            pg8::StaticOrder S; S.init(g.M, g.N, (int)gridDim.x, (int)blockIdx.x);
            pg8::gemm_phase<pg8::EpiXbc, pg8::StaticOrder, true, true>((PG8_LAS unsigned char*)lds_, g, S, E, c.tid);
        } break;
#endif
#ifndef DIS_KPREP
        case OP_GEMM_IN: {
            pg8::Gemm g{HY, W1, MTOT, AIN, DM, DM};
            pg8::EpiAttnIn E{BIG, attn_kn + (size_t)li * 128, ROPE, (PG8_LAS float*)((PG8_LAS unsigned char*)lds_ + 131072)};
            pg8::StaticOrder S; S.init(g.M, g.N, (int)gridDim.x, (int)blockIdx.x);
            pg8::gemm_phase<pg8::EpiAttnIn, pg8::StaticOrder, true, true>((PG8_LAS unsigned char*)lds_, g, S, E, c.tid);
        } break;
#endif
#ifndef DIS_ATTN
        case OP_ATTN: attn_phase(c, li, BIG, attn_sink + (size_t)li * 8, attn_qn + (size_t)li * 128, ROPE, dry, 0); break;
#endif
#ifndef DIS_CONV
        case OP_CONV: conv_pass(c, BIG, HALO, conv_w + (size_t)li * 3 * CONVD, conv_b + (size_t)li * CONVD, dry); break;
#endif
#ifndef DIS_SCAN
        case OP_SCAN: ssd::scan_phase(c, st == 2 ? 1 : 0, BIG, DTB, YB, a_log + (size_t)li * 64, ssm_d + (size_t)li * 32, dry, 0); break;
#endif
#ifndef DIS_GNORM
        case OP_GEMM_Z: {
            pg8::Gemm g{HY, W1 + (size_t)NXB * DM, l == DEPTH_ - 1 ? MLAT : MTOT, DI, DM, DM};
            pg8::EpiGnorm E{YB, ssm_norm + (size_t)li * DI, (PG8_LAS float*)((PG8_LAS unsigned char*)lds_ + 131072)};
            pg8::StaticOrder S; S.init(g.M, g.N, (int)gridDim.x, (int)blockIdx.x);
            pg8::gemm_phase<pg8::EpiGnorm, pg8::StaticOrder, true, true>((PG8_LAS unsigned char*)lds_, g, S, E, c.tid);
        } break;
#endif
        default: break;
        }
        }
        const int nst = l < 0 ? 2 : (ssm ? 7 : 4);
        if (++st == nst) { st = 0; ++l; if (l == DEPTH_) break; }
        if (nsync++ == 0) grid.sync(); else xcd_barrier(xbar);
    }
}

extern "C" void kernel_launch(void* const* d_in, const int* in_sizes, int n_in, void* d_out, int out_size, void* d_ws, size_t ws_size, hipStream_t stream) {
    static int grid = 0;
    if (grid == 0) {
        if (n_in != 21 || in_sizes[0] != MLAT * DM || out_size != MLAT * DM || ws_size < WS_END) {
            fprintf(stderr, "kernel_launch: unexpected shapes (n_in %d, in0 %d, out %d, ws %zu < %zu?)\n", n_in, n_in > 0 ? in_sizes[0] : -1, out_size, ws_size, (size_t)WS_END); grid = -1; return; }
        int dev = 0, cus = 0, per_cu = 0;
        if (hipGetDevice(&dev) != hipSuccess || hipDeviceGetAttribute(&cus, hipDeviceAttributeMultiprocessorCount, dev) != hipSuccess) { grid = -1; return; }
        if (hipFuncSetAttribute((const void*)mega, hipFuncAttributeMaxDynamicSharedMemorySize, LDS_BYTES) != hipSuccess) { fprintf(stderr, "kernel_launch: hipFuncSetAttribute failed\n"); grid = -1; return; }
        if (hipOccupancyMaxActiveBlocksPerMultiprocessor(&per_cu, (const void*)mega, 512, LDS_BYTES) != hipSuccess || per_cu < 1) { fprintf(stderr, "kernel_launch: occupancy query says %d\n", per_cu); per_cu = 1; }
        (void)hipGetLastError();
        grid = cus * per_cu;
    }
    if (grid < 0) return;
    Args a{};
    for (int i = 0; i < 21; ++i) a.in[i] = (const float*)d_in[i];
    a.out = (float*)d_out; a.ws = (unsigned char*)d_ws; a.probe = PROBE_OP;
    if (hipMemsetAsync(d_ws, 0, 16384, stream) != hipSuccess) { fprintf(stderr, "kernel_launch: memset failed\n"); return; }
    void* args[] = {&a};
    hipError_t e = hipLaunchCooperativeKernel((const void*)mega, dim3(grid), dim3(512), args, LDS_BYTES, stream);
    if (e != hipSuccess) fprintf(stderr, "kernel_launch: cooperative launch failed: %s (grid %d)\n", hipGetErrorString(e), grid);
}
```

```cpp
#include <hip/hip_runtime.h>
#include <hip/hip_bf16.h>
#include <hip/hip_cooperative_groups.h>
#include <cstdio>
#include <cstdint>
namespace cg = cooperative_groups;

constexpr int T_ = 8192, NB = 4, CL = 256, DM = 1024, MLAT = NB * T_, MCTX = NB * CL, MTOT = MLAT + MCTX;
constexpr int DEPTH_ = 4;
constexpr int AIN = 5120, AW = 2048;
constexpr int DI = 2048, CONVD = 4096, SSMH = 32, NXB = 4352;
constexpr float EPS_ = 1e-6f;
constexpr int PC_QA = 0, PC_QB = 1024, PC_KA = 2048, PC_VA = 2304, PC_KB = 2560, PC_VB = 2816, PC_GA = 3072, PC_GB = 4096;

constexpr size_t MiB = 1u << 20;
constexpr size_t WS_MOD = 1 * MiB;
constexpr size_t WS_ROPE = WS_MOD + 512 * 1024;
constexpr size_t WS_CTX = 2 * MiB;
constexpr size_t WS_W1 = 6 * MiB;
constexpr size_t WS_W2 = 19 * MiB;
constexpr size_t WS_HY = 26 * MiB;
constexpr size_t WS_DT = 92 * MiB;
constexpr size_t WS_HALO = 101 * MiB;
constexpr size_t WS_BIG = 106 * MiB;
constexpr size_t WS_Y = 370 * MiB;
constexpr size_t WS_END = 502 * MiB;

typedef unsigned short bf16_t;
typedef short bf16x8 __attribute__((ext_vector_type(8)));
typedef short s16x4 __attribute__((ext_vector_type(4)));
typedef float f32x4 __attribute__((ext_vector_type(4)));
typedef float f32x2 __attribute__((ext_vector_type(2)));
typedef float f32x16 __attribute__((ext_vector_type(16)));
typedef unsigned u32x4 __attribute__((ext_vector_type(4)));
typedef unsigned u32x2 __attribute__((ext_vector_type(2)));

__device__ __forceinline__ unsigned cvtpk(float lo, float hi) { unsigned r; asm volatile("v_cvt_pk_bf16_f32 %0, %1, %2" : "=v"(r) : "v"(lo), "v"(hi)); return r; }
__device__ __forceinline__ float bf2f(unsigned short u) { return __uint_as_float((unsigned)u << 16); }
__device__ __forceinline__ float bflo(unsigned w) { return __uint_as_float(w << 16); }
__device__ __forceinline__ float bfhi(unsigned w) { return __uint_as_float(w & 0xffff0000u); }
__device__ __forceinline__ unsigned short f2bf(float f) { return (unsigned short)(cvtpk(f, 0.f) & 0xffffu); }
__device__ __forceinline__ float silu_f(float x) { return x / (1.f + __expf(-x)); }
__device__ __forceinline__ float wave_sum(float v) {
#pragma unroll
    for (int o = 1; o < 64; o <<= 1) v += __shfl_xor(v, o);
    return v;
}
__device__ __forceinline__ int crow(int r, int hi) { return (r & 3) + 8 * (r >> 2) + 4 * hi; }
#define SBAR() __builtin_amdgcn_sched_barrier(0)

#define XLAS __attribute__((address_space(3)))
#define XB_TMO      128
#define XB_XCNT(j)  (256  + 64 * (j))
#define XB_XSUB(j)  (1280 + 64 * (j))
#define XB_XGEN(j)  (2304 + 64 * (j))
#define XB_TOP      3328
#define XB_TOPGEN   3392
#define XCD_BAR_WORDS 3456
#define XB_SPIN_CAP (1u << 18)

__device__ __forceinline__ unsigned xb_ld(unsigned* p)              { return __hip_atomic_load(p, __ATOMIC_RELAXED, __HIP_MEMORY_SCOPE_AGENT); }
__device__ __forceinline__ unsigned xb_add(unsigned* p, unsigned v) { return __hip_atomic_fetch_add(p, v, __ATOMIC_RELAXED, __HIP_MEMORY_SCOPE_AGENT); }
__device__ __forceinline__ unsigned xb_xcc_id() { return (unsigned)__builtin_amdgcn_s_getreg((3 << 11) | 20) & 0xFu; }
#define XB_SPIN(cond, bar) do { unsigned _sp = 0; while (cond) { __builtin_amdgcn_s_sleep(1); \
    if ((++_sp & 255u) == 0u) { if (xb_ld(&(bar)[XB_TMO])) break; if (_sp > XB_SPIN_CAP) { atomicAdd(&(bar)[XB_TMO], 1u); break; } } } } while (0)

struct XcdBarrier {
    unsigned* bar; unsigned x;
    volatile XLAS unsigned* st;
};

__device__ __forceinline__ XcdBarrier xcd_barrier_post(unsigned* bar, volatile XLAS unsigned* st) {
    XcdBarrier b; b.bar = bar; b.x = xb_xcc_id(); b.st = st;
    if (threadIdx.x == 0) (void)xb_add(&bar[XB_XCNT(b.x)], 1u);
    return b;
}
__device__ __forceinline__ void xcd_barrier_complete(unsigned* bar, unsigned x, unsigned& nloc, unsigned& nx) {
    const unsigned G = gridDim.x * gridDim.y * gridDim.z;
    unsigned sum, cnt, mine, sp = 0u;
    for (;;) {
        sum = 0u; cnt = 0u; mine = 0u;
#pragma unroll
        for (unsigned j = 0; j < 16; ++j) { const unsigned c = xb_ld(&bar[XB_XCNT(j)]); sum += c; cnt += (c > 0u) ? 1u : 0u; mine = (j == x) ? c : mine; }
        if (sum == G) break;
        __builtin_amdgcn_s_sleep(1);
        if ((++sp & 255u) == 0u) { if (xb_ld(&bar[XB_TMO])) break; if (sp > XB_SPIN_CAP) { atomicAdd(&bar[XB_TMO], 1u); break; } }
    }
    nloc = mine > 0u ? mine : 1u; nx = cnt > 0u ? cnt : 1u;
}

__device__ __forceinline__ void xcd_barrier(const XcdBarrier& b) {
    asm volatile("s_waitcnt vmcnt(0)" ::: "memory");
    __syncthreads();
    if (threadIdx.x == 0) {
        unsigned* bar = b.bar;
        __builtin_amdgcn_s_waitcnt(0);
        unsigned nloc = b.st[0], nx = b.st[1];
        if (nloc == 0u) { xcd_barrier_complete(bar, b.x, nloc, nx); b.st[0] = nloc; b.st[1] = nx; }
        const unsigned old = xb_add(&bar[XB_XSUB(b.x)], 1u);
        const unsigned gen = old / nloc;
        if (old + 1u == (gen + 1u) * nloc) {
            __builtin_amdgcn_fence(__ATOMIC_RELEASE, "agent");
            asm volatile("s_waitcnt vmcnt(0)" ::: "memory");
            const unsigned og = xb_add(&bar[XB_TOP], 1u);
            const unsigned tg = og / nx;
            if (og + 1u == (tg + 1u) * nx) xb_add(&bar[XB_TOPGEN], 1u);
            else XB_SPIN(xb_ld(&bar[XB_TOPGEN]) == tg, bar);
            __builtin_amdgcn_fence(__ATOMIC_ACQUIRE, "agent");
            xb_add(&bar[XB_XGEN(b.x)], 1u);
            asm volatile("s_waitcnt vmcnt(0)" ::: "memory");
        } else {
            XB_SPIN(xb_ld(&bar[XB_XGEN(b.x)]) == gen, bar);
            __builtin_amdgcn_fence(__ATOMIC_ACQUIRE, "agent");
            asm volatile("s_waitcnt vmcnt(0)" ::: "memory");
        }
    }
    __syncthreads();
}
namespace pg8 {
#define PG8_LAS __attribute__((address_space(3)))
typedef unsigned short bf16_t;
typedef short bf16x8 __attribute__((ext_vector_type(8)));
typedef float f32x4 __attribute__((ext_vector_type(4)));
typedef unsigned u32x4 __attribute__((ext_vector_type(4)));
constexpr int BM = 256, BK = 64, HALF = 128, HTB = HALF * BK * 2  , STAGE_BYTES = 8 * HTB, NXCD = 8, WGM = 8;

__host__ __device__ __forceinline__ int lds_byte(int r, int c) { const int st = (r >> 4) * 2 + (c >> 5), rr = r & 15, cc = c & 31, ob = rr * 64 + cc * 2; return st * 1024 + (ob ^ (((ob >> 9) & 1) << 5)); }
__host__ __device__ __forceinline__ void stage_rc(int b, int& R, int& C) { const int st = b / 1024, sb = b % 1024, swz = sb ^ (((sb >> 9) & 1) << 5); R = (st >> 1) * 16 + swz / 64; C = (st & 1) * 32 + (swz % 64) / 2; }
__host__ __device__ __forceinline__ int perm32(int rho) { const int n = rho >> 4, i = rho & 15; return 8 * (i >> 2) + 4 * n + (i & 3); }

struct Unit { int pm, pn; };
struct Gemm { const bf16_t* A; const bf16_t* Bt; int M, N, K, lda; };

struct StaticOrder {
    int nM, nN, nwg, G, c;
    __host__ __device__ void init(int M, int N, int G_, int c_) { nM = M / BM; nN = N / BM; nwg = nM * nN; G = G_; c = c_; }
    __host__ __device__ bool next(int i, Unit& u) const {
        const long L = (long)i * G + c; if (L >= nwg) return false;
        int wgid = (int)L; { const int q = nwg / NXCD, r = nwg % NXCD, xcd = wgid % NXCD, off = wgid / NXCD; wgid = (xcd < r ? xcd * (q + 1) : r * (q + 1) + (xcd - r) * q) + off; }
        const int nig = WGM * nN, gid = wgid / nig, fm = gid * WGM, gsz = (nM - fm) < WGM ? (nM - fm) : WGM;
        u.pm = fm + ((wgid % nig) % gsz); u.pn = (wgid % nig) / gsz; return true;
    }
    __device__ __forceinline__ void a_ready(const Unit&) const {}
    __device__ __forceinline__ void done(const Unit&) const {}
};

struct EpiBf16 {
    static constexpr bool PERM = true, AFTER_DRAIN = false;
    bf16_t* O; int ldc;
    __device__ __forceinline__ void operator()(const f32x4 (&acc)[2][2][4][2], const Unit& u, int wr, int wc, int fr, int fq) const {
        asm volatile("s_nop 7\n\ts_nop 7\n\ts_nop 7" ::: "memory");
        const int row0 = u.pm * BM + wr * 64 + fr, col0 = u.pn * BM + wc * 32 + 8 * fq;
#pragma unroll
        for (int ai = 0; ai < 2; ++ai)
#pragma unroll
            for (int m = 0; m < 4; ++m) { bf16_t* rowp = O + (size_t)(row0 + ai * HALF + m * 16) * ldc + col0;
#pragma unroll
                for (int bj = 0; bj < 2; ++bj) { const f32x4 v0 = acc[ai][bj][m][0], v1 = acc[ai][bj][m][1];
                    u32x4 w; w.x = cvtpk(v0[0], v0[1]); w.y = cvtpk(v0[2], v0[3]); w.z = cvtpk(v1[0], v1[1]); w.w = cvtpk(v1[2], v1[3]);
                    *(u32x4*)(rowp + bj * HALF) = w; } }
    }
};
struct EpiGnorm {
    static constexpr bool PERM = true, AFTER_DRAIN = false;
    bf16_t* Y; const float* nw; PG8_LAS float* tab;
    __device__ __forceinline__ void operator()(f32x4 (&acc)[2][2][4][2], const Unit& u, int wr, int wc, int fr, int fq) const {
        const int row0 = u.pm * BM + wr * 64 + fr, col0 = u.pn * BM + wc * 32 + 8 * fq;
#pragma unroll
        for (int ai = 0; ai < 2; ++ai)
#pragma unroll
            for (int m = 0; m < 4; ++m) { const bf16_t* yp = Y + (size_t)(row0 + ai * HALF + m * 16) * DI + col0; float ssq = 0.f;
#pragma unroll
                for (int bj = 0; bj < 2; ++bj) { const u32x4 yv = *(const u32x4*)(yp + bj * HALF); f32x4& z0 = acc[ai][bj][m][0]; f32x4& z1 = acc[ai][bj][m][1];
                    z0[0] = bflo(yv.x) * silu_f(z0[0]); z0[1] = bfhi(yv.x) * silu_f(z0[1]); z0[2] = bflo(yv.y) * silu_f(z0[2]); z0[3] = bfhi(yv.y) * silu_f(z0[3]);
                    z1[0] = bflo(yv.z) * silu_f(z1[0]); z1[1] = bfhi(yv.z) * silu_f(z1[1]); z1[2] = bflo(yv.w) * silu_f(z1[2]); z1[3] = bfhi(yv.w) * silu_f(z1[3]);
                    ssq += (z0[0] * z0[0] + z0[1] * z0[1]) + (z0[2] * z0[2] + z0[3] * z0[3]) + (z1[0] * z1[0] + z1[1] * z1[1]) + (z1[2] * z1[2] + z1[3] * z1[3]); }
                ssq += __shfl_xor(ssq, 16); ssq += __shfl_xor(ssq, 32);
                if (fq == 0) tab[(ai * HALF + wr * 64 + m * 16 + fr) * 4 + wc] = ssq; }
        asm volatile("s_waitcnt lgkmcnt(0)" ::: "memory"); __builtin_amdgcn_s_barrier(); asm volatile("" ::: "memory");
        f32x4 w[2][2];
#pragma unroll
        for (int bj = 0; bj < 2; ++bj) { w[bj][0] = *(const f32x4*)(nw + col0 + bj * HALF); w[bj][1] = *(const f32x4*)(nw + col0 + bj * HALF + 4); }
#pragma unroll
        for (int ai = 0; ai < 2; ++ai)
#pragma unroll
            for (int m = 0; m < 4; ++m) { const f32x4 t = *(const PG8_LAS f32x4*)(tab + (ai * HALF + wr * 64 + m * 16 + fr) * 4);
                const float rs = rsqrtf(((t[0] + t[1]) + (t[2] + t[3])) * (1.f / 256.f) + EPS_);
                bf16_t* yp = Y + (size_t)(row0 + ai * HALF + m * 16) * DI + col0;
#pragma unroll
                for (int bj = 0; bj < 2; ++bj) { const f32x4 v0 = acc[ai][bj][m][0] * rs * w[bj][0], v1 = acc[ai][bj][m][1] * rs * w[bj][1];
                    u32x4 o; o.x = cvtpk(v0[0], v0[1]); o.y = cvtpk(v0[2], v0[3]); o.z = cvtpk(v1[0], v1[1]); o.w = cvtpk(v1[2], v1[3]);
                    *(u32x4*)(yp + bj * HALF) = o; } }
    }
};
struct EpiAttnIn {
    static constexpr bool PERM = true, AFTER_DRAIN = false;
    bf16_t* O; const float* knw; const f32x2* rope; PG8_LAS float* tab;
    __device__ __forceinline__ void operator()(f32x4 (&acc)[2][2][4][2], const Unit& u, int wr, int wc, int fr, int fq) const {
        asm volatile("s_nop 7\n\ts_nop 7\n\ts_nop 7" ::: "memory");
        const int row0 = u.pm * BM + wr * 64 + fr, col0 = u.pn * BM + wc * 32 + 8 * fq;
        const bool isK = u.pn == 8 || u.pn == 10, isB = u.pn == 10;
        if (isB) {
#pragma unroll
            for (int ai = 0; ai < 2; ++ai)
#pragma unroll
                for (int m = 0; m < 4; ++m)
#pragma unroll
                    for (int bj = 0; bj < 2; ++bj) { const f32x4 a = acc[ai][bj][m][0], b = acc[ai][bj][m][1];
                        float ssq = (a[0] * a[0] + a[1] * a[1]) + (a[2] * a[2] + a[3] * a[3]) + (b[0] * b[0] + b[1] * b[1]) + (b[2] * b[2] + b[3] * b[3]);
                        ssq += __shfl_xor(ssq, 16); ssq += __shfl_xor(ssq, 32);
                        if (fq == 0) tab[((ai * HALF + wr * 64 + m * 16 + fr) * 2 + bj) * 4 + wc] = ssq; }
            asm volatile("s_waitcnt lgkmcnt(0)" ::: "memory"); __builtin_amdgcn_s_barrier(); asm volatile("" ::: "memory");
        }
        f32x4 kw0 = {1.f, 1.f, 1.f, 1.f}, kw1 = kw0;
        if (isB) { kw0 = *(const f32x4*)(knw + wc * 32 + 8 * fq); kw1 = *(const f32x4*)(knw + wc * 32 + 8 * fq + 4); }
        const int i0 = wc * 16 + 4 * fq;
#pragma unroll
        for (int ai = 0; ai < 2; ++ai)
#pragma unroll
            for (int m = 0; m < 4; ++m) { const int row = row0 + ai * HALF + m * 16; bf16_t* rowp = O + (size_t)row * AIN + col0;
                f32x4 c01 = {1.f, 0.f, 1.f, 0.f}, c23 = c01;
                const bool rot = isK && row < MLAT;
                if (rot) { const int pos = row & (T_ - 1); const int tb = i0 < 32 ? (pos >> 6) : (pos & 63); const f32x4* tp = (const f32x4*)(rope + tb * 32 + (i0 & 31)); c01 = tp[0]; c23 = tp[1]; }
#pragma unroll
                for (int bj = 0; bj < 2; ++bj) { f32x4 v0 = acc[ai][bj][m][0], v1 = acc[ai][bj][m][1];
                    if (isB) { const f32x4 t = *(const PG8_LAS f32x4*)(tab + ((ai * HALF + wr * 64 + m * 16 + fr) * 2 + bj) * 4);
                        const float rs = rsqrtf(((t[0] + t[1]) + (t[2] + t[3])) * (1.f / 128.f) + EPS_); v0 = v0 * rs * kw0; v1 = v1 * rs * kw1; }
                    if (rot) { float x0, x1;
                        x0 = v0[0]; x1 = v0[1]; v0[0] = x0 * c01[0] - x1 * c01[1]; v0[1] = x0 * c01[1] + x1 * c01[0];
                        x0 = v0[2]; x1 = v0[3]; v0[2] = x0 * c01[2] - x1 * c01[3]; v0[3] = x0 * c01[3] + x1 * c01[2];
                        x0 = v1[0]; x1 = v1[1]; v1[0] = x0 * c23[0] - x1 * c23[1]; v1[1] = x0 * c23[1] + x1 * c23[0];
                        x0 = v1[2]; x1 = v1[3]; v1[2] = x0 * c23[2] - x1 * c23[3]; v1[3] = x0 * c23[3] + x1 * c23[2]; }
                    u32x4 w; w.x = cvtpk(v0[0], v0[1]); w.y = cvtpk(v0[2], v0[3]); w.z = cvtpk(v1[0], v1[1]); w.w = cvtpk(v1[2], v1[3]);
                    *(u32x4*)(rowp + bj * HALF) = w; } }
    }
};
struct EpiXbc {
    static constexpr bool PERM = true, AFTER_DRAIN = false;
    bf16_t* O; bf16_t* halo; float* dt; const float* dtb;
    __device__ __forceinline__ void operator()(const f32x4 (&acc)[2][2][4][2], const Unit& u, int wr, int wc, int fr, int fq) const {
        asm volatile("s_nop 7\n\ts_nop 7\n\ts_nop 7" ::: "memory");
        const int row0 = u.pm * BM + wr * 64 + fr;
        if (u.pn < 16) {
            const int col0 = u.pn * BM + wc * 32 + 8 * fq;
#pragma unroll
            for (int ai = 0; ai < 2; ++ai)
#pragma unroll
                for (int m = 0; m < 4; ++m) { const int row = row0 + ai * HALF + m * 16; bf16_t* rowp = O + (size_t)row * CONVD + col0;
                    const int rl = row & 127;
#pragma unroll
                    for (int bj = 0; bj < 2; ++bj) { const f32x4 v0 = acc[ai][bj][m][0], v1 = acc[ai][bj][m][1];
                        u32x4 w; w.x = cvtpk(v0[0], v0[1]); w.y = cvtpk(v0[2], v0[3]); w.z = cvtpk(v1[0], v1[1]); w.w = cvtpk(v1[2], v1[3]);
                        *(u32x4*)(rowp + bj * HALF) = w;
                        if (rl == 0) *(u32x4*)(halo + ((size_t)(row >> 7) * 2 + 0) * CONVD + col0 + bj * HALF) = w;
                        if (rl == 127) *(u32x4*)(halo + ((size_t)(row >> 7) * 2 + 1) * CONVD + col0 + bj * HALF) = w; } }
        } else {
            const int lc = wc * 32 + 8 * fq;
            if (wc < 2) {
                const f32x4 b0 = *(const f32x4*)(dtb + lc), b1 = *(const f32x4*)(dtb + lc + 4);
#pragma unroll
                for (int ai = 0; ai < 2; ++ai)
#pragma unroll
                    for (int m = 0; m < 4; ++m) { const int row = row0 + ai * HALF + m * 16;
                        f32x4 v0 = acc[ai][0][m][0] + b0, v1 = acc[ai][0][m][1] + b1;
#pragma unroll
                        for (int j = 0; j < 4; ++j) { v0[j] = v0[j] > 20.f ? v0[j] : log1pf(__expf(v0[j])); v1[j] = v1[j] > 20.f ? v1[j] : log1pf(__expf(v1[j])); }
#pragma unroll
                        for (int j = 0; j < 4; ++j) { dt[(size_t)(lc + j) * MTOT + row] = v0[j]; dt[(size_t)(lc + 4 + j) * MTOT + row] = v1[j]; } }
            }
        }
    }
};
template <class Epi, class Sched, bool ALIGN_EPI = false, bool SP2 = false>
__device__ __forceinline__ void gemm_phase(PG8_LAS unsigned char* lds, const Gemm g, const Sched& S, const Epi& E, const int tid) {
    const int wid = __builtin_amdgcn_readfirstlane(tid >> 6), lane = tid & 63, wr = wid >> 2, wc = wid & 3, fr = lane & 15, fq = lane >> 4;
    const int K = g.K, nt = K / BK;
    unsigned voffA[2], voffB[2];
#pragma unroll
    for (int i = 0; i < 2; ++i) { int R, C; stage_rc(tid * 16 + i * 8192, R, C); const int Rb = Epi::PERM ? ((R & ~31) + perm32(R & 31)) : R;
        voffA[i] = (unsigned)(R * g.lda + C) * 2u; voffB[i] = (unsigned)(Rb * K + C) * 2u; }
    const size_t kstep = (size_t)(BK * 2);
    const size_t hstepA = (size_t)HALF * g.lda * 2, hstepB = (size_t)HALF * K * 2;
    const size_t tstepA = 2 * hstepA, tstepB = 2 * hstepB;
    const unsigned ldsw = (unsigned)wid * 1024u;
    const int aoff = lds_byte(wr * 64 + fr, fq * 8), boff = lds_byte(wc * 32 + fr, fq * 8);
#define PG8_SA(b, h) (((b) * 2 + (h)) * HTB)
#define PG8_SB(b, h) ((4 + (b) * 2 + (h)) * HTB)
#define PG8_STAGE(bufoff, gbase, voff) do { _Pragma("unroll") for (int _i = 0; _i < 2; ++_i) \
        __builtin_amdgcn_global_load_lds((const unsigned*)((const char*)(gbase) + (voff)[_i]), (PG8_LAS unsigned*)(lds + (bufoff) + ldsw + _i * 8192), 16, 0, 0); } while (0)
#define PG8_LDA(dst, b, h) do { _Pragma("unroll") for (int m = 0; m < 4; ++m) _Pragma("unroll") for (int k = 0; k < 2; ++k) dst[m][k] = *(const PG8_LAS bf16x8*)(lds + PG8_SA(b, h) + aoff + m * 2048 + k * 1024); } while (0)
#define PG8_LDB(dst, b, h) do { _Pragma("unroll") for (int n = 0; n < 2; ++n) _Pragma("unroll") for (int k = 0; k < 2; ++k) dst[n][k] = *(const PG8_LAS bf16x8*)(lds + PG8_SB(b, h) + boff + n * 2048 + k * 1024); } while (0)
#define PG8_MMA(ai, bj, At, Bt) do { __builtin_amdgcn_s_setprio(1); _Pragma("unroll") for (int m = 0; m < 4; ++m) _Pragma("unroll") for (int n = 0; n < 2; ++n) _Pragma("unroll") for (int k = 0; k < 2; ++k) \
        acc[ai][bj][m][n] = __builtin_amdgcn_mfma_f32_16x16x32_bf16(Bt[n][k], At[m][k], acc[ai][bj][m][n], 0, 0, 0); __builtin_amdgcn_s_setprio(0); } while (0)
#define PG8_WAIT_V(n) asm volatile("s_waitcnt vmcnt(" #n ")" ::: "memory")
#define PG8_WAIT_L(n) asm volatile("s_waitcnt lgkmcnt(" #n ")" ::: "memory")
#define PG8_BAR __builtin_amdgcn_s_barrier()
#define PG8_SCHED __builtin_amdgcn_sched_barrier(0)
    Unit cur, nxt; int ui = 0;
    if (!S.next(0, cur)) return;
    f32x4 acc[2][2][4][2];
#pragma unroll
    for (int a = 0; a < 2; ++a)
#pragma unroll
        for (int b = 0; b < 2; ++b)
#pragma unroll
            for (int m = 0; m < 4; ++m)
#pragma unroll
                for (int n = 0; n < 2; ++n) acc[a][b][m][n] = (f32x4){0.f, 0.f, 0.f, 0.f};
    bf16x8 At[4][2], B0[2][2], B1[2][2];
    const char* cA = (const char*)g.A + (size_t)cur.pm * tstepA; const char* cB = (const char*)g.Bt + (size_t)cur.pn * tstepB;
    S.a_ready(cur);
    if constexpr (SP2) {
        PG8_STAGE(PG8_SB(0, 0), cB, voffB); PG8_STAGE(PG8_SB(0, 1), cB + hstepB, voffB); PG8_STAGE(PG8_SA(0, 0), cA, voffA); PG8_STAGE(PG8_SA(0, 1), cA + hstepA, voffA);
        if (wr == 1) PG8_BAR;
        PG8_WAIT_V(2); PG8_BAR;
        PG8_STAGE(PG8_SB(1, 0), cB + kstep, voffB); PG8_STAGE(PG8_SA(1, 0), cA + kstep, voffA); PG8_STAGE(PG8_SB(1, 1), cB + hstepB + kstep, voffB);
        PG8_WAIT_V(6); PG8_BAR;
    } else {
        PG8_STAGE(PG8_SB(0, 0), cB, voffB); PG8_STAGE(PG8_SA(0, 0), cA, voffA); PG8_STAGE(PG8_SB(0, 1), cB + hstepB, voffB); PG8_STAGE(PG8_SA(0, 1), cA + hstepA, voffA);
        if (wr == 1) PG8_BAR;
        PG8_WAIT_V(4); PG8_BAR;
        PG8_STAGE(PG8_SB(1, 0), cB + kstep, voffB); PG8_STAGE(PG8_SA(1, 0), cA + kstep, voffA); PG8_STAGE(PG8_SB(1, 1), cB + hstepB + kstep, voffB);
        PG8_WAIT_V(6); PG8_BAR;
    }
    for (;;) {
        const bool has_next = S.next(ui + 1, nxt);
        const char* nA = has_next ? (const char*)g.A + (size_t)nxt.pm * tstepA : cA; const char* nB = has_next ? (const char*)g.Bt + (size_t)nxt.pn * tstepB : cB;
        for (int t = 0; t < nt; t += 2) {
            const bool last = (t == nt - 2);
            const char* a1 = cA + (size_t)(t + 1) * kstep;
            const char* a2 = last ? nA : cA + (size_t)(t + 2) * kstep; const char* b2 = last ? nB : cB + (size_t)(t + 2) * kstep;
            const char* a3 = a2 + kstep; const char* b3 = b2 + kstep;
            if (last && has_next) S.a_ready(nxt);
            if constexpr (SP2) {
            PG8_LDB(B0, 0, 0); PG8_LDB(B1, 0, 1); PG8_SCHED; PG8_LDA(At, 0, 0); PG8_STAGE(PG8_SA(1, 1), a1 + hstepA, voffA);
            PG8_WAIT_V(8); PG8_WAIT_L(0); PG8_BAR; PG8_MMA(0, 0, At, B0); PG8_MMA(0, 1, At, B1); PG8_BAR; PG8_SCHED;
            PG8_LDA(At, 0, 1); PG8_STAGE(PG8_SB(0, 0), b2, voffB); PG8_STAGE(PG8_SB(0, 1), b2 + hstepB, voffB); PG8_STAGE(PG8_SA(0, 0), a2, voffA);
            PG8_WAIT_V(8); PG8_WAIT_L(0); PG8_BAR; PG8_MMA(1, 0, At, B0); PG8_MMA(1, 1, At, B1); PG8_BAR; PG8_SCHED;
            PG8_LDB(B0, 1, 0); PG8_LDB(B1, 1, 1); PG8_SCHED; PG8_LDA(At, 1, 0); PG8_STAGE(PG8_SA(0, 1), a2 + hstepA, voffA);
            PG8_WAIT_V(8); PG8_WAIT_L(0); PG8_BAR; PG8_MMA(0, 0, At, B0); PG8_MMA(0, 1, At, B1); PG8_BAR; PG8_SCHED;
            PG8_LDA(At, 1, 1); PG8_STAGE(PG8_SB(1, 0), b3, voffB); PG8_STAGE(PG8_SB(1, 1), b3 + hstepB, voffB); PG8_STAGE(PG8_SA(1, 0), a3, voffA);
            PG8_WAIT_V(8); PG8_WAIT_L(0); PG8_BAR; PG8_MMA(1, 0, At, B0); PG8_MMA(1, 1, At, B1); PG8_BAR; PG8_SCHED;
            } else {
            PG8_LDB(B0, 0, 0); PG8_SCHED; PG8_LDA(At, 0, 0); PG8_STAGE(PG8_SA(1, 1), a1 + hstepA, voffA);
            PG8_WAIT_L(8); PG8_BAR; PG8_WAIT_L(0); PG8_MMA(0, 0, At, B0); PG8_BAR; PG8_SCHED;
            PG8_LDB(B1, 0, 1); PG8_STAGE(PG8_SB(0, 0), b2, voffB);
            PG8_BAR; PG8_WAIT_L(0); PG8_MMA(0, 1, At, B1); PG8_BAR;
            PG8_LDA(At, 0, 1); PG8_STAGE(PG8_SA(0, 0), a2, voffA);
            PG8_BAR; PG8_WAIT_L(0); PG8_MMA(1, 0, At, B0); PG8_BAR; PG8_SCHED;
            PG8_STAGE(PG8_SB(0, 1), b2 + hstepB, voffB);
            PG8_WAIT_V(6); PG8_BAR; PG8_MMA(1, 1, At, B1); PG8_BAR;
            PG8_LDB(B0, 1, 0); PG8_SCHED; PG8_LDA(At, 1, 0); PG8_STAGE(PG8_SA(0, 1), a2 + hstepA, voffA);
            PG8_WAIT_L(8); PG8_BAR; PG8_WAIT_L(0); PG8_MMA(0, 0, At, B0); PG8_BAR; PG8_SCHED;
            PG8_LDB(B1, 1, 1); PG8_STAGE(PG8_SB(1, 0), b3, voffB);
            PG8_BAR; PG8_WAIT_L(0); PG8_MMA(0, 1, At, B1); PG8_BAR;
            PG8_LDA(At, 1, 1); PG8_STAGE(PG8_SA(1, 0), a3, voffA);
            PG8_BAR; PG8_WAIT_L(0); PG8_MMA(1, 0, At, B0); PG8_BAR; PG8_SCHED;
            PG8_STAGE(PG8_SB(1, 1), b3 + hstepB, voffB);
            PG8_WAIT_V(6); PG8_BAR; PG8_MMA(1, 1, At, B1); PG8_BAR;
            }
        }
        if constexpr (ALIGN_EPI) { if (wr == 0) PG8_BAR; }
        if constexpr (!Epi::AFTER_DRAIN) { E(acc, cur, wr, wc, fr, fq); S.done(cur); }
        if (!has_next) break;
#pragma unroll
        for (int a = 0; a < 2; ++a)
#pragma unroll
            for (int b = 0; b < 2; ++b)
#pragma unroll
                for (int m = 0; m < 4; ++m)
#pragma unroll
                    for (int n = 0; n < 2; ++n) acc[a][b][m][n] = (f32x4){0.f, 0.f, 0.f, 0.f};
        cur = nxt; cA = nA; cB = nB; ++ui;
        if constexpr (ALIGN_EPI) { if (wr == 1) PG8_BAR; }
    }
    PG8_WAIT_V(0);
    if constexpr (!ALIGN_EPI) { if (wr == 0) PG8_BAR; }
    PG8_BAR;
    if constexpr (Epi::AFTER_DRAIN) { E.fused(acc, cur, wr, wc, fr, fq, lds, wid, lane); S.done(cur); }
#undef PG8_SA
#undef PG8_SB
#undef PG8_STAGE
#undef PG8_LDA
#undef PG8_LDB
#undef PG8_MMA
#undef PG8_WAIT_V
#undef PG8_WAIT_L
#undef PG8_BAR
#undef PG8_SCHED
}
}
namespace att {
constexpr int D = 128, NW = 8, QBLK = 32, KVBLK = 64, LDP = AIN;
constexpr float SCALE = 0.088388347648318440f, THR = 8.f;
#ifndef ATT_NQR
#define ATT_NQR 5
#endif
#ifndef ATT_NQR_U
#define ATT_NQR_U 8
#endif
constexpr int NQR = ATT_NQR, NQR_U = ATT_NQR_U;
constexpr size_t SHM_V = KVBLK * D * 2, SHM_K = KVBLK * D * 2, SHM_ATTN = 2 * SHM_V + 2 * SHM_K + NW * 64 * 4, SHM_Q = (8 - NQR) * 8192;
#define KSWZ(row, colB) ((row) * 256 + ((colB) ^ (((row) & 7) << 4)))
__device__ __forceinline__ void partialSM(f32x16& p0, f32x16& p1, float& m_reg, float& mn, float& alpha) {
  constexpr float C = SCALE * 1.4426950408889634f;
  float pmax = p0[0];
#pragma unroll
  for (int r = 1; r < 16; ++r) pmax = fmaxf(pmax, p0[r]);
#pragma unroll
  for (int r = 0; r < 16; ++r) pmax = fmaxf(pmax, p1[r]);
  { auto rr = __builtin_amdgcn_permlane32_swap(__float_as_uint(pmax), __float_as_uint(pmax), false, false);
    pmax = fmaxf(__uint_as_float(rr[0]), __uint_as_float(rr[1])); }
  if (__builtin_expect(__all(pmax - m_reg <= THR / SCALE), 1)) { mn = m_reg; alpha = 1.f; }
  else { mn = fmaxf(m_reg, pmax); alpha = __builtin_amdgcn_exp2f((m_reg - mn) * C); m_reg = mn; }
  float mnC = -mn * C;
#pragma unroll
  for (int r = 0; r < 16; ++r) p0[r] = fmaf(p0[r], C, mnC);
#pragma unroll
  for (int r = 0; r < 16; ++r) p1[r] = fmaf(p1[r], C, mnC);
#pragma unroll
  for (int r = 0; r < 16; ++r) p0[r] = __builtin_amdgcn_exp2f(p0[r]);
}
__device__ __forceinline__ void finishSM(f32x16& p0, f32x16& p1, float alpha, float& l_reg, bf16x8& pa0, bf16x8& pa1, bf16x8& pa2, bf16x8& pa3) {
#pragma unroll
  for (int r = 0; r < 16; ++r) p1[r] = __builtin_amdgcn_exp2f(p1[r]);
  float ps = 0;
#pragma unroll
  for (int r = 0; r < 16; ++r) ps += p0[r];
#pragma unroll
  for (int r = 0; r < 16; ++r) ps += p1[r];
  { auto rr = __builtin_amdgcn_permlane32_swap(__float_as_uint(ps), __float_as_uint(ps), false, false);
    ps = __uint_as_float(rr[0]) + __uint_as_float(rr[1]); }
  l_reg = l_reg * alpha + ps;
#define PK4(P, BASE, OUT) do { unsigned a0 = cvtpk(P[BASE + 0], P[BASE + 1]), a1 = cvtpk(P[BASE + 2], P[BASE + 3]);   \
    unsigned b0 = cvtpk(P[BASE + 4], P[BASE + 5]), b1 = cvtpk(P[BASE + 6], P[BASE + 7]);                              \
    auto r0 = __builtin_amdgcn_permlane32_swap(a0, b0, false, false); auto r1 = __builtin_amdgcn_permlane32_swap(a1, b1, false, false); \
    u32x4 w = {r0[0], r1[0], r0[1], r1[1]}; OUT = *reinterpret_cast<bf16x8*>(&w); } while (0)
  PK4(p0, 0, pa0); PK4(p0, 8, pa1); PK4(p1, 0, pa2); PK4(p1, 8, pa3);
#undef PK4
}
template <int NQ>
__device__ __forceinline__ void qkt(f32x16& p0, f32x16& p1, const char* Ks, const bf16x8* qr, const char* ql, int r32, int hi) {
  p0 = f32x16{}; p1 = f32x16{};
  const int x = (r32 & 7) << 4, kb = r32 * 256;
  const char* a0 = Ks + kb + ((hi * 16) ^ x); const char* a1 = Ks + kb + ((32 + hi * 16) ^ x); const char* a2 = Ks + kb + ((64 + hi * 16) ^ x); const char* a3 = Ks + kb + ((96 + hi * 16) ^ x);
#define QK1(QV, AP, IMM) { const bf16x8 b0 = *reinterpret_cast<const bf16x8*>(AP + IMM); const bf16x8 b1 = *reinterpret_cast<const bf16x8*>(AP + IMM + 8192); const bf16x8 qv = QV; \
    p0 = __builtin_amdgcn_mfma_f32_32x32x16_bf16(b0, qv, p0, 0, 0, 0); p1 = __builtin_amdgcn_mfma_f32_32x32x16_bf16(b1, qv, p1, 0, 0, 0); }
#define QLD(I) (*reinterpret_cast<const bf16x8*>(ql + (I) * 8192))
  #define QSEL(I) ((I) < NQ ? qr[(I) < NQ ? (I) : 0] : QLD((I) - NQ))
  QK1(QSEL(0), a0, 0) QK1(QSEL(1), a1, 0) QK1(QSEL(2), a2, 0) QK1(QSEL(3), a3, 0) QK1(QSEL(4), a0, 128) QK1(QSEL(5), a1, 128) QK1(QSEL(6), a2, 128) QK1(QSEL(7), a3, 128)
#undef QSEL
#undef QK1
#undef QLD
}
__device__ __forceinline__ void wmask(f32x16& p0, f32x16& p1, int kp, int qp, int hi) {
#pragma unroll
  for (int r = 0; r < 16; ++r) { const int d = qp - (kp + crow(r, hi));
    if (d > 128 || d < -128) p0[r] = -INFINITY;
    if (d - 32 > 128 || d - 32 < -128) p1[r] = -INFINITY; }
}
__device__ __forceinline__ int v_st(int k, int c) { const int kk = (k & ~0xC) | ((k & 4) << 1) | ((k & 8) >> 1); return ((kk >> 3) * 4 + (c >> 5)) * 512 + ((kk & 7) * 32 + (c & 31)) * 2; }
__device__ __forceinline__ int v_rd_base(int lane) { return ((lane & 3) << 3) | (((lane >> 2) & 3) << 6) | (((lane >> 4) & 1) << 5) | (((lane >> 5) & 1) << 8); }
constexpr int v_rd_off(int d0, int ks, int half) { return d0 * 512 + ks * 4096 + half * 2048; }
template <int OFF> __device__ __forceinline__ s16x4 tr_read(int vb) {
  s16x4 r; asm volatile("ds_read_b64_tr_b16 %0, %1 offset:%2" : "=&v"(r) : "v"(vb), "i"(OFF) : "memory"); return r;
}
template <int D0> __device__ __forceinline__ void pv_one(f32x16& od, int vb, bf16x8 pa0, bf16x8 pa1, bf16x8 pa2, bf16x8 pa3) {
  const s16x4 l0 = tr_read<v_rd_off(D0, 0, 0)>(vb), h0 = tr_read<v_rd_off(D0, 0, 1)>(vb), l1 = tr_read<v_rd_off(D0, 1, 0)>(vb), h1 = tr_read<v_rd_off(D0, 1, 1)>(vb);
  const s16x4 l2 = tr_read<v_rd_off(D0, 2, 0)>(vb), h2 = tr_read<v_rd_off(D0, 2, 1)>(vb), l3 = tr_read<v_rd_off(D0, 3, 0)>(vb), h3 = tr_read<v_rd_off(D0, 3, 1)>(vb);
  asm volatile("s_waitcnt lgkmcnt(0)" ::: "memory"); SBAR();
#define PK(L, H) (bf16x8){L[0], L[1], L[2], L[3], H[0], H[1], H[2], H[3]}
  od = __builtin_amdgcn_mfma_f32_32x32x16_bf16(pa0, PK(l0, h0), od, 0, 0, 0);
  od = __builtin_amdgcn_mfma_f32_32x32x16_bf16(pa1, PK(l1, h1), od, 0, 0, 0);
  od = __builtin_amdgcn_mfma_f32_32x32x16_bf16(pa2, PK(l2, h2), od, 0, 0, 0);
  od = __builtin_amdgcn_mfma_f32_32x32x16_bf16(pa3, PK(l3, h3), od, 0, 0, 0);
#undef PK
}
__device__ __forceinline__ void pv_d0(f32x16* o, int vb, bf16x8 pa0, bf16x8 pa1, bf16x8 pa2, bf16x8 pa3) {
  pv_one<0>(o[0], vb, pa0, pa1, pa2, pa3); pv_one<1>(o[1], vb, pa0, pa1, pa2, pa3); pv_one<2>(o[2], vb, pa0, pa1, pa2, pa3); pv_one<3>(o[3], vb, pa0, pa1, pa2, pa3);
}

struct Item { int qrow0, qpos0, qcol, gcol, kcol, vcol, n0, r0, r1, NT, kp1, masked, normq, has_sink; float sinkv; };

template <bool MASKED>
__device__ __forceinline__ void attn_item(bf16_t* __restrict__ P, const Item it, const float* __restrict__ qnw, const f32x2* __restrict__ rope, char* lds, const int tid, const bool dry) {
  const int wid = tid >> 6, lane = tid & 63, r32 = lane & 31, hi = lane >> 5;
  constexpr int NBUF = 3;
  char* V_lds = lds; char* K_lds = lds + NBUF * SHM_V;
  float* ws = (float*)(lds + NBUF * (SHM_V + SHM_K)) + wid * 64; float* li_l = ws; float* al_l = ws + 32;
  float m_reg = -1e30f, l_reg = 0; constexpr int NQ = MASKED ? NQR : NQR_U;
  f32x16 o[4] = {}; bf16x8 qr[NQ > 0 ? NQ : 1]; char* ql = lds + NBUF * (SHM_V + SHM_K) + 2048 + tid * 16;
  const int qrow = it.qrow0 + wid * QBLK + r32;
  const int vb0 = (int)(uintptr_t)V_lds + v_rd_base(lane);
  const int widu = __builtin_amdgcn_readfirstlane(wid);
  unsigned koffs[2], voffs[2];
#pragma unroll
  for (int i = 0; i < 2; ++i) { const int ci = (wid * 2 + i) * 64 + lane;
    { const int row = ci >> 4, cc = (ci & 15) ^ (row & 7); koffs[i] = (unsigned)(row * LDP + cc * 8); }
    { const int sub = ci >> 5, kk = (sub >> 2) * 8 + ((ci & 31) >> 2), k = (kk & ~0xC) | ((kk & 4) << 1) | ((kk & 8) >> 1), cv = (sub & 3) * 32 + (ci & 3) * 8; voffs[i] = (unsigned)(k * LDP + cv); } }
#define ALAS __attribute__((address_space(3)))
#define TROW(t) ((size_t)((t) < it.n0 ? it.r0 + 64 * (t) : it.r1 + 64 * ((t) - it.n0)))
#define DMA(t, b) do { const bf16_t* gb_ = P + TROW(t) * LDP; _Pragma("unroll") for (int i_ = 0; i_ < 2; ++i_) {                                  \
    __builtin_amdgcn_global_load_lds((const unsigned*)(gb_ + it.kcol + koffs[i_]), (ALAS unsigned*)(K_lds + (b) * SHM_K + (widu * 2 + i_) * 1024), 16, 0, 0); \
    __builtin_amdgcn_global_load_lds((const unsigned*)(gb_ + it.vcol + voffs[i_]), (ALAS unsigned*)(V_lds + (b) * SHM_V + (widu * 2 + i_) * 1024), 16, 0, 0); } } while (0)
#define LANDED() do { asm volatile("s_waitcnt vmcnt(0)" ::: "memory"); __builtin_amdgcn_s_barrier(); asm volatile("" ::: "memory"); } while (0)
#define RESC(a) do { if (__any((a) < 1.f)) { if (hi == 0) al_l[r32] = (a); asm volatile("s_waitcnt lgkmcnt(0)" ::: "memory"); \
    _Pragma("unroll") for (int d = 0; d < 4; ++d) _Pragma("unroll") for (int r = 0; r < 16; ++r) o[d][r] *= al_l[crow(r, hi)]; } } while (0)
#define WMASK(pa, pb, t) do { if constexpr (MASKED) { if ((t) >= it.n0) wmask(pa, pb, it.kp1 + 64 * ((t) - it.n0), pos_q, hi); } } while (0)
  const int pos_q = it.qpos0 + wid * QBLK + r32;
  f32x16 pA0, pA1, pB0, pB1; float mnA, mnB, alA, alB; bf16x8 pa0, pa1, pa2, pa3; const int NT = it.NT;
  DMA(0, 0); DMA(1, 1);
  {
    const bf16_t* Qw = P + (size_t)qrow * LDP + it.qcol + hi * 8;
    bf16x8 raw[8];
#pragma unroll
    for (int d0 = 0; d0 < 8; ++d0) raw[d0] = *reinterpret_cast<const bf16x8*>(Qw + d0 * 16);
    float rs = 1.f;
    if (it.normq) { float ssq = 0.f;
#pragma unroll
      for (int d0 = 0; d0 < 8; ++d0)
#pragma unroll
        for (int j = 0; j < 8; ++j) { const float v = bf2f((unsigned short)raw[d0][j]); ssq += v * v; }
      ssq += __shfl_xor(ssq, 32);
      rs = rsqrtf(ssq * (1.f / 128.f) + EPS_); }
    const int pos = it.qpos0 + wid * QBLK + r32;
#pragma unroll
    for (int d0 = 0; d0 < 8; ++d0) {
      float v[8];
#pragma unroll
      for (int j = 0; j < 8; ++j) v[j] = bf2f((unsigned short)raw[d0][j]);
      if (it.normq) { const f32x4 w0 = *(const f32x4*)(qnw + d0 * 16 + hi * 8), w1 = *(const f32x4*)(qnw + d0 * 16 + hi * 8 + 4);
#pragma unroll
        for (int j = 0; j < 4; ++j) { v[j] *= rs * w0[j]; v[4 + j] *= rs * w1[j]; } }
      if (it.qpos0 >= 0) { const int tab = d0 < 4 ? (pos >> 6) : (pos & 63); const f32x4* tp = (const f32x4*)(rope + tab * 32 + (d0 & 3) * 8 + hi * 4);
        const f32x4 c01 = tp[0], c23 = tp[1];
        float x0, x1;
        x0 = v[0]; x1 = v[1]; v[0] = x0 * c01[0] - x1 * c01[1]; v[1] = x0 * c01[1] + x1 * c01[0];
        x0 = v[2]; x1 = v[3]; v[2] = x0 * c01[2] - x1 * c01[3]; v[3] = x0 * c01[3] + x1 * c01[2];
        x0 = v[4]; x1 = v[5]; v[4] = x0 * c23[0] - x1 * c23[1]; v[5] = x0 * c23[1] + x1 * c23[0];
        x0 = v[6]; x1 = v[7]; v[6] = x0 * c23[2] - x1 * c23[3]; v[7] = x0 * c23[3] + x1 * c23[2]; }
      u32x4 w = {cvtpk(v[0], v[1]), cvtpk(v[2], v[3]), cvtpk(v[4], v[5]), cvtpk(v[6], v[7])};
      if (d0 < NQ) qr[d0 < NQ ? d0 : 0] = *reinterpret_cast<bf16x8*>(&w); else *reinterpret_cast<u32x4*>(ql + (d0 - NQ) * 8192) = w;
    }
  }
  LANDED();
  qkt<NQ>(pA0, pA1, K_lds, qr, ql, r32, hi); WMASK(pA0, pA1, 0); partialSM(pA0, pA1, m_reg, mnA, alA);
  int b = 1, bp = 0, bn = 2;
  for (int t = 1; t + 1 < NT; t += 2) {
    DMA(t + 1, bn);
    SBAR(); qkt<NQ>(pB0, pB1, K_lds + b * SHM_K, qr, ql, r32, hi); WMASK(pB0, pB1, t);
    finishSM(pA0, pA1, alA, l_reg, pa0, pa1, pa2, pa3); SBAR();
    pv_d0(o, vb0 + bp * (int)SHM_V, pa0, pa1, pa2, pa3); partialSM(pB0, pB1, m_reg, mnB, alB);
    RESC(alB); LANDED();
    bp = b; b = bn; bn = bn == 2 ? 0 : bn + 1;
    DMA(t + 2, bn);
    SBAR(); qkt<NQ>(pA0, pA1, K_lds + b * SHM_K, qr, ql, r32, hi); WMASK(pA0, pA1, t + 1);
    finishSM(pB0, pB1, alB, l_reg, pa0, pa1, pa2, pa3); SBAR();
    pv_d0(o, vb0 + bp * (int)SHM_V, pa0, pa1, pa2, pa3); partialSM(pA0, pA1, m_reg, mnA, alA);
    RESC(alA); LANDED();
    bp = b; b = bn; bn = bn == 2 ? 0 : bn + 1;
  }
  SBAR(); qkt<NQ>(pB0, pB1, K_lds + b * SHM_K, qr, ql, r32, hi); WMASK(pB0, pB1, NT - 1);
  finishSM(pA0, pA1, alA, l_reg, pa0, pa1, pa2, pa3); SBAR();
  pv_d0(o, vb0 + bp * (int)SHM_V, pa0, pa1, pa2, pa3); partialSM(pB0, pB1, m_reg, mnB, alB);
  RESC(alB);
  finishSM(pB0, pB1, alB, l_reg, pa0, pa1, pa2, pa3); SBAR();
  pv_d0(o, vb0 + b * (int)SHM_V, pa0, pa1, pa2, pa3);
  if (it.has_sink) { constexpr float C = SCALE * 1.4426950408889634f; l_reg += __builtin_amdgcn_exp2f(it.sinkv * 1.4426950408889634f - m_reg * C); }
  if (hi == 0) li_l[r32] = l_reg; asm volatile("s_waitcnt lgkmcnt(0)" ::: "memory");
  float rli[16];
#pragma unroll
  for (int r = 0; r < 16; ++r) rli[r] = __builtin_amdgcn_rcpf(li_l[crow(r, hi)]);
  bf16_t* Ow = P + (size_t)(it.qrow0 + wid * QBLK) * LDP;
  __syncthreads();
  {
    char* T = lds + wid * 12288;
#pragma unroll
    for (int r = 0; r < 16; ++r) { const int orow = crow(r, hi);
#pragma unroll
      for (int d0 = 0; d0 < 4; ++d0) *(unsigned short*)(T + orow * 272 + (d0 * 32 + r32) * 2) = f2bf(o[d0][r] * rli[r]); }
    asm volatile("s_waitcnt lgkmcnt(0)" ::: "memory");
    u32x4 gv[8];
#pragma unroll
    for (int k = 0; k < 8; ++k) { const int ci = k * 64 + lane; gv[k] = *(const u32x4*)(Ow + (size_t)(ci >> 4) * LDP + it.gcol + (ci & 15) * 8); }
#pragma unroll
    for (int k = 0; k < 8; ++k) { const int ci = k * 64 + lane; const u32x4 tv = *(const u32x4*)(T + (ci >> 4) * 272 + (ci & 15) * 16); const u32x4 g = gv[k];
      u32x4 w;
      w.x = cvtpk(bflo(tv.x) * silu_f(bflo(g.x)), bfhi(tv.x) * silu_f(bfhi(g.x))); w.y = cvtpk(bflo(tv.y) * silu_f(bflo(g.y)), bfhi(tv.y) * silu_f(bfhi(g.y)));
      w.z = cvtpk(bflo(tv.z) * silu_f(bflo(g.z)), bfhi(tv.z) * silu_f(bfhi(g.z))); w.w = cvtpk(bflo(tv.w) * silu_f(bflo(g.w)), bfhi(tv.w) * silu_f(bfhi(g.w)));
      if (!dry) *(u32x4*)(Ow + (size_t)(ci >> 4) * LDP + it.qcol + (ci & 15) * 8) = w; }
  }
  __syncthreads();
#undef TROW
#undef DMA
#undef LANDED
#undef RESC
#undef WMASK
}
}

struct Ctx {
    int tid, lane, wave, gw, ngw;
    char* lds;
};
#define LDS_WAIT() asm volatile("s_waitcnt lgkmcnt(0)" ::: "memory")

__device__ __forceinline__ void transpose_item(const float* __restrict__ W, int K, int Ntot, int src0, bf16_t* __restrict__ WT, int dst0, int ncols, float* scr, int item, int lane) {
    const int nblk = ncols / 32, kb = item / nblk, nb = item % nblk, k0 = 64 * kb, n0 = 32 * nb;
#pragma unroll 8
    for (int i = 0; i < 32; ++i) { const int kk = 2 * i + (lane >> 5); scr[kk * 33 + (lane & 31)] = __builtin_nontemporal_load(W + (size_t)(k0 + kk) * Ntot + src0 + n0 + (lane & 31)); }
    LDS_WAIT(); asm volatile("" ::: "memory");
    const int c = lane & 7;
#pragma unroll
    for (int j = 0; j < 4; ++j) { const int n = (lane >> 3) + 8 * j; const float* s = scr + (8 * c) * 33 + n;
        u32x4 o; o.x = cvtpk(s[0 * 33], s[1 * 33]); o.y = cvtpk(s[2 * 33], s[3 * 33]); o.z = cvtpk(s[4 * 33], s[5 * 33]); o.w = cvtpk(s[6 * 33], s[7 * 33]);
        *(u32x4*)(WT + (size_t)(dst0 + n0 + n) * K + k0 + 8 * c) = o; }
    LDS_WAIT(); asm volatile("" ::: "memory");
}
__device__ __forceinline__ void convert_weights(const Ctx& c, int l, const float* attn_w_in, const float* attn_w_out, const float* ssm_w_in, const float* ssm_w_out, bf16_t* W1, bf16_t* W2) {
    float* scr = (float*)(c.lds + c.wave * 16384);
    const int i = l >> 1;
    if ((l & 1) == 0) {
        const float* Wi = attn_w_in + (size_t)i * DM * AIN; const float* Wo = attn_w_out + (size_t)i * AW * DM;
        constexpr int I_IN = (DM / 64) * (AIN / 32), I_OUT = (AW / 64) * (DM / 32);
        for (int it = c.gw; it < I_IN + I_OUT; it += c.ngw) {
            if (it < I_IN) {
                const int kb = it / (AIN / 32), nbg = it % (AIN / 32), scol = nbg * 32;
                int src0, ncols, dst0;
                if (scol < 1024) { src0 = 0; ncols = 1024; dst0 = PC_QA; }
                else if (scol < 1280) { src0 = 1024; ncols = 256; dst0 = PC_KA; }
                else if (scol < 1536) { src0 = 1280; ncols = 256; dst0 = PC_VA; }
                else if (scol < 2560) { src0 = 1536; ncols = 1024; dst0 = PC_GA; }
                else if (scol < 3584) { src0 = 2560; ncols = 1024; dst0 = PC_QB; }
                else if (scol < 3840) { src0 = 3584; ncols = 256; dst0 = PC_KB; }
                else if (scol < 4096) { src0 = 3840; ncols = 256; dst0 = PC_VB; }
                else { src0 = 4096; ncols = 1024; dst0 = PC_GB; }
                const int nb = (scol - src0) / 32;
                transpose_item(Wi, DM, AIN, src0, W1, dst0, ncols, scr, kb * (ncols / 32) + nb, c.lane);
            } else transpose_item(Wo, AW, DM, 0, W2, 0, DM, scr, it - I_IN, c.lane);
        }
    } else {
        constexpr int SIN = 6208;
        const float* Wi = ssm_w_in + (size_t)i * DM * SIN; const float* Wo = ssm_w_out + (size_t)i * DI * DM;
        constexpr int I_IN = (DM / 64) * (SIN / 32), I_OUT = (DI / 64) * (DM / 32);
        for (int it = c.gw; it < I_IN + I_OUT; it += c.ngw) {
            if (it < I_IN) {
                const int kb = it / (SIN / 32), nbg = it % (SIN / 32), scol = nbg * 32;
                int src0, ncols, dst0;
                if (scol < 2048) { src0 = 0; ncols = 2048; dst0 = NXB; }
                else if (scol < 6144) { src0 = 2048; ncols = 4096; dst0 = 0; }
                else { src0 = 6144; ncols = 64; dst0 = 4096; }
                const int nb = (scol - src0) / 32;
                transpose_item(Wi, DM, SIN, src0, W1, dst0, ncols, scr, kb * (ncols / 32) + nb, c.lane);
            } else transpose_item(Wo, DI, DM, 0, W2, 0, DM, scr, it - I_IN, c.lane);
        }
    }
}

__device__ __forceinline__ void adaln_phase(const Ctx& c, const float* cvec, const float* cctx, const float* w_ada, const float* b_ada, float* MOD) {
    float* sv = (float*)c.lds;
    float* red = (float*)(c.lds + 5 * 1024 * 4);
    bool have = false;
    for (int it = blockIdx.x; it < DEPTH_ * 48; it += gridDim.x) {
        if (!have) { for (int e = c.tid; e < 5 * 1024; e += 512) { const float v = e < 4096 ? cvec[e] : cctx[e - 4096]; sv[e] = silu_f(v); } have = true; __syncthreads(); }
        const int l = it / 48, col = (it % 48) * 64 + c.lane;
        const float* wp = w_ada + ((size_t)l * DM + c.wave * 128) * 3072 + col;
        float a0 = 0, a1 = 0, a2 = 0, a3 = 0, a4 = 0;
#pragma unroll 8
        for (int k = 0; k < 128; ++k) { const float w = __builtin_nontemporal_load(wp + (size_t)k * 3072); const int kk = c.wave * 128 + k;
            a0 += sv[kk] * w; a1 += sv[1024 + kk] * w; a2 += sv[2048 + kk] * w; a3 += sv[3072 + kk] * w; a4 += sv[4096 + kk] * w; }
        float* rp = red + (c.wave * 5) * 64 + c.lane;
        rp[0] = a0; rp[64] = a1; rp[128] = a2; rp[192] = a3; rp[256] = a4;
        __syncthreads();
        if (c.tid < 320) { const int who = c.tid >> 6, ln = c.tid & 63; float s = b_ada[(size_t)l * 3072 + (it % 48) * 64 + ln];
#pragma unroll
            for (int w = 0; w < 8; ++w) s += red[(w * 5 + who) * 64 + ln];
            MOD[((size_t)l * 5 + who) * 3072 + (it % 48) * 64 + ln] = s; }
        __syncthreads();
    }
}
__device__ __forceinline__ void rope_phase(const Ctx& c, f32x2* rope) {
    for (int e = blockIdx.x * 512 + c.tid; e < 128 * 32; e += gridDim.x * 512) { const int pos = e >> 5, f = e & 31;
        const float inv = 1.0f / powf(10000.0f, (float)f / 32.0f); const float ang = (float)pos * inv;
        rope[e] = (f32x2){cosf(ang), sinf(ang)}; }
}

__device__ __forceinline__ void norm_pass(const Ctx& c, int l, const float* xin, float* xout, const float* cin, float* cout, bf16_t* HY, const float* MOD, const float* norm_pre, const float* norm_post, bool do_ctx, const bool dry) {
    const bool have_y = l >= 0, have_h = l + 1 < DEPTH_;
    const int nchunks = MLAT / 16 + (do_ctx ? MCTX : 0);
    for (int ch = c.gw; ch < nchunks; ch += c.ngw) {
        const bool isctx = ch >= MLAT / 16; const int row0 = isctx ? (ch - MLAT / 16) : ch * 16; const int who = isctx ? 4 : (row0 / T_); const int nrow = isctx ? 1 : 16;
        const float* xi = isctx ? cin : xin; float* xo = isctx ? cout : xout; const int hrow0 = isctx ? MLAT + row0 : row0;
        f32x4 A1[4], A2[4], A3[4];
#pragma unroll
        for (int j = 0; j < 4; ++j) { const int col = 4 * c.lane + 256 * j;
            if (have_y) { const f32x4 gt = *(const f32x4*)(MOD + ((size_t)l * 5 + who) * 3072 + 2048 + col); const f32x4 pw = *(const f32x4*)(norm_post + (size_t)l * DM + col); A1[j] = gt * pw; }
            if (have_h) { const f32x4 sh = *(const f32x4*)(MOD + ((size_t)(l + 1) * 5 + who) * 3072 + col), sc = *(const f32x4*)(MOD + ((size_t)(l + 1) * 5 + who) * 3072 + 1024 + col);
                const f32x4 pw = *(const f32x4*)(norm_pre + (size_t)(l + 1) * DM + col); A2[j] = pw * (sc + 1.0f); A3[j] = sh; } }
        f32x4 nx[4]; u32x2 ny[4];
#pragma unroll
        for (int j = 0; j < 4; ++j) { nx[j] = __builtin_nontemporal_load((const f32x4*)(xi + (size_t)row0 * DM + 4 * c.lane + 256 * j)); if (have_y) ny[j] = __builtin_nontemporal_load((const u32x2*)(HY + (size_t)hrow0 * DM + 4 * c.lane + 256 * j)); }
        for (int r = 0; r < nrow; ++r) {
            const size_t xoff = (size_t)(row0 + r) * DM, hoff = (size_t)(hrow0 + r) * DM;
            f32x4 x[4]; u32x2 yw[4];
#pragma unroll
            for (int j = 0; j < 4; ++j) { x[j] = nx[j]; yw[j] = ny[j]; }
            if (r + 1 < nrow) {
#pragma unroll
                for (int j = 0; j < 4; ++j) { nx[j] = __builtin_nontemporal_load((const f32x4*)(xi + xoff + DM + 4 * c.lane + 256 * j)); if (have_y) ny[j] = __builtin_nontemporal_load((const u32x2*)(HY + hoff + DM + 4 * c.lane + 256 * j)); } }
            if (have_y) {
                f32x4 y[4]; float ssq = 0.f;
#pragma unroll
                for (int j = 0; j < 4; ++j) { const u32x2 w = yw[j]; y[j] = (f32x4){bflo(w.x), bfhi(w.x), bflo(w.y), bfhi(w.y)};
                    ssq += (y[j][0] * y[j][0] + y[j][1] * y[j][1]) + (y[j][2] * y[j][2] + y[j][3] * y[j][3]); }
                const float rs = rsqrtf(wave_sum(ssq) * (1.f / DM) + EPS_);
#pragma unroll
                for (int j = 0; j < 4; ++j) { x[j] = x[j] + A1[j] * (y[j] * rs); if (!dry) __builtin_nontemporal_store(x[j], (f32x4*)(xo + xoff + 4 * c.lane + 256 * j)); }
            }
            if (have_h) {
                float ssq = 0.f;
#pragma unroll
                for (int j = 0; j < 4; ++j) ssq += (x[j][0] * x[j][0] + x[j][1] * x[j][1]) + (x[j][2] * x[j][2] + x[j][3] * x[j][3]);
                const float rs = rsqrtf(wave_sum(ssq) * (1.f / DM) + EPS_);
#pragma unroll
                for (int j = 0; j < 4; ++j) { const f32x4 h = x[j] * rs * A2[j] + A3[j]; u32x2 w; w.x = cvtpk(h[0], h[1]); w.y = cvtpk(h[2], h[3]); if (!dry) *(u32x2*)(HY + hoff + 4 * c.lane + 256 * j) = w; }
            }
        }
    }
}

__device__ __forceinline__ void kprep_pass(const Ctx& c, bf16_t* P, const float* knw, const f32x2* rope, const bool dry) {
    const int hsel = c.lane >> 4, e0 = (c.lane & 15) * 8;
    const int col = (hsel < 2 ? PC_KA + hsel * 128 : PC_KB + (hsel - 2) * 128) + e0;
    const f32x4 w0 = *(const f32x4*)(knw + e0), w1 = *(const f32x4*)(knw + e0 + 4);
    for (int row0 = c.gw; row0 < MTOT; row0 += 2 * c.ngw) {
        const int row1 = row0 + c.ngw; const bool two = row1 < MTOT;
        const u32x4 rawA = *(const u32x4*)(P + (size_t)row0 * AIN + col);
        const u32x4 rawB = two ? *(const u32x4*)(P + (size_t)row1 * AIN + col) : (u32x4){0u, 0u, 0u, 0u};
#pragma unroll
        for (int half = 0; half < 2; ++half) {
        if (half == 1 && !two) break;
        const int row = half ? row1 : row0; const u32x4 raw = half ? rawB : rawA;
        bf16_t* p = P + (size_t)row * AIN + col;
        float v[8] = {bflo(raw.x), bfhi(raw.x), bflo(raw.y), bfhi(raw.y), bflo(raw.z), bfhi(raw.z), bflo(raw.w), bfhi(raw.w)};
        if (hsel >= 2) { float ssq = 0.f;
#pragma unroll
            for (int j = 0; j < 8; ++j) ssq += v[j] * v[j];
            ssq += __shfl_xor(ssq, 1); ssq += __shfl_xor(ssq, 2); ssq += __shfl_xor(ssq, 4); ssq += __shfl_xor(ssq, 8);
            const float rs = rsqrtf(ssq * (1.f / 128.f) + EPS_);
#pragma unroll
            for (int j = 0; j < 4; ++j) { v[j] *= rs * w0[j]; v[4 + j] *= rs * w1[j]; } }
        if (row < MLAT) { const int pos = row & (T_ - 1), i0 = e0 >> 1; const int tab = i0 < 32 ? (pos >> 6) : (pos & 63);
            const f32x4* tp = (const f32x4*)(rope + tab * 32 + (i0 & 31)); const f32x4 c01 = tp[0], c23 = tp[1];
            float x0, x1;
            x0 = v[0]; x1 = v[1]; v[0] = x0 * c01[0] - x1 * c01[1]; v[1] = x0 * c01[1] + x1 * c01[0];
            x0 = v[2]; x1 = v[3]; v[2] = x0 * c01[2] - x1 * c01[3]; v[3] = x0 * c01[3] + x1 * c01[2];
            x0 = v[4]; x1 = v[5]; v[4] = x0 * c23[0] - x1 * c23[1]; v[5] = x0 * c23[1] + x1 * c23[0];
            x0 = v[6]; x1 = v[7]; v[6] = x0 * c23[2] - x1 * c23[3]; v[7] = x0 * c23[3] + x1 * c23[2]; }
        if (!dry && (hsel >= 2 || row < MLAT)) { u32x4 w = {cvtpk(v[0], v[1]), cvtpk(v[2], v[3]), cvtpk(v[4], v[5]), cvtpk(v[6], v[7])}; *(u32x4*)p = w; }
        }
    }
}

__device__ __forceinline__ void conv_pass(const Ctx& c, bf16_t* X, const bf16_t* halo, const float* cw, const float* cb, const bool dry) {
    for (int u = blockIdx.x; u < (MTOT / 128) * 4; u += gridDim.x) {
        const int ck = u >> 2, q = u & 3, strip = c.tid & 127, rg = c.tid >> 7, col = q * 1024 + strip * 8, row0 = ck * 128 + rg * 32;
        const bool seq_start = ck < 256 ? (ck & 63) == 0 : ((ck - 256) & 1) == 0, seq_end = ck < 256 ? (ck & 63) == 63 : ((ck - 256) & 1) == 1;
        float w0[8], w1[8], w2[8], bs[8];
#pragma unroll
        for (int j = 0; j < 8; ++j) { w0[j] = cw[col + j]; w1[j] = cw[CONVD + col + j]; w2[j] = cw[2 * CONVD + col + j]; bs[j] = cb[col + j]; }
        u32x4 prev = {0u, 0u, 0u, 0u}, last = {0u, 0u, 0u, 0u};
        if (rg == 0) { if (!seq_start) prev = *(const u32x4*)(halo + ((size_t)(ck - 1) * 2 + 1) * CONVD + col); } else prev = *(const u32x4*)(X + (size_t)(row0 - 1) * CONVD + col);
        if (rg == 3) { if (!seq_end) last = *(const u32x4*)(halo + ((size_t)(ck + 1) * 2 + 0) * CONVD + col); } else last = *(const u32x4*)(X + (size_t)(row0 + 32) * CONVD + col);
        u32x4 cur = *(const u32x4*)(X + (size_t)row0 * CONVD + col);
        asm volatile("s_waitcnt vmcnt(0)" ::: "memory");
        __syncthreads();
        for (int ib = 0; ib < 4; ++ib) {
            u32x4 nx[8];
#pragma unroll
            for (int i = 0; i < 8; ++i) { const int r = ib * 8 + i + 1; nx[i] = (r < 32) ? *(const u32x4*)(X + (size_t)(row0 + r) * CONVD + col) : last; }
#pragma unroll
            for (int i = 0; i < 8; ++i) {
                const u32x4 n = nx[i];
                const float pv[8] = {bflo(prev.x), bfhi(prev.x), bflo(prev.y), bfhi(prev.y), bflo(prev.z), bfhi(prev.z), bflo(prev.w), bfhi(prev.w)};
                const float cv[8] = {bflo(cur.x), bfhi(cur.x), bflo(cur.y), bfhi(cur.y), bflo(cur.z), bfhi(cur.z), bflo(cur.w), bfhi(cur.w)};
                const float nv[8] = {bflo(n.x), bfhi(n.x), bflo(n.y), bfhi(n.y), bflo(n.z), bfhi(n.z), bflo(n.w), bfhi(n.w)};
                float o[8];
#pragma unroll
                for (int j = 0; j < 8; ++j) o[j] = silu_f(bs[j] + w0[j] * pv[j] + w1[j] * cv[j] + w2[j] * nv[j]);
                u32x4 w = {cvtpk(o[0], o[1]), cvtpk(o[2], o[3]), cvtpk(o[4], o[5]), cvtpk(o[6], o[7])};
                if (!dry) *(u32x4*)(X + (size_t)(row0 + ib * 8 + i) * CONVD + col) = w;
                prev = cur; cur = n;
            }
        }
    }
}

__device__ __forceinline__ void gnorm_pass(const Ctx& c, bf16_t* Y, const bf16_t* Z, const float* nw, const int nrows, const bool dry) {
    f32x4 w[8];
#pragma unroll
    for (int j = 0; j < 8; ++j) w[j] = *(const f32x4*)(nw + 256 * j + 4 * c.lane);
    for (int row = c.gw; row < nrows; row += c.ngw) {
        const size_t off = (size_t)row * DI + 4 * c.lane;
        u32x2 yv[8], zv[8];
#pragma unroll
        for (int j = 0; j < 8; ++j) { yv[j] = *(const u32x2*)(Y + off + 256 * j); zv[j] = *(const u32x2*)(Z + off + 256 * j); }
#pragma unroll
        for (int j = 0; j < 8; ++j) {
            f32x4 g = {bflo(yv[j].x) * silu_f(bflo(zv[j].x)), bfhi(yv[j].x) * silu_f(bfhi(zv[j].x)), bflo(yv[j].y) * silu_f(bflo(zv[j].y)), bfhi(yv[j].y) * silu_f(bfhi(zv[j].y))};
            const float ssq = wave_sum((g[0] * g[0] + g[1] * g[1]) + (g[2] * g[2] + g[3] * g[3]));
            const float rs = rsqrtf(ssq * (1.f / 256.f) + EPS_);
            g = g * rs * w[j];
            u32x2 o; o.x = cvtpk(g[0], g[1]); o.y = cvtpk(g[2], g[3]); if (!dry) *(u32x2*)(Y + off + 256 * j) = o;
        }
    }
}

namespace ssd {
constexpr int RS = 272;
constexpr int O_CN = 0, O_BN = 34816, O_GP = 69632, O_XDT = 104448, O_XW = 112640, O_XN = 120832, O_HS = 129024, O_CUM = 137728, LDS_SSD = O_CUM + 1024;
#define MF32(a, b, c) __builtin_amdgcn_mfma_f32_32x32x16_bf16(a, b, c, 0, 0, 0)
#define PK8(L, H) (bf16x8){L[0], L[1], L[2], L[3], H[0], H[1], H[2], H[3]}
__device__ __forceinline__ u32x2 pack4(float a, float b, float c, float d) { u32x2 w; w.x = cvtpk(a, b); w.y = cvtpk(c, d); return w; }


#define RDL(x, n) __uint_as_float((unsigned)__builtin_amdgcn_readlane((int)__float_as_uint(x), (n)))
__device__ __forceinline__ float wave_scan_incl(float v, int lane) {
#define DPP_SHR(x, n) __uint_as_float((unsigned)__builtin_amdgcn_update_dpp(0, (int)__float_as_uint(x), 0x110 + (n), 0xf, 0xf, true))
    v += DPP_SHR(v, 1); v += DPP_SHR(v, 2); v += DPP_SHR(v, 4); v += DPP_SHR(v, 8);
#undef DPP_SHR
    const float t0 = RDL(v, 15), t1 = RDL(v, 31), t2 = RDL(v, 47);
    const int row = lane >> 4;
    v += row == 1 ? t0 : row == 2 ? t0 + t1 : row == 3 ? (t0 + t1) + t2 : 0.f;
    return v;
}
template <int KK0> __device__ __forceinline__ void state_steps(f32x16& S, int base_b, int base_w) {
    using att::tr_read;
    const s16x4 a0l = tr_read<(KK0 + 0) * 16 * RS>(base_b), a0h = tr_read<(KK0 + 0) * 16 * RS + 4 * RS>(base_b), a1l = tr_read<(KK0 + 1) * 16 * RS>(base_b), a1h = tr_read<(KK0 + 1) * 16 * RS + 4 * RS>(base_b);
    const s16x4 a2l = tr_read<(KK0 + 2) * 16 * RS>(base_b), a2h = tr_read<(KK0 + 2) * 16 * RS + 4 * RS>(base_b), a3l = tr_read<(KK0 + 3) * 16 * RS>(base_b), a3h = tr_read<(KK0 + 3) * 16 * RS + 4 * RS>(base_b);
    const s16x4 b0l = tr_read<(KK0 + 0) * 1024>(base_w), b0h = tr_read<(KK0 + 0) * 1024 + 256>(base_w), b1l = tr_read<(KK0 + 1) * 1024>(base_w), b1h = tr_read<(KK0 + 1) * 1024 + 256>(base_w);
    const s16x4 b2l = tr_read<(KK0 + 2) * 1024>(base_w), b2h = tr_read<(KK0 + 2) * 1024 + 256>(base_w), b3l = tr_read<(KK0 + 3) * 1024>(base_w), b3h = tr_read<(KK0 + 3) * 1024 + 256>(base_w);
    asm volatile("s_waitcnt lgkmcnt(0)" ::: "memory"); SBAR();
    S = MF32(PK8(a0l, a0h), PK8(b0l, b0h), S); S = MF32(PK8(a1l, a1h), PK8(b1l, b1h), S);
    S = MF32(PK8(a2l, a2h), PK8(b2l, b2h), S); S = MF32(PK8(a3l, a3h), PK8(b3l, b3h), S);
}
template <int KK0> __device__ __forceinline__ void ydiag_steps(f32x16& acc, int base_x, const char* gp_row) {
    using att::tr_read;
    const s16x4 a0l = tr_read<(KK0 + 0) * 1024>(base_x), a0h = tr_read<(KK0 + 0) * 1024 + 256>(base_x), a1l = tr_read<(KK0 + 1) * 1024>(base_x), a1h = tr_read<(KK0 + 1) * 1024 + 256>(base_x);
    const s16x4 a2l = tr_read<(KK0 + 2) * 1024>(base_x), a2h = tr_read<(KK0 + 2) * 1024 + 256>(base_x), a3l = tr_read<(KK0 + 3) * 1024>(base_x), a3h = tr_read<(KK0 + 3) * 1024 + 256>(base_x);
    asm volatile("s_waitcnt lgkmcnt(0)" ::: "memory"); SBAR();
    const bf16x8 b0 = *(const bf16x8*)(gp_row + (KK0 + 0) * 32), b1 = *(const bf16x8*)(gp_row + (KK0 + 1) * 32), b2 = *(const bf16x8*)(gp_row + (KK0 + 2) * 32), b3 = *(const bf16x8*)(gp_row + (KK0 + 3) * 32);
    acc = MF32(PK8(a0l, a0h), b0, acc); acc = MF32(PK8(a1l, a1h), b1, acc); acc = MF32(PK8(a2l, a2h), b2, acc); acc = MF32(PK8(a3l, a3h), b3, acc);
}

__device__ __forceinline__ void scan_phase(const Ctx& c, const int dir, const bf16_t* __restrict__ X, const float* __restrict__ DT, bf16_t* __restrict__ Y, const float* __restrict__ a_log, const float* __restrict__ dskip, const bool dry, const int pvar) {
    char* L = c.lds; float* cumL = (float*)(L + O_CUM);
    const int tid = c.tid, lane = c.lane, wave = c.wave, r32 = lane & 31, hi = lane >> 5;
    const int blk = (lane >> 4) & 1, qq = (lane & 15) >> 2, pp = lane & 3;
    for (int item = blockIdx.x; item < 256; item += gridDim.x) {
        const int xcd_ = item & 7, slot_ = item >> 3, grp_ = xcd_ + 8 * (slot_ >> 3), mem_ = slot_ & 7;
        const int ph = mem_ & 1, b = grp_ >> 3, g = grp_ & 7, h = 4 * g + (mem_ >> 1);
        const float Acoef = -__expf(a_log[dir * 32 + h]), Dh = dskip[h];
        const int xcol = h * 64 + ph * 32, bcol = 2048 + g * 128, ccol = 3072 + g * 128, dtcol = dir * 32 + h;
        f32x16 S = {};
        bf16x8 rc[4], rb[4], rx; float d0r, d1r;
#define CHUNK_ROW(q) ((q) < 2 ? MLAT + b * CL + (dir == 0 ? (q) : 1 - (q)) * 128 : b * T_ + (dir == 0 ? (q) - 2 : 65 - (q)) * 128)
#define LOADCHUNK(q) do { const int R_ = CHUNK_ROW(q);                                                                         \
        _Pragma("unroll") for (int i = 0; i < 4; ++i) { const size_t ro = (size_t)(R_ + (tid >> 4) + 32 * i) * CONVD + (tid & 15) * 8;     \
            rc[i] = *(const bf16x8*)(X + ro + ccol); rb[i] = *(const bf16x8*)(X + ro + bcol); }                                \
        rx = *(const bf16x8*)(X + (size_t)(R_ + (tid >> 2)) * CONVD + xcol + (tid & 3) * 8);                                    \
        d0r = DT[(size_t)dtcol * MTOT + R_ + lane]; d1r = DT[(size_t)dtcol * MTOT + R_ + 64 + lane]; } while (0)
        LOADCHUNK(0);
        for (int q = 0; q < 66; ++q) {
            const int R0 = CHUNK_ROW(q);
            const float a0 = d0r * Acoef, a1 = d1r * Acoef;
            float p0 = wave_scan_incl(a0, lane), p1 = wave_scan_incl(a1, lane);
            p1 += RDL(p0, 63);
            const float tot = RDL(p1, 63);
            float c0, c1;
            if (dir == 0) { c0 = p0; c1 = p1; } else { c0 = tot - p0 + a0; c1 = tot - p1 + a1; }
            if (wave == 0) { cumL[lane] = c0; cumL[64 + lane] = c1; }
#pragma unroll
            for (int i = 0; i < 4; ++i) { const int off = ((tid >> 4) + 32 * i) * RS + (tid & 15) * 16;
                *(bf16x8*)(L + O_CN + off) = rc[i]; *(bf16x8*)(L + O_BN + off) = rb[i]; }
            {
                const int sl = (tid >> 2) & 63;
                const float dts = __shfl(wave < 4 ? d0r : d1r, sl), cums = __shfl(wave < 4 ? c0 : c1, sl);
                const float wend = dts * __expf(tot - cums);
                float xv[8];
#pragma unroll
                for (int j = 0; j < 8; ++j) xv[j] = bf2f((unsigned short)rx[j]);
                const int xo = (tid >> 2) * 64 + (tid & 3) * 16;
                *(bf16x8*)(L + O_XN + xo) = rx;
                u32x4 w1 = {cvtpk(xv[0] * dts, xv[1] * dts), cvtpk(xv[2] * dts, xv[3] * dts), cvtpk(xv[4] * dts, xv[5] * dts), cvtpk(xv[6] * dts, xv[7] * dts)};
                u32x4 w2 = {cvtpk(xv[0] * wend, xv[1] * wend), cvtpk(xv[2] * wend, xv[3] * wend), cvtpk(xv[4] * wend, xv[5] * wend), cvtpk(xv[6] * wend, xv[7] * wend)};
                *(u32x4*)(L + O_XDT + xo) = w1; *(u32x4*)(L + O_XW + xo) = w2;
            }
            if (q + 1 < 66) LOADCHUNK(q + 1);
            __syncthreads();
            if (!(dry && pvar == 1)) {
            if (wave >= 4) { const int nb = (wave - 4) * 32;
#pragma unroll
                for (int qd = 0; qd < 4; ++qd) *(u32x2*)(L + O_HS + r32 * RS + (nb + 8 * qd + 4 * hi) * 2) = pack4(S[4 * qd], S[4 * qd + 1], S[4 * qd + 2], S[4 * qd + 3]); }
            {
                const int sb = wave >> 1, lb0 = 2 * (wave & 1);
                const char* ap = L + O_BN + (sb * 32 + r32) * RS + hi * 16; const char* bp0 = L + O_CN + (lb0 * 32 + r32) * RS + hi * 16; const char* bp1 = bp0 + 32 * RS;
                bf16x8 fa[8], fb0[8], fb1[8];
#pragma unroll
                for (int kk = 0; kk < 8; ++kk) { fa[kk] = *(const bf16x8*)(ap + kk * 32); fb0[kk] = *(const bf16x8*)(bp0 + kk * 32); fb1[kk] = *(const bf16x8*)(bp1 + kk * 32); }
                f32x16 acc0 = {}, acc1 = {};
#pragma unroll
                for (int kk = 0; kk < 8; ++kk) { acc0 = MF32(fa[kk], fb0[kk], acc0); acc1 = MF32(fa[kk], fb1[kk], acc1); }
#pragma unroll
                for (int tt = 0; tt < 2; ++tt) {
                    const int lb = lb0 + tt, l = lb * 32 + r32; const float cl = cumL[l];
#pragma unroll
                    for (int qd = 0; qd < 4; ++qd) { float v[4];
#pragma unroll
                        for (int e = 0; e < 4; ++e) { const int s_ = sb * 32 + 8 * qd + 4 * hi + e; const float cs = cumL[s_];
                            const float av = tt == 0 ? acc0[4 * qd + e] : acc1[4 * qd + e];
                            const bool valid = dir == 0 ? (s_ <= l) : (s_ >= l); v[e] = valid ? av * __expf(cl - cs) : 0.f; }
                        *(u32x2*)(L + O_GP + l * RS + (sb * 32 + 8 * qd + 4 * hi) * 2) = pack4(v[0], v[1], v[2], v[3]); }
                }
            }
            }
            __syncthreads();
            if (dry && pvar >= 1) { } else
            if (wave < 4) {
                const int l = wave * 32 + r32;
                f32x16 aoff = {}, adg = {};
                bf16_t* yp = Y + (size_t)(R0 + l) * DI + xcol;
                u32x2 pvv[4] = {};
                if (dir == 0) {
#pragma unroll
                    for (int qd = 0; qd < 4; ++qd) pvv[qd] = *(const u32x2*)(yp + 8 * qd + 4 * hi); }
                const char* hp = L + O_HS + r32 * RS + hi * 16; const char* cp = L + O_CN + l * RS + hi * 16;
                {
                    bf16x8 fh[8], fc[8];
#pragma unroll
                    for (int kk = 0; kk < 8; ++kk) { fh[kk] = *(const bf16x8*)(hp + kk * 32); fc[kk] = *(const bf16x8*)(cp + kk * 32); }
#pragma unroll
                    for (int kk = 0; kk < 8; ++kk) aoff = MF32(fh[kk], fc[kk], aoff);
                }
                const int base_x = (int)(uintptr_t)(L + O_XDT) + (8 * hi + qq) * 64 + (16 * blk + 4 * pp) * 2;
                const char* gp_row = L + O_GP + l * RS + hi * 16;
                ydiag_steps<0>(adg, base_x, gp_row); ydiag_steps<4>(adg, base_x, gp_row);
                const float ec = __expf(cumL[l]);
#pragma unroll
                for (int qd = 0; qd < 4; ++qd) { const int pc = 8 * qd + 4 * hi; float v[4];
#pragma unroll
                    for (int e = 0; e < 4; ++e) v[e] = aoff[4 * qd + e] * ec + adg[4 * qd + e];
                    if (dir == 0) { const u32x2 xn = *(const u32x2*)(L + O_XN + l * 64 + pc * 2); const u32x2 pv = pvv[qd];
                        v[0] += Dh * bflo(xn.x) + bflo(pv.x); v[1] += Dh * bfhi(xn.x) + bfhi(pv.x); v[2] += Dh * bflo(xn.y) + bflo(pv.y); v[3] += Dh * bfhi(xn.y) + bfhi(pv.y); }
                    if (!dry) *(u32x2*)(yp + pc) = pack4(v[0], v[1], v[2], v[3]); }
            } else {
                const int nb = (wave - 4) * 32; const float dec = __expf(tot);
#pragma unroll
                for (int r = 0; r < 16; ++r) S[r] *= dec;
                const int base_b = (int)(uintptr_t)(L + O_BN) + (8 * hi + qq) * RS + (nb + 16 * blk + 4 * pp) * 2;
                const int base_w = (int)(uintptr_t)(L + O_XW) + (8 * hi + qq) * 64 + (16 * blk + 4 * pp) * 2;
                state_steps<0>(S, base_b, base_w); state_steps<4>(S, base_b, base_w);
            }
            __syncthreads();
        }
#undef CHUNK_ROW
#undef LOADCHUNK
    }
}
}

constexpr int LDS_BYTES = 163840;
#ifndef PROBE_OP
#define PROBE_OP -1
#endif
struct Args { const float* in[21]; float* out; unsigned char* ws; long probe; };

enum Op { OP_GEMM_BF16 = 0, OP_GEMM_XBC, OP_GEMM_IN, OP_ATTN, OP_CONV, OP_SCAN, OP_GEMM_Z, OP_NORM, OP_PROLOGUE };

__device__ __forceinline__ void attn_phase(const Ctx& c, int li, bf16_t* P, const float* sink, const float* qnw, const f32x2* rope, const bool dry, const int pvar) {
    for (int i = blockIdx.x; i < 2112; i += gridDim.x) {
        att::Item it;
        if (i < 2048) {
            const int ii = i & 1023, x = ii & 7, wi = (ii >> 3) & 31, k = ii >> 8, b = x >> 1, kvh = x & 1, head = kvh * 4 + k, i0 = wi * 256;
            const bool mixB = i < 1024;
            it.qrow0 = b * T_ + i0; it.qpos0 = i0;
            if (mixB) { it.qcol = PC_QB + head * 128; it.gcol = PC_GB + head * 128; it.kcol = PC_KB + kvh * 128; it.vcol = PC_VB + kvh * 128;
                it.n0 = T_ / 64; it.r0 = b * T_; it.r1 = MLAT + b * CL; it.NT = T_ / 64 + CL / 64; it.kp1 = 0; it.masked = 0; it.normq = 1; it.has_sink = 0; it.sinkv = 0.f; }
            else { const int ks = i0 >= 128 ? i0 - 128 : 0, ke = i0 + 384 <= T_ ? i0 + 384 : T_;
                it.qcol = PC_QA + head * 128; it.gcol = PC_GA + head * 128; it.kcol = PC_KA + kvh * 128; it.vcol = PC_VA + kvh * 128;
                it.n0 = CL / 64; it.r0 = MLAT + b * CL; it.r1 = b * T_ + ks; it.NT = CL / 64 + (ke - ks) / 64; it.kp1 = ks; it.masked = 1; it.normq = 0; it.has_sink = 1; it.sinkv = sink[head]; }
        } else {
            const int j = i - 2048, head = j & 7, mixB = (j >> 3) & 1, b = j >> 4, kvh = head >> 2;
            it.qrow0 = MLAT + b * CL; it.qpos0 = -1; it.n0 = CL / 64; it.r0 = MLAT + b * CL; it.r1 = 0; it.NT = CL / 64; it.kp1 = 0; it.masked = 0;
            if (mixB) { it.qcol = PC_QB + head * 128; it.gcol = PC_GB + head * 128; it.kcol = PC_KB + kvh * 128; it.vcol = PC_VB + kvh * 128; it.normq = 1; it.has_sink = 0; it.sinkv = 0.f; }
            else { it.qcol = PC_QA + head * 128; it.gcol = PC_GA + head * 128; it.kcol = PC_KA + kvh * 128; it.vcol = PC_VA + kvh * 128; it.normq = 0; it.has_sink = 1; it.sinkv = sink[head]; }
        }
        if (it.masked) att::attn_item<true>(P, it, qnw, rope, c.lds, c.tid, dry); else att::attn_item<false>(P, it, qnw, rope, c.lds, c.tid, dry);
    }
}

__global__ void __launch_bounds__(512) mega(Args a) {
    extern __shared__ __attribute__((aligned(16))) unsigned char lds_[];
    cg::grid_group grid = cg::this_grid();
    volatile XLAS unsigned* bst = (volatile XLAS unsigned*)((XLAS unsigned char*)lds_ + (LDS_BYTES - 16));
    if (threadIdx.x < 4) bst[threadIdx.x] = 0u;
    __syncthreads();
    XcdBarrier xbar = xcd_barrier_post((unsigned*)a.ws, bst);
    int nsync = 0;
    unsigned char* ws = a.ws;
    float* MOD = (float*)(ws + WS_MOD); f32x2* ROPE = (f32x2*)(ws + WS_ROPE); float* CTXR = (float*)(ws + WS_CTX);
    bf16_t* W1 = (bf16_t*)(ws + WS_W1); bf16_t* W2 = (bf16_t*)(ws + WS_W2); bf16_t* HY = (bf16_t*)(ws + WS_HY);
    float* DTB = (float*)(ws + WS_DT); bf16_t* HALO = (bf16_t*)(ws + WS_HALO); bf16_t* BIG = (bf16_t*)(ws + WS_BIG); bf16_t* YB = (bf16_t*)(ws + WS_Y);
    const float* x_in = a.in[0]; const float* cvec = a.in[1]; const float* ctx_in = a.in[2]; const float* c_ctx = a.in[3]; const float* w_ada = a.in[4]; const float* b_ada = a.in[5];
    const float* norm_pre = a.in[6]; const float* norm_post = a.in[7]; const float* attn_w_in = a.in[8]; const float* attn_w_out = a.in[9]; const float* attn_sink = a.in[10];
    const float* attn_qn = a.in[11]; const float* attn_kn = a.in[12]; const float* ssm_w_in = a.in[13]; const float* conv_w = a.in[14]; const float* conv_b = a.in[15];
    const float* dt_bias = a.in[16]; const float* a_log = a.in[17]; const float* ssm_d = a.in[18]; const float* ssm_norm = a.in[19]; const float* ssm_w_out = a.in[20];

    int l = -1, st = 0;
    for (;;) {
        int op; const bool ssm = (l & 1) != 0 && l >= 0;
        if (l < 0) op = st == 0 ? OP_PROLOGUE : OP_NORM;
        else if (!ssm) op = st == 0 ? OP_GEMM_IN : st == 1 ? OP_ATTN : st == 2 ? OP_GEMM_BF16 : OP_NORM;
        else op = st == 0 ? OP_GEMM_XBC : st == 1 ? OP_CONV : (st == 2 || st == 3) ? OP_SCAN : st == 4 ? OP_GEMM_Z : st == 5 ? OP_GEMM_BF16 : OP_NORM;
        const int li = l >> 1;
        {
        constexpr bool dry = false;
        int tid_ = threadIdx.x; asm volatile("" : "+v"(tid_));
        Ctx c; c.tid = tid_; c.lane = c.tid & 63; c.wave = __builtin_amdgcn_readfirstlane(c.tid >> 6); c.gw = blockIdx.x * 8 + c.wave; c.ngw = gridDim.x * 8; c.lds = (char*)lds_;
        switch (op) {
#ifndef DIS_PRO
        case OP_PROLOGUE: {
            convert_weights(c, 0, attn_w_in, attn_w_out, ssm_w_in, ssm_w_out, W1, W2);
            __syncthreads();
            adaln_phase(c, cvec, c_ctx, w_ada, b_ada, MOD);
            rope_phase(c, ROPE);
        } break;
#endif
#ifndef DIS_NORM
        case OP_NORM: {
            const bool first = l <= 0;
            norm_pass(c, l, first ? x_in : a.out, a.out, first ? ctx_in : CTXR, CTXR, HY, MOD, norm_pre, norm_post, l < DEPTH_ - 1, dry);
            if (!dry && l >= 0 && l + 1 < DEPTH_) { __syncthreads(); convert_weights(c, l + 1, attn_w_in, attn_w_out, ssm_w_in, ssm_w_out, W1, W2); }
        } break;
#endif
#ifndef DIS_GEMM
        case OP_GEMM_BF16: {
            pg8::Gemm g; pg8::EpiBf16 E;
            if (!ssm) { g = pg8::Gemm{BIG, W2, MTOT, DM, AW, AIN}; E = pg8::EpiBf16{HY, DM}; }
            else { g = pg8::Gemm{YB, W2, MTOT, DM, DI, DI}; E = pg8::EpiBf16{HY, DM}; }
            if (l == DEPTH_ - 1) g.M = MLAT;
            pg8::StaticOrder S; S.init(g.M, g.N, (int)gridDim.x, (int)blockIdx.x);
            pg8::gemm_phase<pg8::EpiBf16, pg8::StaticOrder, true, true>((PG8_LAS unsigned char*)lds_, g, S, E, c.tid);
        } break;
#endif
#ifndef DIS_GEMMX
        case OP_GEMM_XBC: {
            pg8::Gemm g{HY, W1, MTOT, NXB, DM, DM}; pg8::EpiXbc E{BIG, HALO, DTB, dt_bias + (size_t)li * 64};
            pg8::StaticOrder S; S.init(g.M, g.N, (int)gridDim.x, (int)blockIdx.x);
            pg8::gemm_phase<pg8::EpiXbc, pg8::StaticOrder, true, true>((PG8_LAS unsigned char*)lds_, g, S, E, c.tid);
        } break;
#endif
#ifndef DIS_KPREP
        case OP_GEMM_IN: {
            pg8::Gemm g{HY, W1, MTOT, AIN, DM, DM};
            pg8::EpiAttnIn E{BIG, attn_kn + (size_t)li * 128, ROPE, (PG8_LAS float*)((PG8_LAS unsigned char*)lds_ + 131072)};
            pg8::StaticOrder S; S.init(g.M, g.N, (int)gridDim.x, (int)blockIdx.x);
            pg8::gemm_phase<pg8::EpiAttnIn, pg8::StaticOrder, true, true>((PG8_LAS unsigned char*)lds_, g, S, E, c.tid);
        } break;
#endif
#ifndef DIS_ATTN
        case OP_ATTN: attn_phase(c, li, BIG, attn_sink + (size_t)li * 8, attn_qn + (size_t)li * 128, ROPE, dry, 0); break;
#endif
#ifndef DIS_CONV
        case OP_CONV: conv_pass(c, BIG, HALO, conv_w + (size_t)li * 3 * CONVD, conv_b + (size_t)li * CONVD, dry); break;
#endif
#ifndef DIS_SCAN
        case OP_SCAN: ssd::scan_phase(c, st == 2 ? 1 : 0, BIG, DTB, YB, a_log + (size_t)li * 64, ssm_d + (size_t)li * 32, dry, 0); break;
#endif
#ifndef DIS_GNORM
        case OP_GEMM_Z: {
            pg8::Gemm g{HY, W1 + (size_t)NXB * DM, l == DEPTH_ - 1 ? MLAT : MTOT, DI, DM, DM};
            pg8::EpiGnorm E{YB, ssm_norm + (size_t)li * DI, (PG8_LAS float*)((PG8_LAS unsigned char*)lds_ + 131072)};
            pg8::StaticOrder S; S.init(g.M, g.N, (int)gridDim.x, (int)blockIdx.x);
            pg8::gemm_phase<pg8::EpiGnorm, pg8::StaticOrder, true, true>((PG8_LAS unsigned char*)lds_, g, S, E, c.tid);
        } break;
#endif
        default: break;
        }
        }
        const int nst = l < 0 ? 2 : (ssm ? 7 : 4);
        if (++st == nst) { st = 0; ++l; if (l == DEPTH_) break; }
        if (nsync++ == 0) grid.sync(); else xcd_barrier(xbar);
    }
}

extern "C" void kernel_launch(void* const* d_in, const int* in_sizes, int n_in, void* d_out, int out_size, void* d_ws, size_t ws_size, hipStream_t stream) {
    static int grid = 0;
    if (grid == 0) {
        if (n_in != 21 || in_sizes[0] != MLAT * DM || out_size != MLAT * DM || ws_size < WS_END) {
            fprintf(stderr, "kernel_launch: unexpected shapes (n_in %d, in0 %d, out %d, ws %zu < %zu?)\n", n_in, n_in > 0 ? in_sizes[0] : -1, out_size, ws_size, (size_t)WS_END); grid = -1; return; }
        int dev = 0, cus = 0, per_cu = 0;
        if (hipGetDevice(&dev) != hipSuccess || hipDeviceGetAttribute(&cus, hipDeviceAttributeMultiprocessorCount, dev) != hipSuccess) { grid = -1; return; }
        if (hipFuncSetAttribute((const void*)mega, hipFuncAttributeMaxDynamicSharedMemorySize, LDS_BYTES) != hipSuccess) { fprintf(stderr, "kernel_launch: hipFuncSetAttribute failed\n"); grid = -1; return; }
        if (hipOccupancyMaxActiveBlocksPerMultiprocessor(&per_cu, (const void*)mega, 512, LDS_BYTES) != hipSuccess || per_cu < 1) { fprintf(stderr, "kernel_launch: occupancy query says %d\n", per_cu); per_cu = 1; }
        (void)hipGetLastError();
        grid = cus * per_cu;
    }
    if (grid < 0) return;
    Args a{};
    for (int i = 0; i < 21; ++i) a.in[i] = (const float*)d_in[i];
    a.out = (float*)d_out; a.ws = (unsigned char*)d_ws; a.probe = PROBE_OP;
    if (hipMemsetAsync(d_ws, 0, 16384, stream) != hipSuccess) { fprintf(stderr, "kernel_launch: memset failed\n"); return; }
    void* args[] = {&a};
    hipError_t e = hipLaunchCooperativeKernel((const void*)mega, dim3(grid), dim3(512), args, LDS_BYTES, stream);
    if (e != hipSuccess) fprintf(stderr, "kernel_launch: cooperative launch failed: %s (grid %d)\n", hipGetErrorString(e), grid);
}
```

```cpp
#include <hip/hip_runtime.h>
#include <hip/hip_bf16.h>
#include <hip/hip_cooperative_groups.h>
#include <cstdio>
#include <cstdint>
namespace cg = cooperative_groups;

constexpr int T_ = 8192, NB = 4, CL = 256, DM = 1024, MLAT = NB * T_, MCTX = NB * CL, MTOT = MLAT + MCTX;
constexpr int DEPTH_ = 4;
constexpr int AIN = 5120, AW = 2048;
constexpr int DI = 2048, CONVD = 4096, SSMH = 32, NXB = 4352;
constexpr float EPS_ = 1e-6f;
constexpr int PC_QA = 0, PC_QB = 1024, PC_KA = 2048, PC_VA = 2304, PC_KB = 2560, PC_VB = 2816, PC_GA = 3072, PC_GB = 4096;

constexpr size_t MiB = 1u << 20;
constexpr size_t WS_MOD = 1 * MiB;
constexpr size_t WS_ROPE = WS_MOD + 512 * 1024;
constexpr size_t WS_CTX = 2 * MiB;
constexpr size_t WS_W1 = 6 * MiB;
constexpr size_t WS_W2 = 19 * MiB;
constexpr size_t WS_HY = 26 * MiB;
constexpr size_t WS_DT = 92 * MiB;
constexpr size_t WS_HALO = 101 * MiB;
constexpr size_t WS_BIG = 106 * MiB;
constexpr size_t WS_Y = 370 * MiB;
constexpr size_t WS_END = 502 * MiB;

typedef unsigned short bf16_t;
typedef short bf16x8 __attribute__((ext_vector_type(8)));
typedef short s16x4 __attribute__((ext_vector_type(4)));
typedef float f32x4 __attribute__((ext_vector_type(4)));
typedef float f32x2 __attribute__((ext_vector_type(2)));
typedef float f32x16 __attribute__((ext_vector_type(16)));
typedef unsigned u32x4 __attribute__((ext_vector_type(4)));
typedef unsigned u32x2 __attribute__((ext_vector_type(2)));

__device__ __forceinline__ unsigned cvtpk(float lo, float hi) { unsigned r; asm volatile("v_cvt_pk_bf16_f32 %0, %1, %2" : "=v"(r) : "v"(lo), "v"(hi)); return r; }
__device__ __forceinline__ float bf2f(unsigned short u) { return __uint_as_float((unsigned)u << 16); }
__device__ __forceinline__ float bflo(unsigned w) { return __uint_as_float(w << 16); }
__device__ __forceinline__ float bfhi(unsigned w) { return __uint_as_float(w & 0xffff0000u); }
__device__ __forceinline__ unsigned short f2bf(float f) { return (unsigned short)(cvtpk(f, 0.f) & 0xffffu); }
__device__ __forceinline__ float silu_f(float x) { return x * __builtin_amdgcn_rcpf(1.f + __expf(-x)); }
__device__ __forceinline__ float wave_sum(float v) {
#pragma unroll
    for (int o = 1; o < 64; o <<= 1) v += __shfl_xor(v, o);
    return v;
}
__device__ __forceinline__ int crow(int r, int hi) { return (r & 3) + 8 * (r >> 2) + 4 * hi; }
#define SBAR() __builtin_amdgcn_sched_barrier(0)

#define XLAS __attribute__((address_space(3)))
#define XB_TMO      128
#define XB_XCNT(j)  (256  + 64 * (j))
#define XB_XSUB(j)  (1280 + 64 * (j))
#define XB_XGEN(j)  (2304 + 64 * (j))
#define XB_TOP      3328
#define XB_TOPGEN   3392
#define XCD_BAR_WORDS 3456
#define XB_SPIN_CAP (1u << 18)

__device__ __forceinline__ unsigned xb_ld(unsigned* p)              { return __hip_atomic_load(p, __ATOMIC_RELAXED, __HIP_MEMORY_SCOPE_AGENT); }
__device__ __forceinline__ unsigned xb_add(unsigned* p, unsigned v) { return __hip_atomic_fetch_add(p, v, __ATOMIC_RELAXED, __HIP_MEMORY_SCOPE_AGENT); }
__device__ __forceinline__ unsigned xb_xcc_id() { return (unsigned)__builtin_amdgcn_s_getreg((3 << 11) | 20) & 0xFu; }
#define XB_SPIN(cond, bar) do { unsigned _sp = 0; while (cond) { __builtin_amdgcn_s_sleep(1); \
    if ((++_sp & 255u) == 0u) { if (xb_ld(&(bar)[XB_TMO])) break; if (_sp > XB_SPIN_CAP) { atomicAdd(&(bar)[XB_TMO], 1u); break; } } } } while (0)

struct XcdBarrier {
    unsigned* bar; unsigned x;
    volatile XLAS unsigned* st;
};

__device__ __forceinline__ XcdBarrier xcd_barrier_post(unsigned* bar, volatile XLAS unsigned* st) {
    XcdBarrier b; b.bar = bar; b.x = xb_xcc_id(); b.st = st;
    if (threadIdx.x == 0) (void)xb_add(&bar[XB_XCNT(b.x)], 1u);
    return b;
}
__device__ __forceinline__ void xcd_barrier_complete(unsigned* bar, unsigned x, unsigned& nloc, unsigned& nx) {
    const unsigned G = gridDim.x * gridDim.y * gridDim.z;
    unsigned sum, cnt, mine, sp = 0u;
    for (;;) {
        sum = 0u; cnt = 0u; mine = 0u;
#pragma unroll
        for (unsigned j = 0; j < 16; ++j) { const unsigned c = xb_ld(&bar[XB_XCNT(j)]); sum += c; cnt += (c > 0u) ? 1u : 0u; mine = (j == x) ? c : mine; }
        if (sum == G) break;
        __builtin_amdgcn_s_sleep(1);
        if ((++sp & 255u) == 0u) { if (xb_ld(&bar[XB_TMO])) break; if (sp > XB_SPIN_CAP) { atomicAdd(&bar[XB_TMO], 1u); break; } }
    }
    nloc = mine > 0u ? mine : 1u; nx = cnt > 0u ? cnt : 1u;
}

__device__ __forceinline__ void xcd_barrier(const XcdBarrier& b) {
    asm volatile("s_waitcnt vmcnt(0)" ::: "memory");
    __syncthreads();
    if (threadIdx.x == 0) {
        unsigned* bar = b.bar;
        __builtin_amdgcn_s_waitcnt(0);
        unsigned nloc = b.st[0], nx = b.st[1];
        if (nloc == 0u) { xcd_barrier_complete(bar, b.x, nloc, nx); b.st[0] = nloc; b.st[1] = nx; }
        const unsigned old = xb_add(&bar[XB_XSUB(b.x)], 1u);
        const unsigned gen = old / nloc;
        if (old + 1u == (gen + 1u) * nloc) {
            __builtin_amdgcn_fence(__ATOMIC_RELEASE, "agent");
            asm volatile("s_waitcnt vmcnt(0)" ::: "memory");
            const unsigned og = xb_add(&bar[XB_TOP], 1u);
            const unsigned tg = og / nx;
            if (og + 1u == (tg + 1u) * nx) xb_add(&bar[XB_TOPGEN], 1u);
            else XB_SPIN(xb_ld(&bar[XB_TOPGEN]) == tg, bar);
            __builtin_amdgcn_fence(__ATOMIC_ACQUIRE, "agent");
            xb_add(&bar[XB_XGEN(b.x)], 1u);
            asm volatile("s_waitcnt vmcnt(0)" ::: "memory");
        } else {
            XB_SPIN(xb_ld(&bar[XB_XGEN(b.x)]) == gen, bar);
            __builtin_amdgcn_fence(__ATOMIC_ACQUIRE, "agent");
            asm volatile("s_waitcnt vmcnt(0)" ::: "memory");
        }
    }
    __syncthreads();
}
namespace pg8 {
#define PG8_LAS __attribute__((address_space(3)))
typedef unsigned short bf16_t;
typedef short bf16x8 __attribute__((ext_vector_type(8)));
typedef float f32x4 __attribute__((ext_vector_type(4)));
typedef unsigned u32x4 __attribute__((ext_vector_type(4)));
constexpr int BM = 256, BK = 64, HALF = 128, HTB = HALF * BK * 2  , STAGE_BYTES = 8 * HTB, NXCD = 8, WGM = 8;

__host__ __device__ __forceinline__ int lds_byte(int r, int c) { const int st = (r >> 4) * 2 + (c >> 5), rr = r & 15, cc = c & 31, ob = rr * 64 + cc * 2; return st * 1024 + (ob ^ (((ob >> 9) & 1) << 5)); }
__host__ __device__ __forceinline__ void stage_rc(int b, int& R, int& C) { const int st = b / 1024, sb = b % 1024, swz = sb ^ (((sb >> 9) & 1) << 5); R = (st >> 1) * 16 + swz / 64; C = (st & 1) * 32 + (swz % 64) / 2; }
__host__ __device__ __forceinline__ int perm32(int rho) { const int n = rho >> 4, i = rho & 15; return 8 * (i >> 2) + 4 * n + (i & 3); }

struct Unit { int pm, pn; };
struct Gemm { const bf16_t* A; const bf16_t* Bt; int M, N, K, lda; };

struct StaticOrder {
    int nM, nN, nwg, G, c;
    __host__ __device__ void init(int M, int N, int G_, int c_) { nM = M / BM; nN = N / BM; nwg = nM * nN; G = G_; c = c_; }
    __host__ __device__ bool next(int i, Unit& u) const {
        const long L = (long)i * G + c; if (L >= nwg) return false;
        int wgid = (int)L; { const int q = nwg / NXCD, r = nwg % NXCD, xcd = wgid % NXCD, off = wgid / NXCD; wgid = (xcd < r ? xcd * (q + 1) : r * (q + 1) + (xcd - r) * q) + off; }
        const int nig = WGM * nN, gid = wgid / nig, fm = gid * WGM, gsz = (nM - fm) < WGM ? (nM - fm) : WGM;
        u.pm = fm + ((wgid % nig) % gsz); u.pn = (wgid % nig) / gsz; return true;
    }
    __device__ __forceinline__ void a_ready(const Unit&) const {}
    __device__ __forceinline__ void done(const Unit&) const {}
};

struct EpiBf16 {
    static constexpr bool PERM = true, AFTER_DRAIN = false;
    bf16_t* O; int ldc;
    __device__ __forceinline__ void operator()(const f32x4 (&acc)[2][2][4][2], const Unit& u, int wr, int wc, int fr, int fq) const {
        asm volatile("s_nop 7\n\ts_nop 7\n\ts_nop 7" ::: "memory");
        const int row0 = u.pm * BM + wr * 64 + fr, col0 = u.pn * BM + wc * 32 + 8 * fq;
#pragma unroll
        for (int ai = 0; ai < 2; ++ai)
#pragma unroll
            for (int m = 0; m < 4; ++m) { bf16_t* rowp = O + (size_t)(row0 + ai * HALF + m * 16) * ldc + col0;
#pragma unroll
                for (int bj = 0; bj < 2; ++bj) { const f32x4 v0 = acc[ai][bj][m][0], v1 = acc[ai][bj][m][1];
                    u32x4 w; w.x = cvtpk(v0[0], v0[1]); w.y = cvtpk(v0[2], v0[3]); w.z = cvtpk(v1[0], v1[1]); w.w = cvtpk(v1[2], v1[3]);
                    *(u32x4*)(rowp + bj * HALF) = w; } }
    }
};
struct EpiGnorm {
    static constexpr bool PERM = true, AFTER_DRAIN = false;
    bf16_t* Y; const float* nw; PG8_LAS float* tab;
    __device__ __forceinline__ void operator()(f32x4 (&acc)[2][2][4][2], const Unit& u, int wr, int wc, int fr, int fq) const {
        const int row0 = u.pm * BM + wr * 64 + fr, col0 = u.pn * BM + wc * 32 + 8 * fq;
#pragma unroll
        for (int ai = 0; ai < 2; ++ai)
#pragma unroll
            for (int m = 0; m < 4; ++m) { const bf16_t* yp = Y + (size_t)(row0 + ai * HALF + m * 16) * DI + col0; float ssq = 0.f;
#pragma unroll
                for (int bj = 0; bj < 2; ++bj) { const u32x4 yv = *(const u32x4*)(yp + bj * HALF); f32x4& z0 = acc[ai][bj][m][0]; f32x4& z1 = acc[ai][bj][m][1];
                    z0[0] = bflo(yv.x) * silu_f(z0[0]); z0[1] = bfhi(yv.x) * silu_f(z0[1]); z0[2] = bflo(yv.y) * silu_f(z0[2]); z0[3] = bfhi(yv.y) * silu_f(z0[3]);
                    z1[0] = bflo(yv.z) * silu_f(z1[0]); z1[1] = bfhi(yv.z) * silu_f(z1[1]); z1[2] = bflo(yv.w) * silu_f(z1[2]); z1[3] = bfhi(yv.w) * silu_f(z1[3]);
                    ssq += (z0[0] * z0[0] + z0[1] * z0[1]) + (z0[2] * z0[2] + z0[3] * z0[3]) + (z1[0] * z1[0] + z1[1] * z1[1]) + (z1[2] * z1[2] + z1[3] * z1[3]); }
                ssq += __shfl_xor(ssq, 16); ssq += __shfl_xor(ssq, 32);
                if (fq == 0) tab[(ai * HALF + wr * 64 + m * 16 + fr) * 4 + wc] = ssq; }
        asm volatile("s_waitcnt lgkmcnt(0)" ::: "memory"); __builtin_amdgcn_s_barrier(); asm volatile("" ::: "memory");
        f32x4 w[2][2];
#pragma unroll
        for (int bj = 0; bj < 2; ++bj) { w[bj][0] = *(const f32x4*)(nw + col0 + bj * HALF); w[bj][1] = *(const f32x4*)(nw + col0 + bj * HALF + 4); }
#pragma unroll
        for (int ai = 0; ai < 2; ++ai)
#pragma unroll
            for (int m = 0; m < 4; ++m) { const f32x4 t = *(const PG8_LAS f32x4*)(tab + (ai * HALF + wr * 64 + m * 16 + fr) * 4);
                const float rs = rsqrtf(((t[0] + t[1]) + (t[2] + t[3])) * (1.f / 256.f) + EPS_);
                bf16_t* yp = Y + (size_t)(row0 + ai * HALF + m * 16) * DI + col0;
#pragma unroll
                for (int bj = 0; bj < 2; ++bj) { const f32x4 v0 = acc[ai][bj][m][0] * rs * w[bj][0], v1 = acc[ai][bj][m][1] * rs * w[bj][1];
                    u32x4 o; o.x = cvtpk(v0[0], v0[1]); o.y = cvtpk(v0[2], v0[3]); o.z = cvtpk(v1[0], v1[1]); o.w = cvtpk(v1[2], v1[3]);
                    *(u32x4*)(yp + bj * HALF) = o; } }
    }
};
struct EpiAttnIn {
    static constexpr bool PERM = true, AFTER_DRAIN = false;
    bf16_t* O; const float* knw; const f32x2* rope; PG8_LAS float* tab;
    __device__ __forceinline__ void operator()(f32x4 (&acc)[2][2][4][2], const Unit& u, int wr, int wc, int fr, int fq) const {
        asm volatile("s_nop 7\n\ts_nop 7\n\ts_nop 7" ::: "memory");
        const int row0 = u.pm * BM + wr * 64 + fr, col0 = u.pn * BM + wc * 32 + 8 * fq;
        const bool isK = u.pn == 8 || u.pn == 10, isB = u.pn == 10;
        if (isB) {
#pragma unroll
            for (int ai = 0; ai < 2; ++ai)
#pragma unroll
                for (int m = 0; m < 4; ++m)
#pragma unroll
                    for (int bj = 0; bj < 2; ++bj) { const f32x4 a = acc[ai][bj][m][0], b = acc[ai][bj][m][1];
                        float ssq = (a[0] * a[0] + a[1] * a[1]) + (a[2] * a[2] + a[3] * a[3]) + (b[0] * b[0] + b[1] * b[1]) + (b[2] * b[2] + b[3] * b[3]);
                        ssq += __shfl_xor(ssq, 16); ssq += __shfl_xor(ssq, 32);
                        if (fq == 0) tab[((ai * HALF + wr * 64 + m * 16 + fr) * 2 + bj) * 4 + wc] = ssq; }
            asm volatile("s_waitcnt lgkmcnt(0)" ::: "memory"); __builtin_amdgcn_s_barrier(); asm volatile("" ::: "memory");
        }
        f32x4 kw0 = {1.f, 1.f, 1.f, 1.f}, kw1 = kw0;
        if (isB) { kw0 = *(const f32x4*)(knw + wc * 32 + 8 * fq); kw1 = *(const f32x4*)(knw + wc * 32 + 8 * fq + 4); }
        const int i0 = wc * 16 + 4 * fq;
#pragma unroll
        for (int ai = 0; ai < 2; ++ai)
#pragma unroll
            for (int m = 0; m < 4; ++m) { const int row = row0 + ai * HALF + m * 16; bf16_t* rowp = O + (size_t)row * AIN + col0;
                f32x4 c01 = {1.f, 0.f, 1.f, 0.f}, c23 = c01;
                const bool rot = isK && row < MLAT;
                if (rot) { const int pos = row & (T_ - 1); const int tb = i0 < 32 ? (pos >> 6) : (pos & 63); const f32x4* tp = (const f32x4*)(rope + tb * 32 + (i0 & 31)); c01 = tp[0]; c23 = tp[1]; }
#pragma unroll
                for (int bj = 0; bj < 2; ++bj) { f32x4 v0 = acc[ai][bj][m][0], v1 = acc[ai][bj][m][1];
                    if (isB) { const f32x4 t = *(const PG8_LAS f32x4*)(tab + ((ai * HALF + wr * 64 + m * 16 + fr) * 2 + bj) * 4);
                        const float rs = rsqrtf(((t[0] + t[1]) + (t[2] + t[3])) * (1.f / 128.f) + EPS_); v0 = v0 * rs * kw0; v1 = v1 * rs * kw1; }
                    if (rot) { float x0, x1;
                        x0 = v0[0]; x1 = v0[1]; v0[0] = x0 * c01[0] - x1 * c01[1]; v0[1] = x0 * c01[1] + x1 * c01[0];
                        x0 = v0[2]; x1 = v0[3]; v0[2] = x0 * c01[2] - x1 * c01[3]; v0[3] = x0 * c01[3] + x1 * c01[2];
                        x0 = v1[0]; x1 = v1[1]; v1[0] = x0 * c23[0] - x1 * c23[1]; v1[1] = x0 * c23[1] + x1 * c23[0];
                        x0 = v1[2]; x1 = v1[3]; v1[2] = x0 * c23[2] - x1 * c23[3]; v1[3] = x0 * c23[3] + x1 * c23[2]; }
                    u32x4 w; w.x = cvtpk(v0[0], v0[1]); w.y = cvtpk(v0[2], v0[3]); w.z = cvtpk(v1[0], v1[1]); w.w = cvtpk(v1[2], v1[3]);
                    *(u32x4*)(rowp + bj * HALF) = w; } }
    }
};
struct EpiXbc {
    static constexpr bool PERM = true, AFTER_DRAIN = false;
    bf16_t* O; bf16_t* halo; float* dt; const float* dtb;
    __device__ __forceinline__ void operator()(const f32x4 (&acc)[2][2][4][2], const Unit& u, int wr, int wc, int fr, int fq) const {
        asm volatile("s_nop 7\n\ts_nop 7\n\ts_nop 7" ::: "memory");
        const int row0 = u.pm * BM + wr * 64 + fr;
        if (u.pn < 16) {
            const int col0 = u.pn * BM + wc * 32 + 8 * fq;
#pragma unroll
            for (int ai = 0; ai < 2; ++ai)
#pragma unroll
                for (int m = 0; m < 4; ++m) { const int row = row0 + ai * HALF + m * 16; bf16_t* rowp = O + (size_t)row * CONVD + col0;
                    const int rl = row & 127;
#pragma unroll
                    for (int bj = 0; bj < 2; ++bj) { const f32x4 v0 = acc[ai][bj][m][0], v1 = acc[ai][bj][m][1];
                        u32x4 w; w.x = cvtpk(v0[0], v0[1]); w.y = cvtpk(v0[2], v0[3]); w.z = cvtpk(v1[0], v1[1]); w.w = cvtpk(v1[2], v1[3]);
                        *(u32x4*)(rowp + bj * HALF) = w;
                        if (rl == 0) *(u32x4*)(halo + ((size_t)(row >> 7) * 2 + 0) * CONVD + col0 + bj * HALF) = w;
                        if (rl == 127) *(u32x4*)(halo + ((size_t)(row >> 7) * 2 + 1) * CONVD + col0 + bj * HALF) = w; } }
        } else {
            const int lc = wc * 32 + 8 * fq;
            if (wc < 2) {
                const f32x4 b0 = *(const f32x4*)(dtb + lc), b1 = *(const f32x4*)(dtb + lc + 4);
#pragma unroll
                for (int ai = 0; ai < 2; ++ai)
#pragma unroll
                    for (int m = 0; m < 4; ++m) { const int row = row0 + ai * HALF + m * 16;
                        f32x4 v0 = acc[ai][0][m][0] + b0, v1 = acc[ai][0][m][1] + b1;
#pragma unroll
                        for (int j = 0; j < 4; ++j) { v0[j] = v0[j] > 20.f ? v0[j] : log1pf(__expf(v0[j])); v1[j] = v1[j] > 20.f ? v1[j] : log1pf(__expf(v1[j])); }
#pragma unroll
                        for (int j = 0; j < 4; ++j) { dt[(size_t)(lc + j) * MTOT + row] = v0[j]; dt[(size_t)(lc + 4 + j) * MTOT + row] = v1[j]; } }
            }
        }
    }
};
template <class Epi, class Sched, bool ALIGN_EPI = false, bool SP2 = false>
__device__ __forceinline__ void gemm_phase(PG8_LAS unsigned char* lds, const Gemm g, const Sched& S, const Epi& E, const int tid) {
    const int wid = __builtin_amdgcn_readfirstlane(tid >> 6), lane = tid & 63, wr = wid >> 2, wc = wid & 3, fr = lane & 15, fq = lane >> 4;
    const int K = g.K, nt = K / BK;
    unsigned voffA[2], voffB[2];
#pragma unroll
    for (int i = 0; i < 2; ++i) { int R, C; stage_rc(tid * 16 + i * 8192, R, C); const int Rb = Epi::PERM ? ((R & ~31) + perm32(R & 31)) : R;
        voffA[i] = (unsigned)(R * g.lda + C) * 2u; voffB[i] = (unsigned)(Rb * K + C) * 2u; }
    const size_t kstep = (size_t)(BK * 2);
    const size_t hstepA = (size_t)HALF * g.lda * 2, hstepB = (size_t)HALF * K * 2;
    const size_t tstepA = 2 * hstepA, tstepB = 2 * hstepB;
    const unsigned ldsw = (unsigned)wid * 1024u;
    const int aoff = lds_byte(wr * 64 + fr, fq * 8), boff = lds_byte(wc * 32 + fr, fq * 8);
#define PG8_SA(b, h) (((b) * 2 + (h)) * HTB)
#define PG8_SB(b, h) ((4 + (b) * 2 + (h)) * HTB)
#define PG8_STAGE(bufoff, gbase, voff) do { _Pragma("unroll") for (int _i = 0; _i < 2; ++_i) \
        __builtin_amdgcn_global_load_lds((const unsigned*)((const char*)(gbase) + (voff)[_i]), (PG8_LAS unsigned*)(lds + (bufoff) + ldsw + _i * 8192), 16, 0, 0); } while (0)
#define PG8_LDA(dst, b, h) do { _Pragma("unroll") for (int m = 0; m < 4; ++m) _Pragma("unroll") for (int k = 0; k < 2; ++k) dst[m][k] = *(const PG8_LAS bf16x8*)(lds + PG8_SA(b, h) + aoff + m * 2048 + k * 1024); } while (0)
#define PG8_LDB(dst, b, h) do { _Pragma("unroll") for (int n = 0; n < 2; ++n) _Pragma("unroll") for (int k = 0; k < 2; ++k) dst[n][k] = *(const PG8_LAS bf16x8*)(lds + PG8_SB(b, h) + boff + n * 2048 + k * 1024); } while (0)
#define PG8_MMA(ai, bj, At, Bt) do { __builtin_amdgcn_s_setprio(1); _Pragma("unroll") for (int m = 0; m < 4; ++m) _Pragma("unroll") for (int n = 0; n < 2; ++n) _Pragma("unroll") for (int k = 0; k < 2; ++k) \
        acc[ai][bj][m][n] = __builtin_amdgcn_mfma_f32_16x16x32_bf16(Bt[n][k], At[m][k], acc[ai][bj][m][n], 0, 0, 0); __builtin_amdgcn_s_setprio(0); } while (0)
#define PG8_WAIT_V(n) asm volatile("s_waitcnt vmcnt(" #n ")" ::: "memory")
#define PG8_WAIT_L(n) asm volatile("s_waitcnt lgkmcnt(" #n ")" ::: "memory")
#define PG8_BAR __builtin_amdgcn_s_barrier()
#define PG8_SCHED __builtin_amdgcn_sched_barrier(0)
    Unit cur, nxt; int ui = 0;
    if (!S.next(0, cur)) return;
    f32x4 acc[2][2][4][2];
#pragma unroll
    for (int a = 0; a < 2; ++a)
#pragma unroll
        for (int b = 0; b < 2; ++b)
#pragma unroll
            for (int m = 0; m < 4; ++m)
#pragma unroll
                for (int n = 0; n < 2; ++n) acc[a][b][m][n] = (f32x4){0.f, 0.f, 0.f, 0.f};
    bf16x8 At[4][2], B0[2][2], B1[2][2];
    const char* cA = (const char*)g.A + (size_t)cur.pm * tstepA; const char* cB = (const char*)g.Bt + (size_t)cur.pn * tstepB;
    S.a_ready(cur);
    if constexpr (SP2) {
        PG8_STAGE(PG8_SB(0, 0), cB, voffB); PG8_STAGE(PG8_SB(0, 1), cB + hstepB, voffB); PG8_STAGE(PG8_SA(0, 0), cA, voffA); PG8_STAGE(PG8_SA(0, 1), cA + hstepA, voffA);
        if (wr == 1) PG8_BAR;
        PG8_WAIT_V(2); PG8_BAR;
        PG8_STAGE(PG8_SB(1, 0), cB + kstep, voffB); PG8_STAGE(PG8_SA(1, 0), cA + kstep, voffA); PG8_STAGE(PG8_SB(1, 1), cB + hstepB + kstep, voffB);
        PG8_WAIT_V(6); PG8_BAR;
    } else {
        PG8_STAGE(PG8_SB(0, 0), cB, voffB); PG8_STAGE(PG8_SA(0, 0), cA, voffA); PG8_STAGE(PG8_SB(0, 1), cB + hstepB, voffB); PG8_STAGE(PG8_SA(0, 1), cA + hstepA, voffA);
        if (wr == 1) PG8_BAR;
        PG8_WAIT_V(4); PG8_BAR;
        PG8_STAGE(PG8_SB(1, 0), cB + kstep, voffB); PG8_STAGE(PG8_SA(1, 0), cA + kstep, voffA); PG8_STAGE(PG8_SB(1, 1), cB + hstepB + kstep, voffB);
        PG8_WAIT_V(6); PG8_BAR;
    }
    for (;;) {
        const bool has_next = S.next(ui + 1, nxt);
        const char* nA = has_next ? (const char*)g.A + (size_t)nxt.pm * tstepA : cA; const char* nB = has_next ? (const char*)g.Bt + (size_t)nxt.pn * tstepB : cB;
        for (int t = 0; t < nt; t += 2) {
            const bool last = (t == nt - 2);
            const char* a1 = cA + (size_t)(t + 1) * kstep;
            const char* a2 = last ? nA : cA + (size_t)(t + 2) * kstep; const char* b2 = last ? nB : cB + (size_t)(t + 2) * kstep;
            const char* a3 = a2 + kstep; const char* b3 = b2 + kstep;
            if (last && has_next) S.a_ready(nxt);
            if constexpr (SP2) {
            PG8_LDB(B0, 0, 0); PG8_LDB(B1, 0, 1); PG8_SCHED; PG8_LDA(At, 0, 0); PG8_STAGE(PG8_SA(1, 1), a1 + hstepA, voffA);
            PG8_WAIT_V(8); PG8_WAIT_L(0); PG8_BAR; PG8_MMA(0, 0, At, B0); PG8_MMA(0, 1, At, B1); PG8_BAR; PG8_SCHED;
            PG8_LDA(At, 0, 1); PG8_STAGE(PG8_SB(0, 0), b2, voffB); PG8_STAGE(PG8_SB(0, 1), b2 + hstepB, voffB); PG8_STAGE(PG8_SA(0, 0), a2, voffA);
            PG8_WAIT_V(8); PG8_WAIT_L(0); PG8_BAR; PG8_MMA(1, 0, At, B0); PG8_MMA(1, 1, At, B1); PG8_BAR; PG8_SCHED;
            PG8_LDB(B0, 1, 0); PG8_LDB(B1, 1, 1); PG8_SCHED; PG8_LDA(At, 1, 0); PG8_STAGE(PG8_SA(0, 1), a2 + hstepA, voffA);
            PG8_WAIT_V(8); PG8_WAIT_L(0); PG8_BAR; PG8_MMA(0, 0, At, B0); PG8_MMA(0, 1, At, B1); PG8_BAR; PG8_SCHED;
            PG8_LDA(At, 1, 1); PG8_STAGE(PG8_SB(1, 0), b3, voffB); PG8_STAGE(PG8_SB(1, 1), b3 + hstepB, voffB); PG8_STAGE(PG8_SA(1, 0), a3, voffA);
            PG8_WAIT_V(8); PG8_WAIT_L(0); PG8_BAR; PG8_MMA(1, 0, At, B0); PG8_MMA(1, 1, At, B1); PG8_BAR; PG8_SCHED;
            } else {
            PG8_LDB(B0, 0, 0); PG8_SCHED; PG8_LDA(At, 0, 0); PG8_STAGE(PG8_SA(1, 1), a1 + hstepA, voffA);
            PG8_WAIT_L(8); PG8_BAR; PG8_WAIT_L(0); PG8_MMA(0, 0, At, B0); PG8_BAR; PG8_SCHED;
            PG8_LDB(B1, 0, 1); PG8_STAGE(PG8_SB(0, 0), b2, voffB);
            PG8_BAR; PG8_WAIT_L(0); PG8_MMA(0, 1, At, B1); PG8_BAR;
            PG8_LDA(At, 0, 1); PG8_STAGE(PG8_SA(0, 0), a2, voffA);
            PG8_BAR; PG8_WAIT_L(0); PG8_MMA(1, 0, At, B0); PG8_BAR; PG8_SCHED;
            PG8_STAGE(PG8_SB(0, 1), b2 + hstepB, voffB);
            PG8_WAIT_V(6); PG8_BAR; PG8_MMA(1, 1, At, B1); PG8_BAR;
            PG8_LDB(B0, 1, 0); PG8_SCHED; PG8_LDA(At, 1, 0); PG8_STAGE(PG8_SA(0, 1), a2 + hstepA, voffA);
            PG8_WAIT_L(8); PG8_BAR; PG8_WAIT_L(0); PG8_MMA(0, 0, At, B0); PG8_BAR; PG8_SCHED;
            PG8_LDB(B1, 1, 1); PG8_STAGE(PG8_SB(1, 0), b3, voffB);
            PG8_BAR; PG8_WAIT_L(0); PG8_MMA(0, 1, At, B1); PG8_BAR;
            PG8_LDA(At, 1, 1); PG8_STAGE(PG8_SA(1, 0), a3, voffA);
            PG8_BAR; PG8_WAIT_L(0); PG8_MMA(1, 0, At, B0); PG8_BAR; PG8_SCHED;
            PG8_STAGE(PG8_SB(1, 1), b3 + hstepB, voffB);
            PG8_WAIT_V(6); PG8_BAR; PG8_MMA(1, 1, At, B1); PG8_BAR;
            }
        }
        if constexpr (ALIGN_EPI) { if (wr == 0) PG8_BAR; }
        if constexpr (!Epi::AFTER_DRAIN) { E(acc, cur, wr, wc, fr, fq); S.done(cur); }
        if (!has_next) break;
#pragma unroll
        for (int a = 0; a < 2; ++a)
#pragma unroll
            for (int b = 0; b < 2; ++b)
#pragma unroll
                for (int m = 0; m < 4; ++m)
#pragma unroll
                    for (int n = 0; n < 2; ++n) acc[a][b][m][n] = (f32x4){0.f, 0.f, 0.f, 0.f};
        cur = nxt; cA = nA; cB = nB; ++ui;
        if constexpr (ALIGN_EPI) { if (wr == 1) PG8_BAR; }
    }
    PG8_WAIT_V(0);
    if constexpr (!ALIGN_EPI) { if (wr == 0) PG8_BAR; }
    PG8_BAR;
    if constexpr (Epi::AFTER_DRAIN) { E.fused(acc, cur, wr, wc, fr, fq, lds, wid, lane); S.done(cur); }
#undef PG8_SA
#undef PG8_SB
#undef PG8_STAGE
#undef PG8_LDA
#undef PG8_LDB
#undef PG8_MMA
#undef PG8_WAIT_V
#undef PG8_WAIT_L
#undef PG8_BAR
#undef PG8_SCHED
}
}
namespace att {
constexpr int D = 128, NW = 8, QBLK = 32, KVBLK = 64, LDP = AIN;
constexpr float SCALE = 0.088388347648318440f, THR = 8.f;
#ifndef ATT_NQR
#define ATT_NQR 5
#endif
#ifndef ATT_NQR_U
#define ATT_NQR_U 8
#endif
constexpr int NQR = ATT_NQR, NQR_U = ATT_NQR_U;
constexpr size_t SHM_V = KVBLK * D * 2, SHM_K = KVBLK * D * 2, SHM_ATTN = 2 * SHM_V + 2 * SHM_K + NW * 64 * 4, SHM_Q = (8 - NQR) * 8192;
#define KSWZ(row, colB) ((row) * 256 + ((colB) ^ (((row) & 7) << 4)))
__device__ __forceinline__ void partialSM(f32x16& p0, f32x16& p1, float& m_reg, float& mn, float& alpha) {
  constexpr float C = SCALE * 1.4426950408889634f;
  float pmax = p0[0];
#pragma unroll
  for (int r = 1; r < 16; ++r) pmax = fmaxf(pmax, p0[r]);
#pragma unroll
  for (int r = 0; r < 16; ++r) pmax = fmaxf(pmax, p1[r]);
  { auto rr = __builtin_amdgcn_permlane32_swap(__float_as_uint(pmax), __float_as_uint(pmax), false, false);
    pmax = fmaxf(__uint_as_float(rr[0]), __uint_as_float(rr[1])); }
  if (__builtin_expect(__all(pmax - m_reg <= THR / SCALE), 1)) { mn = m_reg; alpha = 1.f; }
  else { mn = fmaxf(m_reg, pmax); alpha = __builtin_amdgcn_exp2f((m_reg - mn) * C); m_reg = mn; }
  float mnC = -mn * C;
#pragma unroll
  for (int r = 0; r < 16; ++r) p0[r] = fmaf(p0[r], C, mnC);
#pragma unroll
  for (int r = 0; r < 16; ++r) p1[r] = fmaf(p1[r], C, mnC);
#pragma unroll
  for (int r = 0; r < 16; ++r) p0[r] = __builtin_amdgcn_exp2f(p0[r]);
}
__device__ __forceinline__ void finishSM(f32x16& p0, f32x16& p1, float alpha, float& l_reg, bf16x8& pa0, bf16x8& pa1, bf16x8& pa2, bf16x8& pa3) {
#pragma unroll
  for (int r = 0; r < 16; ++r) p1[r] = __builtin_amdgcn_exp2f(p1[r]);
  float ps = 0;
#pragma unroll
  for (int r = 0; r < 16; ++r) ps += p0[r];
#pragma unroll
  for (int r = 0; r < 16; ++r) ps += p1[r];
  { auto rr = __builtin_amdgcn_permlane32_swap(__float_as_uint(ps), __float_as_uint(ps), false, false);
    ps = __uint_as_float(rr[0]) + __uint_as_float(rr[1]); }
  l_reg = l_reg * alpha + ps;
#define PK4(P, BASE, OUT) do { unsigned a0 = cvtpk(P[BASE + 0], P[BASE + 1]), a1 = cvtpk(P[BASE + 2], P[BASE + 3]);   \
    unsigned b0 = cvtpk(P[BASE + 4], P[BASE + 5]), b1 = cvtpk(P[BASE + 6], P[BASE + 7]);                              \
    auto r0 = __builtin_amdgcn_permlane32_swap(a0, b0, false, false); auto r1 = __builtin_amdgcn_permlane32_swap(a1, b1, false, false); \
    u32x4 w = {r0[0], r1[0], r0[1], r1[1]}; OUT = *reinterpret_cast<bf16x8*>(&w); } while (0)
  PK4(p0, 0, pa0); PK4(p0, 8, pa1); PK4(p1, 0, pa2); PK4(p1, 8, pa3);
#undef PK4
}
template <int NQ>
__device__ __forceinline__ void qkt(f32x16& p0, f32x16& p1, const char* Ks, const bf16x8* qr, const char* ql, int r32, int hi) {
  p0 = f32x16{}; p1 = f32x16{};
  const int x = (r32 & 7) << 4, kb = r32 * 256;
  const char* a0 = Ks + kb + ((hi * 16) ^ x); const char* a1 = Ks + kb + ((32 + hi * 16) ^ x); const char* a2 = Ks + kb + ((64 + hi * 16) ^ x); const char* a3 = Ks + kb + ((96 + hi * 16) ^ x);
#define QK1(QV, AP, IMM) { const bf16x8 b0 = *reinterpret_cast<const bf16x8*>(AP + IMM); const bf16x8 b1 = *reinterpret_cast<const bf16x8*>(AP + IMM + 8192); const bf16x8 qv = QV; \
    p0 = __builtin_amdgcn_mfma_f32_32x32x16_bf16(b0, qv, p0, 0, 0, 0); p1 = __builtin_amdgcn_mfma_f32_32x32x16_bf16(b1, qv, p1, 0, 0, 0); }
#define QLD(I) (*reinterpret_cast<const bf16x8*>(ql + (I) * 8192))
  #define QSEL(I) ((I) < NQ ? qr[(I) < NQ ? (I) : 0] : QLD((I) - NQ))
  QK1(QSEL(0), a0, 0) QK1(QSEL(1), a1, 0) QK1(QSEL(2), a2, 0) QK1(QSEL(3), a3, 0) QK1(QSEL(4), a0, 128) QK1(QSEL(5), a1, 128) QK1(QSEL(6), a2, 128) QK1(QSEL(7), a3, 128)
#undef QSEL
#undef QK1
#undef QLD
}
__device__ __forceinline__ void wmask(f32x16& p0, f32x16& p1, int kp, int qp, int hi) {
#pragma unroll
  for (int r = 0; r < 16; ++r) { const int d = qp - (kp + crow(r, hi));
    if (d > 128 || d < -128) p0[r] = -INFINITY;
    if (d - 32 > 128 || d - 32 < -128) p1[r] = -INFINITY; }
}
__device__ __forceinline__ int v_st(int k, int c) { const int kk = (k & ~0xC) | ((k & 4) << 1) | ((k & 8) >> 1); return ((kk >> 3) * 4 + (c >> 5)) * 512 + ((kk & 7) * 32 + (c & 31)) * 2; }
__device__ __forceinline__ int v_rd_base(int lane) { return ((lane & 3) << 3) | (((lane >> 2) & 3) << 6) | (((lane >> 4) & 1) << 5) | (((lane >> 5) & 1) << 8); }
constexpr int v_rd_off(int d0, int ks, int half) { return d0 * 512 + ks * 4096 + half * 2048; }
template <int OFF> __device__ __forceinline__ s16x4 tr_read(int vb) {
  s16x4 r; asm volatile("ds_read_b64_tr_b16 %0, %1 offset:%2" : "=&v"(r) : "v"(vb), "i"(OFF) : "memory"); return r;
}
template <int D0> __device__ __forceinline__ void pv_one(f32x16& od, int vb, bf16x8 pa0, bf16x8 pa1, bf16x8 pa2, bf16x8 pa3) {
  const s16x4 l0 = tr_read<v_rd_off(D0, 0, 0)>(vb), h0 = tr_read<v_rd_off(D0, 0, 1)>(vb), l1 = tr_read<v_rd_off(D0, 1, 0)>(vb), h1 = tr_read<v_rd_off(D0, 1, 1)>(vb);
  const s16x4 l2 = tr_read<v_rd_off(D0, 2, 0)>(vb), h2 = tr_read<v_rd_off(D0, 2, 1)>(vb), l3 = tr_read<v_rd_off(D0, 3, 0)>(vb), h3 = tr_read<v_rd_off(D0, 3, 1)>(vb);
  asm volatile("s_waitcnt lgkmcnt(0)" ::: "memory"); SBAR();
#define PK(L, H) (bf16x8){L[0], L[1], L[2], L[3], H[0], H[1], H[2], H[3]}
  od = __builtin_amdgcn_mfma_f32_32x32x16_bf16(pa0, PK(l0, h0), od, 0, 0, 0);
  od = __builtin_amdgcn_mfma_f32_32x32x16_bf16(pa1, PK(l1, h1), od, 0, 0, 0);
  od = __builtin_amdgcn_mfma_f32_32x32x16_bf16(pa2, PK(l2, h2), od, 0, 0, 0);
  od = __builtin_amdgcn_mfma_f32_32x32x16_bf16(pa3, PK(l3, h3), od, 0, 0, 0);
#undef PK
}
__device__ __forceinline__ void pv_d0(f32x16* o, int vb, bf16x8 pa0, bf16x8 pa1, bf16x8 pa2, bf16x8 pa3) {
  pv_one<0>(o[0], vb, pa0, pa1, pa2, pa3); pv_one<1>(o[1], vb, pa0, pa1, pa2, pa3); pv_one<2>(o[2], vb, pa0, pa1, pa2, pa3); pv_one<3>(o[3], vb, pa0, pa1, pa2, pa3);
}

struct Item { int qrow0, qpos0, qcol, gcol, kcol, vcol, n0, r0, r1, NT, kp1, masked, normq, has_sink; float sinkv; };

template <bool MASKED>
__device__ __forceinline__ void attn_item(bf16_t* __restrict__ P, const Item it, const float* __restrict__ qnw, const f32x2* __restrict__ rope, char* lds, const int tid, const bool dry) {
  const int wid = tid >> 6, lane = tid & 63, r32 = lane & 31, hi = lane >> 5;
  constexpr int NBUF = 3;
  char* V_lds = lds; char* K_lds = lds + NBUF * SHM_V;
  float* ws = (float*)(lds + NBUF * (SHM_V + SHM_K)) + wid * 64; float* li_l = ws; float* al_l = ws + 32;
  float m_reg = -1e30f, l_reg = 0; constexpr int NQ = MASKED ? NQR : NQR_U;
  f32x16 o[4] = {}; bf16x8 qr[NQ > 0 ? NQ : 1]; char* ql = lds + NBUF * (SHM_V + SHM_K) + 2048 + tid * 16;
  const int qrow = it.qrow0 + wid * QBLK + r32;
  const int vb0 = (int)(uintptr_t)V_lds + v_rd_base(lane);
  const int widu = __builtin_amdgcn_readfirstlane(wid);
  unsigned koffs[2], voffs[2];
#pragma unroll
  for (int i = 0; i < 2; ++i) { const int ci = (wid * 2 + i) * 64 + lane;
    { const int row = ci >> 4, cc = (ci & 15) ^ (row & 7); koffs[i] = (unsigned)(row * LDP + cc * 8); }
    { const int sub = ci >> 5, kk = (sub >> 2) * 8 + ((ci & 31) >> 2), k = (kk & ~0xC) | ((kk & 4) << 1) | ((kk & 8) >> 1), cv = (sub & 3) * 32 + (ci & 3) * 8; voffs[i] = (unsigned)(k * LDP + cv); } }
#define ALAS __attribute__((address_space(3)))
#define TROW(t) ((size_t)((t) < it.n0 ? it.r0 + 64 * (t) : it.r1 + 64 * ((t) - it.n0)))
#define DMA(t, b) do { const bf16_t* gb_ = P + TROW(t) * LDP; _Pragma("unroll") for (int i_ = 0; i_ < 2; ++i_) {                                  \
    __builtin_amdgcn_global_load_lds((const unsigned*)(gb_ + it.kcol + koffs[i_]), (ALAS unsigned*)(K_lds + (b) * SHM_K + (widu * 2 + i_) * 1024), 16, 0, 0); \
    __builtin_amdgcn_global_load_lds((const unsigned*)(gb_ + it.vcol + voffs[i_]), (ALAS unsigned*)(V_lds + (b) * SHM_V + (widu * 2 + i_) * 1024), 16, 0, 0); } } while (0)
#define LANDED() do { asm volatile("s_waitcnt vmcnt(0)" ::: "memory"); __builtin_amdgcn_s_barrier(); asm volatile("" ::: "memory"); } while (0)
#define RESC(a) do { if (__any((a) < 1.f)) { if (hi == 0) al_l[r32] = (a); asm volatile("s_waitcnt lgkmcnt(0)" ::: "memory"); \
    _Pragma("unroll") for (int d = 0; d < 4; ++d) _Pragma("unroll") for (int r = 0; r < 16; ++r) o[d][r] *= al_l[crow(r, hi)]; } } while (0)
#define WMASK(pa, pb, t) do { if constexpr (MASKED) { if ((t) >= it.n0) wmask(pa, pb, it.kp1 + 64 * ((t) - it.n0), pos_q, hi); } } while (0)
  const int pos_q = it.qpos0 + wid * QBLK + r32;
  f32x16 pA0, pA1, pB0, pB1; float mnA, mnB, alA, alB; bf16x8 pa0, pa1, pa2, pa3; const int NT = it.NT;
  DMA(0, 0); DMA(1, 1);
  {
    const bf16_t* Qw = P + (size_t)qrow * LDP + it.qcol + hi * 8;
    bf16x8 raw[8];
#pragma unroll
    for (int d0 = 0; d0 < 8; ++d0) raw[d0] = *reinterpret_cast<const bf16x8*>(Qw + d0 * 16);
    float rs = 1.f;
    if (it.normq) { float ssq = 0.f;
#pragma unroll
      for (int d0 = 0; d0 < 8; ++d0)
#pragma unroll
        for (int j = 0; j < 8; ++j) { const float v = bf2f((unsigned short)raw[d0][j]); ssq += v * v; }
      ssq += __shfl_xor(ssq, 32);
      rs = rsqrtf(ssq * (1.f / 128.f) + EPS_); }
    const int pos = it.qpos0 + wid * QBLK + r32;
#pragma unroll
    for (int d0 = 0; d0 < 8; ++d0) {
      float v[8];
#pragma unroll
      for (int j = 0; j < 8; ++j) v[j] = bf2f((unsigned short)raw[d0][j]);
      if (it.normq) { const f32x4 w0 = *(const f32x4*)(qnw + d0 * 16 + hi * 8), w1 = *(const f32x4*)(qnw + d0 * 16 + hi * 8 + 4);
#pragma unroll
        for (int j = 0; j < 4; ++j) { v[j] *= rs * w0[j]; v[4 + j] *= rs * w1[j]; } }
      if (it.qpos0 >= 0) { const int tab = d0 < 4 ? (pos >> 6) : (pos & 63); const f32x4* tp = (const f32x4*)(rope + tab * 32 + (d0 & 3) * 8 + hi * 4);
        const f32x4 c01 = tp[0], c23 = tp[1];
        float x0, x1;
        x0 = v[0]; x1 = v[1]; v[0] = x0 * c01[0] - x1 * c01[1]; v[1] = x0 * c01[1] + x1 * c01[0];
        x0 = v[2]; x1 = v[3]; v[2] = x0 * c01[2] - x1 * c01[3]; v[3] = x0 * c01[3] + x1 * c01[2];
        x0 = v[4]; x1 = v[5]; v[4] = x0 * c23[0] - x1 * c23[1]; v[5] = x0 * c23[1] + x1 * c23[0];
        x0 = v[6]; x1 = v[7]; v[6] = x0 * c23[2] - x1 * c23[3]; v[7] = x0 * c23[3] + x1 * c23[2]; }
      u32x4 w = {cvtpk(v[0], v[1]), cvtpk(v[2], v[3]), cvtpk(v[4], v[5]), cvtpk(v[6], v[7])};
      if (d0 < NQ) qr[d0 < NQ ? d0 : 0] = *reinterpret_cast<bf16x8*>(&w); else *reinterpret_cast<u32x4*>(ql + (d0 - NQ) * 8192) = w;
    }
  }
  LANDED();
  qkt<NQ>(pA0, pA1, K_lds, qr, ql, r32, hi); WMASK(pA0, pA1, 0); partialSM(pA0, pA1, m_reg, mnA, alA);
  int b = 1, bp = 0, bn = 2;
  for (int t = 1; t + 1 < NT; t += 2) {
    DMA(t + 1, bn);
    SBAR(); qkt<NQ>(pB0, pB1, K_lds + b * SHM_K, qr, ql, r32, hi); WMASK(pB0, pB1, t);
    finishSM(pA0, pA1, alA, l_reg, pa0, pa1, pa2, pa3); SBAR();
    pv_d0(o, vb0 + bp * (int)SHM_V, pa0, pa1, pa2, pa3); partialSM(pB0, pB1, m_reg, mnB, alB);
    RESC(alB); LANDED();
    bp = b; b = bn; bn = bn == 2 ? 0 : bn + 1;
    DMA(t + 2, bn);
    SBAR(); qkt<NQ>(pA0, pA1, K_lds + b * SHM_K, qr, ql, r32, hi); WMASK(pA0, pA1, t + 1);
    finishSM(pB0, pB1, alB, l_reg, pa0, pa1, pa2, pa3); SBAR();
    pv_d0(o, vb0 + bp * (int)SHM_V, pa0, pa1, pa2, pa3); partialSM(pA0, pA1, m_reg, mnA, alA);
    RESC(alA); LANDED();
    bp = b; b = bn; bn = bn == 2 ? 0 : bn + 1;
  }
  SBAR(); qkt<NQ>(pB0, pB1, K_lds + b * SHM_K, qr, ql, r32, hi); WMASK(pB0, pB1, NT - 1);
  finishSM(pA0, pA1, alA, l_reg, pa0, pa1, pa2, pa3); SBAR();
  pv_d0(o, vb0 + bp * (int)SHM_V, pa0, pa1, pa2, pa3); partialSM(pB0, pB1, m_reg, mnB, alB);
  RESC(alB);
  finishSM(pB0, pB1, alB, l_reg, pa0, pa1, pa2, pa3); SBAR();
  pv_d0(o, vb0 + b * (int)SHM_V, pa0, pa1, pa2, pa3);
  if (it.has_sink) { constexpr float C = SCALE * 1.4426950408889634f; l_reg += __builtin_amdgcn_exp2f(it.sinkv * 1.4426950408889634f - m_reg * C); }
  if (hi == 0) li_l[r32] = l_reg; asm volatile("s_waitcnt lgkmcnt(0)" ::: "memory");
  float rli[16];
#pragma unroll
  for (int r = 0; r < 16; ++r) rli[r] = __builtin_amdgcn_rcpf(li_l[crow(r, hi)]);
  bf16_t* Ow = P + (size_t)(it.qrow0 + wid * QBLK) * LDP;
  __syncthreads();
  {
    char* T = lds + wid * 12288;
#pragma unroll
    for (int r = 0; r < 16; ++r) { const int orow = crow(r, hi);
#pragma unroll
      for (int d0 = 0; d0 < 4; ++d0) *(unsigned short*)(T + orow * 272 + (d0 * 32 + r32) * 2) = f2bf(o[d0][r] * rli[r]); }
    asm volatile("s_waitcnt lgkmcnt(0)" ::: "memory");
    u32x4 gv[8];
#pragma unroll
    for (int k = 0; k < 8; ++k) { const int ci = k * 64 + lane; gv[k] = *(const u32x4*)(Ow + (size_t)(ci >> 4) * LDP + it.gcol + (ci & 15) * 8); }
#pragma unroll
    for (int k = 0; k < 8; ++k) { const int ci = k * 64 + lane; const u32x4 tv = *(const u32x4*)(T + (ci >> 4) * 272 + (ci & 15) * 16); const u32x4 g = gv[k];
      u32x4 w;
      w.x = cvtpk(bflo(tv.x) * silu_f(bflo(g.x)), bfhi(tv.x) * silu_f(bfhi(g.x))); w.y = cvtpk(bflo(tv.y) * silu_f(bflo(g.y)), bfhi(tv.y) * silu_f(bfhi(g.y)));
      w.z = cvtpk(bflo(tv.z) * silu_f(bflo(g.z)), bfhi(tv.z) * silu_f(bfhi(g.z))); w.w = cvtpk(bflo(tv.w) * silu_f(bflo(g.w)), bfhi(tv.w) * silu_f(bfhi(g.w)));
      if (!dry) *(u32x4*)(Ow + (size_t)(ci >> 4) * LDP + it.qcol + (ci & 15) * 8) = w; }
  }
  __syncthreads();
#undef TROW
#undef DMA
#undef LANDED
#undef RESC
#undef WMASK
}
}

struct Ctx {
    int tid, lane, wave, gw, ngw;
    char* lds;
};
#define LDS_WAIT() asm volatile("s_waitcnt lgkmcnt(0)" ::: "memory")

__device__ __forceinline__ void transpose_item(const float* __restrict__ W, int K, int Ntot, int src0, bf16_t* __restrict__ WT, int dst0, int ncols, float* scr, int item, int lane) {
    const int nblk = ncols / 32, kb = item / nblk, nb = item % nblk, k0 = 64 * kb, n0 = 32 * nb;
#pragma unroll 8
    for (int i = 0; i < 32; ++i) { const int kk = 2 * i + (lane >> 5); scr[kk * 33 + (lane & 31)] = __builtin_nontemporal_load(W + (size_t)(k0 + kk) * Ntot + src0 + n0 + (lane & 31)); }
    LDS_WAIT(); asm volatile("" ::: "memory");
    const int c = lane & 7;
#pragma unroll
    for (int j = 0; j < 4; ++j) { const int n = (lane >> 3) + 8 * j; const float* s = scr + (8 * c) * 33 + n;
        u32x4 o; o.x = cvtpk(s[0 * 33], s[1 * 33]); o.y = cvtpk(s[2 * 33], s[3 * 33]); o.z = cvtpk(s[4 * 33], s[5 * 33]); o.w = cvtpk(s[6 * 33], s[7 * 33]);
        *(u32x4*)(WT + (size_t)(dst0 + n0 + n) * K + k0 + 8 * c) = o; }
    LDS_WAIT(); asm volatile("" ::: "memory");
}
__device__ __forceinline__ void convert_weights(const Ctx& c, int l, const float* attn_w_in, const float* attn_w_out, const float* ssm_w_in, const float* ssm_w_out, bf16_t* W1, bf16_t* W2) {
    float* scr = (float*)(c.lds + c.wave * 16384);
    const int i = l >> 1;
    if ((l & 1) == 0) {
        const float* Wi = attn_w_in + (size_t)i * DM * AIN; const float* Wo = attn_w_out + (size_t)i * AW * DM;
        constexpr int I_IN = (DM / 64) * (AIN / 32), I_OUT = (AW / 64) * (DM / 32);
        for (int it = c.gw; it < I_IN + I_OUT; it += c.ngw) {
            if (it < I_IN) {
                const int kb = it / (AIN / 32), nbg = it % (AIN / 32), scol = nbg * 32;
                int src0, ncols, dst0;
                if (scol < 1024) { src0 = 0; ncols = 1024; dst0 = PC_QA; }
                else if (scol < 1280) { src0 = 1024; ncols = 256; dst0 = PC_KA; }
                else if (scol < 1536) { src0 = 1280; ncols = 256; dst0 = PC_VA; }
                else if (scol < 2560) { src0 = 1536; ncols = 1024; dst0 = PC_GA; }
                else if (scol < 3584) { src0 = 2560; ncols = 1024; dst0 = PC_QB; }
                else if (scol < 3840) { src0 = 3584; ncols = 256; dst0 = PC_KB; }
                else if (scol < 4096) { src0 = 3840; ncols = 256; dst0 = PC_VB; }
                else { src0 = 4096; ncols = 1024; dst0 = PC_GB; }
                const int nb = (scol - src0) / 32;
                transpose_item(Wi, DM, AIN, src0, W1, dst0, ncols, scr, kb * (ncols / 32) + nb, c.lane);
            } else transpose_item(Wo, AW, DM, 0, W2, 0, DM, scr, it - I_IN, c.lane);
        }
    } else {
        constexpr int SIN = 6208;
        const float* Wi = ssm_w_in + (size_t)i * DM * SIN; const float* Wo = ssm_w_out + (size_t)i * DI * DM;
        constexpr int I_IN = (DM / 64) * (SIN / 32), I_OUT = (DI / 64) * (DM / 32);
        for (int it = c.gw; it < I_IN + I_OUT; it += c.ngw) {
            if (it < I_IN) {
                const int kb = it / (SIN / 32), nbg = it % (SIN / 32), scol = nbg * 32;
                int src0, ncols, dst0;
                if (scol < 2048) { src0 = 0; ncols = 2048; dst0 = NXB; }
                else if (scol < 6144) { src0 = 2048; ncols = 4096; dst0 = 0; }
                else { src0 = 6144; ncols = 64; dst0 = 4096; }
                const int nb = (scol - src0) / 32;
                transpose_item(Wi, DM, SIN, src0, W1, dst0, ncols, scr, kb * (ncols / 32) + nb, c.lane);
            } else transpose_item(Wo, DI, DM, 0, W2, 0, DM, scr, it - I_IN, c.lane);
        }
    }
}

__device__ __forceinline__ void adaln_phase(const Ctx& c, const float* cvec, const float* cctx, const float* w_ada, const float* b_ada, float* MOD) {
    float* sv = (float*)c.lds;
    float* red = (float*)(c.lds + 5 * 1024 * 4);
    bool have = false;
    for (int it = blockIdx.x; it < DEPTH_ * 48; it += gridDim.x) {
        if (!have) { for (int e = c.tid; e < 5 * 1024; e += 512) { const float v = e < 4096 ? cvec[e] : cctx[e - 4096]; sv[e] = silu_f(v); } have = true; __syncthreads(); }
        const int l = it / 48, col = (it % 48) * 64 + c.lane;
        const float* wp = w_ada + ((size_t)l * DM + c.wave * 128) * 3072 + col;
        float a0 = 0, a1 = 0, a2 = 0, a3 = 0, a4 = 0;
#pragma unroll 8
        for (int k = 0; k < 128; ++k) { const float w = __builtin_nontemporal_load(wp + (size_t)k * 3072); const int kk = c.wave * 128 + k;
            a0 += sv[kk] * w; a1 += sv[1024 + kk] * w; a2 += sv[2048 + kk] * w; a3 += sv[3072 + kk] * w; a4 += sv[4096 + kk] * w; }
        float* rp = red + (c.wave * 5) * 64 + c.lane;
        rp[0] = a0; rp[64] = a1; rp[128] = a2; rp[192] = a3; rp[256] = a4;
        __syncthreads();
        if (c.tid < 320) { const int who = c.tid >> 6, ln = c.tid & 63; float s = b_ada[(size_t)l * 3072 + (it % 48) * 64 + ln];
#pragma unroll
            for (int w = 0; w < 8; ++w) s += red[(w * 5 + who) * 64 + ln];
            MOD[((size_t)l * 5 + who) * 3072 + (it % 48) * 64 + ln] = s; }
        __syncthreads();
    }
}
__device__ __forceinline__ void rope_phase(const Ctx& c, f32x2* rope) {
    for (int e = blockIdx.x * 512 + c.tid; e < 128 * 32; e += gridDim.x * 512) { const int pos = e >> 5, f = e & 31;
        const float inv = 1.0f / powf(10000.0f, (float)f / 32.0f); const float ang = (float)pos * inv;
        rope[e] = (f32x2){cosf(ang), sinf(ang)}; }
}

__device__ __forceinline__ void norm_pass(const Ctx& c, int l, const float* xin, float* xout, const float* cin, float* cout, bf16_t* HY, const float* MOD, const float* norm_pre, const float* norm_post, bool do_ctx, const bool dry) {
    const bool have_y = l >= 0, have_h = l + 1 < DEPTH_;
    const int nchunks = MLAT / 16 + (do_ctx ? MCTX : 0);
    for (int ch = c.gw; ch < nchunks; ch += c.ngw) {
        const bool isctx = ch >= MLAT / 16; const int row0 = isctx ? (ch - MLAT / 16) : ch * 16; const int who = isctx ? 4 : (row0 / T_); const int nrow = isctx ? 1 : 16;
        const float* xi = isctx ? cin : xin; float* xo = isctx ? cout : xout; const int hrow0 = isctx ? MLAT + row0 : row0;
        f32x4 A1[4], A2[4], A3[4];
#pragma unroll
        for (int j = 0; j < 4; ++j) { const int col = 4 * c.lane + 256 * j;
            if (have_y) { const f32x4 gt = *(const f32x4*)(MOD + ((size_t)l * 5 + who) * 3072 + 2048 + col); const f32x4 pw = *(const f32x4*)(norm_post + (size_t)l * DM + col); A1[j] = gt * pw; }
            if (have_h) { const f32x4 sh = *(const f32x4*)(MOD + ((size_t)(l + 1) * 5 + who) * 3072 + col), sc = *(const f32x4*)(MOD + ((size_t)(l + 1) * 5 + who) * 3072 + 1024 + col);
                const f32x4 pw = *(const f32x4*)(norm_pre + (size_t)(l + 1) * DM + col); A2[j] = pw * (sc + 1.0f); A3[j] = sh; } }
        f32x4 nx[4]; u32x2 ny[4];
#pragma unroll
        for (int j = 0; j < 4; ++j) { nx[j] = __builtin_nontemporal_load((const f32x4*)(xi + (size_t)row0 * DM + 4 * c.lane + 256 * j)); if (have_y) ny[j] = __builtin_nontemporal_load((const u32x2*)(HY + (size_t)hrow0 * DM + 4 * c.lane + 256 * j)); }
        for (int r = 0; r < nrow; ++r) {
            const size_t xoff = (size_t)(row0 + r) * DM, hoff = (size_t)(hrow0 + r) * DM;
            f32x4 x[4]; u32x2 yw[4];
#pragma unroll
            for (int j = 0; j < 4; ++j) { x[j] = nx[j]; yw[j] = ny[j]; }
            if (r + 1 < nrow) {
#pragma unroll
                for (int j = 0; j < 4; ++j) { nx[j] = __builtin_nontemporal_load((const f32x4*)(xi + xoff + DM + 4 * c.lane + 256 * j)); if (have_y) ny[j] = __builtin_nontemporal_load((const u32x2*)(HY + hoff + DM + 4 * c.lane + 256 * j)); } }
            if (have_y) {
                f32x4 y[4]; float ssq = 0.f;
#pragma unroll
                for (int j = 0; j < 4; ++j) { const u32x2 w = yw[j]; y[j] = (f32x4){bflo(w.x), bfhi(w.x), bflo(w.y), bfhi(w.y)};
                    ssq += (y[j][0] * y[j][0] + y[j][1] * y[j][1]) + (y[j][2] * y[j][2] + y[j][3] * y[j][3]); }
                const float rs = rsqrtf(wave_sum(ssq) * (1.f / DM) + EPS_);
#pragma unroll
                for (int j = 0; j < 4; ++j) { x[j] = x[j] + A1[j] * (y[j] * rs); if (!dry) __builtin_nontemporal_store(x[j], (f32x4*)(xo + xoff + 4 * c.lane + 256 * j)); }
            }
            if (have_h) {
                float ssq = 0.f;
#pragma unroll
                for (int j = 0; j < 4; ++j) ssq += (x[j][0] * x[j][0] + x[j][1] * x[j][1]) + (x[j][2] * x[j][2] + x[j][3] * x[j][3]);
                const float rs = rsqrtf(wave_sum(ssq) * (1.f / DM) + EPS_);
#pragma unroll
                for (int j = 0; j < 4; ++j) { const f32x4 h = x[j] * rs * A2[j] + A3[j]; u32x2 w; w.x = cvtpk(h[0], h[1]); w.y = cvtpk(h[2], h[3]); if (!dry) *(u32x2*)(HY + hoff + 4 * c.lane + 256 * j) = w; }
            }
        }
    }
}

__device__ __forceinline__ void kprep_pass(const Ctx& c, bf16_t* P, const float* knw, const f32x2* rope, const bool dry) {
    const int hsel = c.lane >> 4, e0 = (c.lane & 15) * 8;
    const int col = (hsel < 2 ? PC_KA + hsel * 128 : PC_KB + (hsel - 2) * 128) + e0;
    const f32x4 w0 = *(const f32x4*)(knw + e0), w1 = *(const f32x4*)(knw + e0 + 4);
    for (int row0 = c.gw; row0 < MTOT; row0 += 2 * c.ngw) {
        const int row1 = row0 + c.ngw; const bool two = row1 < MTOT;
        const u32x4 rawA = *(const u32x4*)(P + (size_t)row0 * AIN + col);
        const u32x4 rawB = two ? *(const u32x4*)(P + (size_t)row1 * AIN + col) : (u32x4){0u, 0u, 0u, 0u};
#pragma unroll
        for (int half = 0; half < 2; ++half) {
        if (half == 1 && !two) break;
        const int row = half ? row1 : row0; const u32x4 raw = half ? rawB : rawA;
        bf16_t* p = P + (size_t)row * AIN + col;
        float v[8] = {bflo(raw.x), bfhi(raw.x), bflo(raw.y), bfhi(raw.y), bflo(raw.z), bfhi(raw.z), bflo(raw.w), bfhi(raw.w)};
        if (hsel >= 2) { float ssq = 0.f;
#pragma unroll
            for (int j = 0; j < 8; ++j) ssq += v[j] * v[j];
            ssq += __shfl_xor(ssq, 1); ssq += __shfl_xor(ssq, 2); ssq += __shfl_xor(ssq, 4); ssq += __shfl_xor(ssq, 8);
            const float rs = rsqrtf(ssq * (1.f / 128.f) + EPS_);
#pragma unroll
            for (int j = 0; j < 4; ++j) { v[j] *= rs * w0[j]; v[4 + j] *= rs * w1[j]; } }
        if (row < MLAT) { const int pos = row & (T_ - 1), i0 = e0 >> 1; const int tab = i0 < 32 ? (pos >> 6) : (pos & 63);
            const f32x4* tp = (const f32x4*)(rope + tab * 32 + (i0 & 31)); const f32x4 c01 = tp[0], c23 = tp[1];
            float x0, x1;
            x0 = v[0]; x1 = v[1]; v[0] = x0 * c01[0] - x1 * c01[1]; v[1] = x0 * c01[1] + x1 * c01[0];
            x0 = v[2]; x1 = v[3]; v[2] = x0 * c01[2] - x1 * c01[3]; v[3] = x0 * c01[3] + x1 * c01[2];
            x0 = v[4]; x1 = v[5]; v[4] = x0 * c23[0] - x1 * c23[1]; v[5] = x0 * c23[1] + x1 * c23[0];
            x0 = v[6]; x1 = v[7]; v[6] = x0 * c23[2] - x1 * c23[3]; v[7] = x0 * c23[3] + x1 * c23[2]; }
        if (!dry && (hsel >= 2 || row < MLAT)) { u32x4 w = {cvtpk(v[0], v[1]), cvtpk(v[2], v[3]), cvtpk(v[4], v[5]), cvtpk(v[6], v[7])}; *(u32x4*)p = w; }
        }
    }
}

__device__ __forceinline__ void conv_pass(const Ctx& c, bf16_t* X, const bf16_t* halo, const float* cw, const float* cb, const bool dry) {
    for (int u = blockIdx.x; u < (MTOT / 128) * 4; u += gridDim.x) {
        const int ck = u >> 2, q = u & 3, strip = c.tid & 127, rg = c.tid >> 7, col = q * 1024 + strip * 8, row0 = ck * 128 + rg * 32;
        const bool seq_start = ck < 256 ? (ck & 63) == 0 : ((ck - 256) & 1) == 0, seq_end = ck < 256 ? (ck & 63) == 63 : ((ck - 256) & 1) == 1;
        float w0[8], w1[8], w2[8], bs[8];
#pragma unroll
        for (int j = 0; j < 8; ++j) { w0[j] = cw[col + j]; w1[j] = cw[CONVD + col + j]; w2[j] = cw[2 * CONVD + col + j]; bs[j] = cb[col + j]; }
        u32x4 prev = {0u, 0u, 0u, 0u}, last = {0u, 0u, 0u, 0u};
        if (rg == 0) { if (!seq_start) prev = *(const u32x4*)(halo + ((size_t)(ck - 1) * 2 + 1) * CONVD + col); } else prev = *(const u32x4*)(X + (size_t)(row0 - 1) * CONVD + col);
        if (rg == 3) { if (!seq_end) last = *(const u32x4*)(halo + ((size_t)(ck + 1) * 2 + 0) * CONVD + col); } else last = *(const u32x4*)(X + (size_t)(row0 + 32) * CONVD + col);
        u32x4 cur = *(const u32x4*)(X + (size_t)row0 * CONVD + col);
        asm volatile("s_waitcnt vmcnt(0)" ::: "memory");
        __syncthreads();
        for (int ib = 0; ib < 4; ++ib) {
            u32x4 nx[8];
#pragma unroll
            for (int i = 0; i < 8; ++i) { const int r = ib * 8 + i + 1; nx[i] = (r < 32) ? *(const u32x4*)(X + (size_t)(row0 + r) * CONVD + col) : last; }
#pragma unroll
            for (int i = 0; i < 8; ++i) {
                const u32x4 n = nx[i];
                const float pv[8] = {bflo(prev.x), bfhi(prev.x), bflo(prev.y), bfhi(prev.y), bflo(prev.z), bfhi(prev.z), bflo(prev.w), bfhi(prev.w)};
                const float cv[8] = {bflo(cur.x), bfhi(cur.x), bflo(cur.y), bfhi(cur.y), bflo(cur.z), bfhi(cur.z), bflo(cur.w), bfhi(cur.w)};
                const float nv[8] = {bflo(n.x), bfhi(n.x), bflo(n.y), bfhi(n.y), bflo(n.z), bfhi(n.z), bflo(n.w), bfhi(n.w)};
                float o[8];
#pragma unroll
                for (int j = 0; j < 8; ++j) o[j] = silu_f(bs[j] + w0[j] * pv[j] + w1[j] * cv[j] + w2[j] * nv[j]);
                u32x4 w = {cvtpk(o[0], o[1]), cvtpk(o[2], o[3]), cvtpk(o[4], o[5]), cvtpk(o[6], o[7])};
                if (!dry) *(u32x4*)(X + (size_t)(row0 + ib * 8 + i) * CONVD + col) = w;
                prev = cur; cur = n;
            }
        }
        asm volatile("s_waitcnt vmcnt(0)" ::: "memory");
        __syncthreads();
    }
}

__device__ __forceinline__ void gnorm_pass(const Ctx& c, bf16_t* Y, const bf16_t* Z, const float* nw, const int nrows, const bool dry) {
    f32x4 w[8];
#pragma unroll
    for (int j = 0; j < 8; ++j) w[j] = *(const f32x4*)(nw + 256 * j + 4 * c.lane);
    for (int row = c.gw; row < nrows; row += c.ngw) {
        const size_t off = (size_t)row * DI + 4 * c.lane;
        u32x2 yv[8], zv[8];
#pragma unroll
        for (int j = 0; j < 8; ++j) { yv[j] = *(const u32x2*)(Y + off + 256 * j); zv[j] = *(const u32x2*)(Z + off + 256 * j); }
#pragma unroll
        for (int j = 0; j < 8; ++j) {
            f32x4 g = {bflo(yv[j].x) * silu_f(bflo(zv[j].x)), bfhi(yv[j].x) * silu_f(bfhi(zv[j].x)), bflo(yv[j].y) * silu_f(bflo(zv[j].y)), bfhi(yv[j].y) * silu_f(bfhi(zv[j].y))};
            const float ssq = wave_sum((g[0] * g[0] + g[1] * g[1]) + (g[2] * g[2] + g[3] * g[3]));
            const float rs = rsqrtf(ssq * (1.f / 256.f) + EPS_);
            g = g * rs * w[j];
            u32x2 o; o.x = cvtpk(g[0], g[1]); o.y = cvtpk(g[2], g[3]); if (!dry) *(u32x2*)(Y + off + 256 * j) = o;
        }
    }
}

namespace ssd {
constexpr int RS = 272;
constexpr int O_CN = 0, O_BN = 34816, O_GP = 69632, O_XDT = 104448, O_XW = 112640, O_XN = 120832, O_HS = 129024, O_CUM = 137728, LDS_SSD = O_CUM + 1024;
#define MF32(a, b, c) __builtin_amdgcn_mfma_f32_32x32x16_bf16(a, b, c, 0, 0, 0)
#define PK8(L, H) (bf16x8){L[0], L[1], L[2], L[3], H[0], H[1], H[2], H[3]}
__device__ __forceinline__ u32x2 pack4(float a, float b, float c, float d) { u32x2 w; w.x = cvtpk(a, b); w.y = cvtpk(c, d); return w; }


#define RDL(x, n) __uint_as_float((unsigned)__builtin_amdgcn_readlane((int)__float_as_uint(x), (n)))
__device__ __forceinline__ float wave_scan_incl(float v, int lane) {
#define DPP_SHR(x, n) __uint_as_float((unsigned)__builtin_amdgcn_update_dpp(0, (int)__float_as_uint(x), 0x110 + (n), 0xf, 0xf, true))
    v += DPP_SHR(v, 1); v += DPP_SHR(v, 2); v += DPP_SHR(v, 4); v += DPP_SHR(v, 8);
#undef DPP_SHR
    const float t0 = RDL(v, 15), t1 = RDL(v, 31), t2 = RDL(v, 47);
    const int row = lane >> 4;
    v += row == 1 ? t0 : row == 2 ? t0 + t1 : row == 3 ? (t0 + t1) + t2 : 0.f;
    return v;
}
template <int KK0> __device__ __forceinline__ void state_steps(f32x16& S, int base_b, int base_w) {
    using att::tr_read;
    const s16x4 a0l = tr_read<(KK0 + 0) * 16 * RS>(base_b), a0h = tr_read<(KK0 + 0) * 16 * RS + 4 * RS>(base_b), a1l = tr_read<(KK0 + 1) * 16 * RS>(base_b), a1h = tr_read<(KK0 + 1) * 16 * RS + 4 * RS>(base_b);
    const s16x4 a2l = tr_read<(KK0 + 2) * 16 * RS>(base_b), a2h = tr_read<(KK0 + 2) * 16 * RS + 4 * RS>(base_b), a3l = tr_read<(KK0 + 3) * 16 * RS>(base_b), a3h = tr_read<(KK0 + 3) * 16 * RS + 4 * RS>(base_b);
    const s16x4 b0l = tr_read<(KK0 + 0) * 1024>(base_w), b0h = tr_read<(KK0 + 0) * 1024 + 256>(base_w), b1l = tr_read<(KK0 + 1) * 1024>(base_w), b1h = tr_read<(KK0 + 1) * 1024 + 256>(base_w);
    const s16x4 b2l = tr_read<(KK0 + 2) * 1024>(base_w), b2h = tr_read<(KK0 + 2) * 1024 + 256>(base_w), b3l = tr_read<(KK0 + 3) * 1024>(base_w), b3h = tr_read<(KK0 + 3) * 1024 + 256>(base_w);
    asm volatile("s_waitcnt lgkmcnt(0)" ::: "memory"); SBAR();
    S = MF32(PK8(a0l, a0h), PK8(b0l, b0h), S); S = MF32(PK8(a1l, a1h), PK8(b1l, b1h), S);
    S = MF32(PK8(a2l, a2h), PK8(b2l, b2h), S); S = MF32(PK8(a3l, a3h), PK8(b3l, b3h), S);
}
template <int KK0> __device__ __forceinline__ void ydiag_steps(f32x16& acc, int base_x, const char* gp_row) {
    using att::tr_read;
    const s16x4 a0l = tr_read<(KK0 + 0) * 1024>(base_x), a0h = tr_read<(KK0 + 0) * 1024 + 256>(base_x), a1l = tr_read<(KK0 + 1) * 1024>(base_x), a1h = tr_read<(KK0 + 1) * 1024 + 256>(base_x);
    const s16x4 a2l = tr_read<(KK0 + 2) * 1024>(base_x), a2h = tr_read<(KK0 + 2) * 1024 + 256>(base_x), a3l = tr_read<(KK0 + 3) * 1024>(base_x), a3h = tr_read<(KK0 + 3) * 1024 + 256>(base_x);
    asm volatile("s_waitcnt lgkmcnt(0)" ::: "memory"); SBAR();
    const bf16x8 b0 = *(const bf16x8*)(gp_row + (KK0 + 0) * 32), b1 = *(const bf16x8*)(gp_row + (KK0 + 1) * 32), b2 = *(const bf16x8*)(gp_row + (KK0 + 2) * 32), b3 = *(const bf16x8*)(gp_row + (KK0 + 3) * 32);
    acc = MF32(PK8(a0l, a0h), b0, acc); acc = MF32(PK8(a1l, a1h), b1, acc); acc = MF32(PK8(a2l, a2h), b2, acc); acc = MF32(PK8(a3l, a3h), b3, acc);
}

__device__ __forceinline__ void scan_phase(const Ctx& c, const int dir, const bf16_t* __restrict__ X, const float* __restrict__ DT, bf16_t* __restrict__ Y, const float* __restrict__ a_log, const float* __restrict__ dskip, const bool dry, const int pvar) {
    char* L = c.lds; float* cumL = (float*)(L + O_CUM);
    const int tid = c.tid, lane = c.lane, wave = c.wave, r32 = lane & 31, hi = lane >> 5;
    const int blk = (lane >> 4) & 1, qq = (lane & 15) >> 2, pp = lane & 3;
    for (int item = blockIdx.x; item < 256; item += gridDim.x) {
        const int xcd_ = item & 7, slot_ = item >> 3, grp_ = xcd_ + 8 * (slot_ >> 3), mem_ = slot_ & 7;
        const int ph = mem_ & 1, b = grp_ >> 3, g = grp_ & 7, h = 4 * g + (mem_ >> 1);
        const float Acoef = -__expf(a_log[dir * 32 + h]), Dh = dskip[h];
        const int xcol = h * 64 + ph * 32, bcol = 2048 + g * 128, ccol = 3072 + g * 128, dtcol = dir * 32 + h;
        f32x16 S = {};
        bf16x8 rc[4], rb[4], rx; float d0r, d1r;
#define CHUNK_ROW(q) ((q) < 2 ? MLAT + b * CL + (dir == 0 ? (q) : 1 - (q)) * 128 : b * T_ + (dir == 0 ? (q) - 2 : 65 - (q)) * 128)
#define LOADCHUNK(q) do { const int R_ = CHUNK_ROW(q);                                                                         \
        _Pragma("unroll") for (int i = 0; i < 4; ++i) { const size_t ro = (size_t)(R_ + (tid >> 4) + 32 * i) * CONVD + (tid & 15) * 8;     \
            rc[i] = *(const bf16x8*)(X + ro + ccol); rb[i] = *(const bf16x8*)(X + ro + bcol); }                                \
        rx = *(const bf16x8*)(X + (size_t)(R_ + (tid >> 2)) * CONVD + xcol + (tid & 3) * 8);                                    \
        d0r = DT[(size_t)dtcol * MTOT + R_ + lane]; d1r = DT[(size_t)dtcol * MTOT + R_ + 64 + lane]; } while (0)
        LOADCHUNK(0);
        for (int q = 0; q < 66; ++q) {
            const int R0 = CHUNK_ROW(q);
            const float a0 = d0r * Acoef, a1 = d1r * Acoef;
            float p0 = wave_scan_incl(a0, lane), p1 = wave_scan_incl(a1, lane);
            p1 += RDL(p0, 63);
            const float tot = RDL(p1, 63);
            float c0, c1;
            if (dir == 0) { c0 = p0; c1 = p1; } else { c0 = tot - p0 + a0; c1 = tot - p1 + a1; }
            if (wave == 0) { cumL[lane] = c0; cumL[64 + lane] = c1; }
#pragma unroll
            for (int i = 0; i < 4; ++i) { const int off = ((tid >> 4) + 32 * i) * RS + (tid & 15) * 16;
                *(bf16x8*)(L + O_CN + off) = rc[i]; *(bf16x8*)(L + O_BN + off) = rb[i]; }
            {
                const int sl = (tid >> 2) & 63;
                const float dts = __shfl(wave < 4 ? d0r : d1r, sl), cums = __shfl(wave < 4 ? c0 : c1, sl);
                const float wend = dts * __expf(tot - cums);
                float xv[8];
#pragma unroll
                for (int j = 0; j < 8; ++j) xv[j] = bf2f((unsigned short)rx[j]);
                const int xo = (tid >> 2) * 64 + (tid & 3) * 16;
                *(bf16x8*)(L + O_XN + xo) = rx;
                u32x4 w1 = {cvtpk(xv[0] * dts, xv[1] * dts), cvtpk(xv[2] * dts, xv[3] * dts), cvtpk(xv[4] * dts, xv[5] * dts), cvtpk(xv[6] * dts, xv[7] * dts)};
                u32x4 w2 = {cvtpk(xv[0] * wend, xv[1] * wend), cvtpk(xv[2] * wend, xv[3] * wend), cvtpk(xv[4] * wend, xv[5] * wend), cvtpk(xv[6] * wend, xv[7] * wend)};
                *(u32x4*)(L + O_XDT + xo) = w1; *(u32x4*)(L + O_XW + xo) = w2;
            }
            if (q + 1 < 66) LOADCHUNK(q + 1);
            __syncthreads();
            if (!(dry && pvar == 1)) {
            if (wave >= 4) { const int nb = (wave - 4) * 32;
#pragma unroll
                for (int qd = 0; qd < 4; ++qd) *(u32x2*)(L + O_HS + r32 * RS + (nb + 8 * qd + 4 * hi) * 2) = pack4(S[4 * qd], S[4 * qd + 1], S[4 * qd + 2], S[4 * qd + 3]); }
            {
                const int sb = wave >> 1, lb0 = 2 * (wave & 1);
                const char* ap = L + O_BN + (sb * 32 + r32) * RS + hi * 16; const char* bp0 = L + O_CN + (lb0 * 32 + r32) * RS + hi * 16; const char* bp1 = bp0 + 32 * RS;
                bf16x8 fa[8], fb0[8], fb1[8];
#pragma unroll
                for (int kk = 0; kk < 8; ++kk) { fa[kk] = *(const bf16x8*)(ap + kk * 32); fb0[kk] = *(const bf16x8*)(bp0 + kk * 32); fb1[kk] = *(const bf16x8*)(bp1 + kk * 32); }
                f32x16 acc0 = {}, acc1 = {};
#pragma unroll
                for (int kk = 0; kk < 8; ++kk) { acc0 = MF32(fa[kk], fb0[kk], acc0); acc1 = MF32(fa[kk], fb1[kk], acc1); }
#pragma unroll
                for (int tt = 0; tt < 2; ++tt) {
                    const int lb = lb0 + tt, l = lb * 32 + r32; const float cl = cumL[l];
#pragma unroll
                    for (int qd = 0; qd < 4; ++qd) { float v[4];
#pragma unroll
                        for (int e = 0; e < 4; ++e) { const int s_ = sb * 32 + 8 * qd + 4 * hi + e; const float cs = cumL[s_];
                            const float av = tt == 0 ? acc0[4 * qd + e] : acc1[4 * qd + e];
                            const bool valid = dir == 0 ? (s_ <= l) : (s_ >= l); v[e] = valid ? av * __expf(cl - cs) : 0.f; }
                        *(u32x2*)(L + O_GP + l * RS + (sb * 32 + 8 * qd + 4 * hi) * 2) = pack4(v[0], v[1], v[2], v[3]); }
                }
            }
            }
            __syncthreads();
            if (dry && pvar >= 1) { } else
            if (wave < 4) {
                const int l = wave * 32 + r32;
                f32x16 aoff = {}, adg = {};
                bf16_t* yp = Y + (size_t)(R0 + l) * DI + xcol;
                u32x2 pvv[4] = {};
                if (dir == 0) {
#pragma unroll
                    for (int qd = 0; qd < 4; ++qd) pvv[qd] = *(const u32x2*)(yp + 8 * qd + 4 * hi); }
                const char* hp = L + O_HS + r32 * RS + hi * 16; const char* cp = L + O_CN + l * RS + hi * 16;
                {
                    bf16x8 fh[8], fc[8];
#pragma unroll
                    for (int kk = 0; kk < 8; ++kk) { fh[kk] = *(const bf16x8*)(hp + kk * 32); fc[kk] = *(const bf16x8*)(cp + kk * 32); }
#pragma unroll
                    for (int kk = 0; kk < 8; ++kk) aoff = MF32(fh[kk], fc[kk], aoff);
                }
                const int base_x = (int)(uintptr_t)(L + O_XDT) + (8 * hi + qq) * 64 + (16 * blk + 4 * pp) * 2;
                const char* gp_row = L + O_GP + l * RS + hi * 16;
                ydiag_steps<0>(adg, base_x, gp_row); ydiag_steps<4>(adg, base_x, gp_row);
                const float ec = __expf(cumL[l]);
#pragma unroll
                for (int qd = 0; qd < 4; ++qd) { const int pc = 8 * qd + 4 * hi; float v[4];
#pragma unroll
                    for (int e = 0; e < 4; ++e) v[e] = aoff[4 * qd + e] * ec + adg[4 * qd + e];
                    if (dir == 0) { const u32x2 xn = *(const u32x2*)(L + O_XN + l * 64 + pc * 2); const u32x2 pv = pvv[qd];
                        v[0] += Dh * bflo(xn.x) + bflo(pv.x); v[1] += Dh * bfhi(xn.x) + bfhi(pv.x); v[2] += Dh * bflo(xn.y) + bflo(pv.y); v[3] += Dh * bfhi(xn.y) + bfhi(pv.y); }
                    if (!dry) *(u32x2*)(yp + pc) = pack4(v[0], v[1], v[2], v[3]); }
            } else {
                const int nb = (wave - 4) * 32; const float dec = __expf(tot);
#pragma unroll
                for (int r = 0; r < 16; ++r) S[r] *= dec;
                const int base_b = (int)(uintptr_t)(L + O_BN) + (8 * hi + qq) * RS + (nb + 16 * blk + 4 * pp) * 2;
                const int base_w = (int)(uintptr_t)(L + O_XW) + (8 * hi + qq) * 64 + (16 * blk + 4 * pp) * 2;
                state_steps<0>(S, base_b, base_w); state_steps<4>(S, base_b, base_w);
            }
            __syncthreads();
        }
#undef CHUNK_ROW
#undef LOADCHUNK
    }
}
}

constexpr int LDS_BYTES = 163840;
#ifndef PROBE_OP
#define PROBE_OP -1
#endif
struct Args { const float* in[21]; float* out; unsigned char* ws; long probe; };

enum Op { OP_GEMM_BF16 = 0, OP_GEMM_XBC, OP_GEMM_IN, OP_ATTN, OP_CONV, OP_SCAN, OP_GEMM_Z, OP_NORM, OP_PROLOGUE };

__device__ __forceinline__ void attn_phase(const Ctx& c, int li, bf16_t* P, const float* sink, const float* qnw, const f32x2* rope, const bool dry, const int pvar) {
    for (int i = blockIdx.x; i < 2112; i += gridDim.x) {
        att::Item it;
        if (i < 2048) {
            const int ii = i & 1023, x = ii & 7, wi = (ii >> 3) & 31, k = ii >> 8, b = x >> 1, kvh = x & 1, head = kvh * 4 + k, i0 = wi * 256;
            const bool mixB = i < 1024;
            it.qrow0 = b * T_ + i0; it.qpos0 = i0;
            if (mixB) { it.qcol = PC_QB + head * 128; it.gcol = PC_GB + head * 128; it.kcol = PC_KB + kvh * 128; it.vcol = PC_VB + kvh * 128;
                it.n0 = T_ / 64; it.r0 = b * T_; it.r1 = MLAT + b * CL; it.NT = T_ / 64 + CL / 64; it.kp1 = 0; it.masked = 0; it.normq = 1; it.has_sink = 0; it.sinkv = 0.f; }
            else { const int ks = i0 >= 128 ? i0 - 128 : 0, ke = i0 + 384 <= T_ ? i0 + 384 : T_;
                it.qcol = PC_QA + head * 128; it.gcol = PC_GA + head * 128; it.kcol = PC_KA + kvh * 128; it.vcol = PC_VA + kvh * 128;
                it.n0 = CL / 64; it.r0 = MLAT + b * CL; it.r1 = b * T_ + ks; it.NT = CL / 64 + (ke - ks) / 64; it.kp1 = ks; it.masked = 1; it.normq = 0; it.has_sink = 1; it.sinkv = sink[head]; }
        } else {
            const int j = i - 2048, head = j & 7, mixB = (j >> 3) & 1, b = j >> 4, kvh = head >> 2;
            it.qrow0 = MLAT + b * CL; it.qpos0 = -1; it.n0 = CL / 64; it.r0 = MLAT + b * CL; it.r1 = 0; it.NT = CL / 64; it.kp1 = 0; it.masked = 0;
            if (mixB) { it.qcol = PC_QB + head * 128; it.gcol = PC_GB + head * 128; it.kcol = PC_KB + kvh * 128; it.vcol = PC_VB + kvh * 128; it.normq = 1; it.has_sink = 0; it.sinkv = 0.f; }
            else { it.qcol = PC_QA + head * 128; it.gcol = PC_GA + head * 128; it.kcol = PC_KA + kvh * 128; it.vcol = PC_VA + kvh * 128; it.normq = 0; it.has_sink = 1; it.sinkv = sink[head]; }
        }
        if (it.masked) att::attn_item<true>(P, it, qnw, rope, c.lds, c.tid, dry); else att::attn_item<false>(P, it, qnw, rope, c.lds, c.tid, dry);
    }
}

__global__ void __launch_bounds__(512) mega(Args a) {
    extern __shared__ __attribute__((aligned(16))) unsigned char lds_[];
    cg::grid_group grid = cg::this_grid();
    volatile XLAS unsigned* bst = (volatile XLAS unsigned*)((XLAS unsigned char*)lds_ + (LDS_BYTES - 16));
    if (threadIdx.x < 4) bst[threadIdx.x] = 0u;
    __syncthreads();
    XcdBarrier xbar = xcd_barrier_post((unsigned*)a.ws, bst);
    int nsync = 0;
    unsigned char* ws = a.ws;
    float* MOD = (float*)(ws + WS_MOD); f32x2* ROPE = (f32x2*)(ws + WS_ROPE); float* CTXR = (float*)(ws + WS_CTX);
    bf16_t* W1 = (bf16_t*)(ws + WS_W1); bf16_t* W2 = (bf16_t*)(ws + WS_W2); bf16_t* HY = (bf16_t*)(ws + WS_HY);
    float* DTB = (float*)(ws + WS_DT); bf16_t* HALO = (bf16_t*)(ws + WS_HALO); bf16_t* BIG = (bf16_t*)(ws + WS_BIG); bf16_t* YB = (bf16_t*)(ws + WS_Y);
    const float* x_in = a.in[0]; const float* cvec = a.in[1]; const float* ctx_in = a.in[2]; const float* c_ctx = a.in[3]; const float* w_ada = a.in[4]; const float* b_ada = a.in[5];
    const float* norm_pre = a.in[6]; const float* norm_post = a.in[7]; const float* attn_w_in = a.in[8]; const float* attn_w_out = a.in[9]; const float* attn_sink = a.in[10];
    const float* attn_qn = a.in[11]; const float* attn_kn = a.in[12]; const float* ssm_w_in = a.in[13]; const float* conv_w = a.in[14]; const float* conv_b = a.in[15];
    const float* dt_bias = a.in[16]; const float* a_log = a.in[17]; const float* ssm_d = a.in[18]; const float* ssm_norm = a.in[19]; const float* ssm_w_out = a.in[20];

    int l = -1, st = 0;
    for (;;) {
        int op; const bool ssm = (l & 1) != 0 && l >= 0;
        if (l < 0) op = st == 0 ? OP_PROLOGUE : OP_NORM;
        else if (!ssm) op = st == 0 ? OP_GEMM_IN : st == 1 ? OP_ATTN : st == 2 ? OP_GEMM_BF16 : OP_NORM;
        else op = st == 0 ? OP_GEMM_XBC : st == 1 ? OP_CONV : (st == 2 || st == 3) ? OP_SCAN : st == 4 ? OP_GEMM_Z : st == 5 ? OP_GEMM_BF16 : OP_NORM;
        const int li = l >> 1;
        {
        constexpr bool dry = false;
        int tid_ = threadIdx.x; asm volatile("" : "+v"(tid_));
        Ctx c; c.tid = tid_; c.lane = c.tid & 63; c.wave = __builtin_amdgcn_readfirstlane(c.tid >> 6); c.gw = blockIdx.x * 8 + c.wave; c.ngw = gridDim.x * 8; c.lds = (char*)lds_;
        switch (op) {
#ifndef DIS_PRO
        case OP_PROLOGUE: {
            convert_weights(c, 0, attn_w_in, attn_w_out, ssm_w_in, ssm_w_out, W1, W2);
            __syncthreads();
            adaln_phase(c, cvec, c_ctx, w_ada, b_ada, MOD);
            rope_phase(c, ROPE);
        } break;
#endif
#ifndef DIS_NORM
        case OP_NORM: {
            const bool first = l <= 0;
            norm_pass(c, l, first ? x_in : a.out, a.out, first ? ctx_in : CTXR, CTXR, HY, MOD, norm_pre, norm_post, l < DEPTH_ - 1, dry);
            if (!dry && l >= 0 && l + 1 < DEPTH_) { __syncthreads(); convert_weights(c, l + 1, attn_w_in, attn_w_out, ssm_w_in, ssm_w_out, W1, W2); }
        } break;
#endif
#ifndef DIS_GEMM
        case OP_GEMM_BF16: {
            pg8::Gemm g; pg8::EpiBf16 E;
            if (!ssm) { g = pg8::Gemm{BIG, W2, MTOT, DM, AW, AIN}; E = pg8::EpiBf16{HY, DM}; }
            else { g = pg8::Gemm{YB, W2, MTOT, DM, DI, DI}; E = pg8::EpiBf16{HY, DM}; }
            if (l == DEPTH_ - 1) g.M = MLAT;
            pg8::StaticOrder S; S.init(g.M, g.N, (int)gridDim.x, (int)blockIdx.x);
            pg8::gemm_phase<pg8::EpiBf16, pg8::StaticOrder, true, true>((PG8_LAS unsigned char*)lds_, g, S, E, c.tid);
        } break;
#endif
#ifndef DIS_GEMMX
        case OP_GEMM_XBC: {
            pg8::Gemm g{HY, W1, MTOT, NXB, DM, DM}; pg8::EpiXbc E{BIG, HALO, DTB, dt_bias + (size_t)li * 64};
            pg8::StaticOrder S; S.init(g.M, g.N, (int)gridDim.x, (int)blockIdx.x);
            pg8::gemm_phase<pg8::EpiXbc, pg8::StaticOrder, true, true>((PG8_LAS unsigned char*)lds_, g, S, E, c.tid);
        } break;
#endif
#ifndef DIS_KPREP
        case OP_GEMM_IN: {
            pg8::Gemm g{HY, W1, MTOT, AIN, DM, DM};
            pg8::EpiAttnIn E{BIG, attn_kn + (size_t)li * 128, ROPE, (PG8_LAS float*)((PG8_LAS unsigned char*)lds_ + 131072)};
            pg8::StaticOrder S; S.init(g.M, g.N, (int)gridDim.x, (int)blockIdx.x);
            pg8::gemm_phase<pg8::EpiAttnIn, pg8::StaticOrder, true, true>((PG8_LAS unsigned char*)lds_, g, S, E, c.tid);
        } break;
#endif
#ifndef DIS_ATTN
        case OP_ATTN: attn_phase(c, li, BIG, attn_sink + (size_t)li * 8, attn_qn + (size_t)li * 128, ROPE, dry, 0); break;
#endif
#ifndef DIS_CONV
        case OP_CONV: conv_pass(c, BIG, HALO, conv_w + (size_t)li * 3 * CONVD, conv_b + (size_t)li * CONVD, dry); break;
#endif
#ifndef DIS_SCAN
        case OP_SCAN: ssd::scan_phase(c, st == 2 ? 1 : 0, BIG, DTB, YB, a_log + (size_t)li * 64, ssm_d + (size_t)li * 32, dry, 0); break;
#endif
#ifndef DIS_GNORM
        case OP_GEMM_Z: {
            pg8::Gemm g{HY, W1 + (size_t)NXB * DM, l == DEPTH_ - 1 ? MLAT : MTOT, DI, DM, DM};
            pg8::EpiGnorm E{YB, ssm_norm + (size_t)li * DI, (PG8_LAS float*)((PG8_LAS unsigned char*)lds_ + 131072)};
            pg8::StaticOrder S; S.init(g.M, g.N, (int)gridDim.x, (int)blockIdx.x);
            pg8::gemm_phase<pg8::EpiGnorm, pg8::StaticOrder, true, true>((PG8_LAS unsigned char*)lds_, g, S, E, c.tid);
        } break;
#endif
        default: break;
        }
        }
        const int nst = l < 0 ? 2 : (ssm ? 7 : 4);
        if (++st == nst) { st = 0; ++l; if (l == DEPTH_) break; }
        if (nsync++ == 0) grid.sync(); else xcd_barrier(xbar);
    }
}

extern "C" void kernel_launch(void* const* d_in, const int* in_sizes, int n_in, void* d_out, int out_size, void* d_ws, size_t ws_size, hipStream_t stream) {
    static int grid = 0;
    if (grid == 0) {
        if (n_in != 21 || in_sizes[0] != MLAT * DM || out_size != MLAT * DM || ws_size < WS_END) {
            fprintf(stderr, "kernel_launch: unexpected shapes (n_in %d, in0 %d, out %d, ws %zu < %zu?)\n", n_in, n_in > 0 ? in_sizes[0] : -1, out_size, ws_size, (size_t)WS_END); grid = -1; return; }
        int dev = 0, cus = 0, per_cu = 0;
        if (hipGetDevice(&dev) != hipSuccess || hipDeviceGetAttribute(&cus, hipDeviceAttributeMultiprocessorCount, dev) != hipSuccess) { grid = -1; return; }
        if (hipFuncSetAttribute((const void*)mega, hipFuncAttributeMaxDynamicSharedMemorySize, LDS_BYTES) != hipSuccess) { fprintf(stderr, "kernel_launch: hipFuncSetAttribute failed\n"); grid = -1; return; }
        if (hipOccupancyMaxActiveBlocksPerMultiprocessor(&per_cu, (const void*)mega, 512, LDS_BYTES) != hipSuccess || per_cu < 1) { fprintf(stderr, "kernel_launch: occupancy query says %d\n", per_cu); per_cu = 1; }
        (void)hipGetLastError();
        grid = cus * per_cu;
    }
    if (grid < 0) return;
    Args a{};
    for (int i = 0; i < 21; ++i) a.in[i] = (const float*)d_in[i];
    a.out = (float*)d_out; a.ws = (unsigned char*)d_ws; a.probe = PROBE_OP;
    if (hipMemsetAsync(d_ws, 0, 16384, stream) != hipSuccess) { fprintf(stderr, "kernel_launch: memset failed\n"); return; }
    void* args[] = {&a};
    hipError_t e = hipLaunchCooperativeKernel((const void*)mega, dim3(grid), dim3(512), args, LDS_BYTES, stream);
    if (e != hipSuccess) fprintf(stderr, "kernel_launch: cooperative launch failed: %s (grid %d)\n", hipGetErrorString(e), grid);
}
```

```cpp
#include <hip/hip_runtime.h>
#include <hip/hip_bf16.h>
#include <hip/hip_cooperative_groups.h>
#include <cstdio>
#include <cstdint>
namespace cg = cooperative_groups;

constexpr int T_ = 8192, NB = 4, CL = 256, DM = 1024, MLAT = NB * T_, MCTX = NB * CL, MTOT = MLAT + MCTX;
constexpr int DEPTH_ = 4;
constexpr int AIN = 5120, AW = 2048;
constexpr int DI = 2048, CONVD = 4096, SSMH = 32, NXB = 4352;
constexpr float EPS_ = 1e-6f;
constexpr int PC_QA = 0, PC_QB = 1024, PC_KA = 2048, PC_VA = 2304, PC_KB = 2560, PC_VB = 2816, PC_GA = 3072, PC_GB = 4096;

constexpr size_t MiB = 1u << 20;
constexpr size_t WS_MOD = 1 * MiB;
constexpr size_t WS_ROPE = WS_MOD + 512 * 1024;
constexpr size_t WS_CTX = 2 * MiB;
constexpr size_t WS_W1 = 6 * MiB;
constexpr size_t WS_W2 = 19 * MiB;
constexpr size_t WS_HY = 26 * MiB;
constexpr size_t WS_DT = 92 * MiB;
constexpr size_t WS_HALO = 101 * MiB;
constexpr size_t WS_BIG = 106 * MiB;
constexpr size_t WS_Y = 370 * MiB;
constexpr size_t WS_END = 502 * MiB;

typedef unsigned short bf16_t;
typedef short bf16x8 __attribute__((ext_vector_type(8)));
typedef short s16x4 __attribute__((ext_vector_type(4)));
typedef float f32x4 __attribute__((ext_vector_type(4)));
typedef float f32x2 __attribute__((ext_vector_type(2)));
typedef float f32x16 __attribute__((ext_vector_type(16)));
typedef unsigned u32x4 __attribute__((ext_vector_type(4)));
typedef unsigned u32x2 __attribute__((ext_vector_type(2)));

__device__ __forceinline__ unsigned cvtpk(float lo, float hi) { unsigned r; asm volatile("v_cvt_pk_bf16_f32 %0, %1, %2" : "=v"(r) : "v"(lo), "v"(hi)); return r; }
__device__ __forceinline__ float bf2f(unsigned short u) { return __uint_as_float((unsigned)u << 16); }
__device__ __forceinline__ float bflo(unsigned w) { return __uint_as_float(w << 16); }
__device__ __forceinline__ float bfhi(unsigned w) { return __uint_as_float(w & 0xffff0000u); }
__device__ __forceinline__ unsigned short f2bf(float f) { return (unsigned short)(cvtpk(f, 0.f) & 0xffffu); }
__device__ __forceinline__ float silu_f(float x) { return x * __builtin_amdgcn_rcpf(1.f + __expf(-x)); }
__device__ __forceinline__ float wave_sum(float v) {
#pragma unroll
    for (int o = 1; o < 64; o <<= 1) v += __shfl_xor(v, o);
    return v;
}
__device__ __forceinline__ int crow(int r, int hi) { return (r & 3) + 8 * (r >> 2) + 4 * hi; }
#define SBAR() __builtin_amdgcn_sched_barrier(0)

#define XLAS __attribute__((address_space(3)))
#define XB_TMO      128
#define XB_XCNT(j)  (256  + 64 * (j))
#define XB_XSUB(j)  (1280 + 64 * (j))
#define XB_XGEN(j)  (2304 + 64 * (j))
#define XB_TOP      3328
#define XB_TOPGEN   3392
#define XCD_BAR_WORDS 3456
#define XB_SPIN_CAP (1u << 18)

__device__ __forceinline__ unsigned xb_ld(unsigned* p)              { return __hip_atomic_load(p, __ATOMIC_RELAXED, __HIP_MEMORY_SCOPE_AGENT); }
__device__ __forceinline__ unsigned xb_add(unsigned* p, unsigned v) { return __hip_atomic_fetch_add(p, v, __ATOMIC_RELAXED, __HIP_MEMORY_SCOPE_AGENT); }
__device__ __forceinline__ unsigned xb_xcc_id() { return (unsigned)__builtin_amdgcn_s_getreg((3 << 11) | 20) & 0xFu; }
#define XB_SPIN(cond, bar) do { unsigned _sp = 0; while (cond) { __builtin_amdgcn_s_sleep(1); \
    if ((++_sp & 255u) == 0u) { if (xb_ld(&(bar)[XB_TMO])) break; if (_sp > XB_SPIN_CAP) { atomicAdd(&(bar)[XB_TMO], 1u); break; } } } } while (0)

struct XcdBarrier {
    unsigned* bar; unsigned x;
    volatile XLAS unsigned* st;
};

__device__ __forceinline__ XcdBarrier xcd_barrier_post(unsigned* bar, volatile XLAS unsigned* st) {
    XcdBarrier b; b.bar = bar; b.x = xb_xcc_id(); b.st = st;
    if (threadIdx.x == 0) (void)xb_add(&bar[XB_XCNT(b.x)], 1u);
    return b;
}
__device__ __forceinline__ void xcd_barrier_complete(unsigned* bar, unsigned x, unsigned& nloc, unsigned& nx) {
    const unsigned G = gridDim.x * gridDim.y * gridDim.z;
    unsigned sum, cnt, mine, sp = 0u;
    for (;;) {
        sum = 0u; cnt = 0u; mine = 0u;
#pragma unroll
        for (unsigned j = 0; j < 16; ++j) { const unsigned c = xb_ld(&bar[XB_XCNT(j)]); sum += c; cnt += (c > 0u) ? 1u : 0u; mine = (j == x) ? c : mine; }
        if (sum == G) break;
        __builtin_amdgcn_s_sleep(1);
        if ((++sp & 255u) == 0u) { if (xb_ld(&bar[XB_TMO])) break; if (sp > XB_SPIN_CAP) { atomicAdd(&bar[XB_TMO], 1u); break; } }
    }
    nloc = mine > 0u ? mine : 1u; nx = cnt > 0u ? cnt : 1u;
}

__device__ __forceinline__ void xcd_barrier(const XcdBarrier& b) {
    asm volatile("s_waitcnt vmcnt(0)" ::: "memory");
    __syncthreads();
    if (threadIdx.x == 0) {
        unsigned* bar = b.bar;
        __builtin_amdgcn_s_waitcnt(0);
        unsigned nloc = b.st[0], nx = b.st[1];
        if (nloc == 0u) { xcd_barrier_complete(bar, b.x, nloc, nx); b.st[0] = nloc; b.st[1] = nx; }
        const unsigned old = xb_add(&bar[XB_XSUB(b.x)], 1u);
        const unsigned gen = old / nloc;
        if (old + 1u == (gen + 1u) * nloc) {
            __builtin_amdgcn_fence(__ATOMIC_RELEASE, "agent");
            asm volatile("s_waitcnt vmcnt(0)" ::: "memory");
            const unsigned og = xb_add(&bar[XB_TOP], 1u);
            const unsigned tg = og / nx;
            if (og + 1u == (tg + 1u) * nx) xb_add(&bar[XB_TOPGEN], 1u);
            else XB_SPIN(xb_ld(&bar[XB_TOPGEN]) == tg, bar);
            __builtin_amdgcn_fence(__ATOMIC_ACQUIRE, "agent");
            xb_add(&bar[XB_XGEN(b.x)], 1u);
            asm volatile("s_waitcnt vmcnt(0)" ::: "memory");
        } else {
            XB_SPIN(xb_ld(&bar[XB_XGEN(b.x)]) == gen, bar);
            __builtin_amdgcn_fence(__ATOMIC_ACQUIRE, "agent");
            asm volatile("s_waitcnt vmcnt(0)" ::: "memory");
        }
    }
    __syncthreads();
}
namespace pg8 {
#define PG8_LAS __attribute__((address_space(3)))
typedef unsigned short bf16_t;
typedef short bf16x8 __attribute__((ext_vector_type(8)));
typedef float f32x4 __attribute__((ext_vector_type(4)));
typedef unsigned u32x4 __attribute__((ext_vector_type(4)));
constexpr int BM = 256, BK = 64, HALF = 128, HTB = HALF * BK * 2  , STAGE_BYTES = 8 * HTB, NXCD = 8, WGM = 8;

__host__ __device__ __forceinline__ int lds_byte(int r, int c) { const int st = (r >> 4) * 2 + (c >> 5), rr = r & 15, cc = c & 31, ob = rr * 64 + cc * 2; return st * 1024 + (ob ^ (((ob >> 9) & 1) << 5)); }
__host__ __device__ __forceinline__ void stage_rc(int b, int& R, int& C) { const int st = b / 1024, sb = b % 1024, swz = sb ^ (((sb >> 9) & 1) << 5); R = (st >> 1) * 16 + swz / 64; C = (st & 1) * 32 + (swz % 64) / 2; }
__host__ __device__ __forceinline__ int perm32(int rho) { const int n = rho >> 4, i = rho & 15; return 8 * (i >> 2) + 4 * n + (i & 3); }

struct Unit { int pm, pn; };
struct Gemm { const bf16_t* A; const bf16_t* Bt; int M, N, K, lda; };

struct StaticOrder {
    int nM, nN, nwg, G, c;
    __host__ __device__ void init(int M, int N, int G_, int c_) { nM = M / BM; nN = N / BM; nwg = nM * nN; G = G_; c = c_; }
    __host__ __device__ bool next(int i, Unit& u) const {
        const long L = (long)i * G + c; if (L >= nwg) return false;
        int wgid = (int)L; { const int q = nwg / NXCD, r = nwg % NXCD, xcd = wgid % NXCD, off = wgid / NXCD; wgid = (xcd < r ? xcd * (q + 1) : r * (q + 1) + (xcd - r) * q) + off; }
        const int nig = WGM * nN, gid = wgid / nig, fm = gid * WGM, gsz = (nM - fm) < WGM ? (nM - fm) : WGM;
        u.pm = fm + ((wgid % nig) % gsz); u.pn = (wgid % nig) / gsz; return true;
    }
    __device__ __forceinline__ void a_ready(const Unit&) const {}
    __device__ __forceinline__ void done(const Unit&) const {}
};

struct EpiBf16 {
    static constexpr bool PERM = true, AFTER_DRAIN = false;
    bf16_t* O; int ldc;
    __device__ __forceinline__ void operator()(const f32x4 (&acc)[2][2][4][2], const Unit& u, int wr, int wc, int fr, int fq) const {
        asm volatile("s_nop 7\n\ts_nop 7\n\ts_nop 7" ::: "memory");
        const int row0 = u.pm * BM + wr * 64 + fr, col0 = u.pn * BM + wc * 32 + 8 * fq;
#pragma unroll
        for (int ai = 0; ai < 2; ++ai)
#pragma unroll
            for (int m = 0; m < 4; ++m) { bf16_t* rowp = O + (size_t)(row0 + ai * HALF + m * 16) * ldc + col0;
#pragma unroll
                for (int bj = 0; bj < 2; ++bj) { const f32x4 v0 = acc[ai][bj][m][0], v1 = acc[ai][bj][m][1];
                    u32x4 w; w.x = cvtpk(v0[0], v0[1]); w.y = cvtpk(v0[2], v0[3]); w.z = cvtpk(v1[0], v1[1]); w.w = cvtpk(v1[2], v1[3]);
                    *(u32x4*)(rowp + bj * HALF) = w; } }
    }
};
struct EpiGnorm {
    static constexpr bool PERM = true, AFTER_DRAIN = false;
    bf16_t* Y; const float* nw; PG8_LAS float* tab;
    __device__ __forceinline__ void operator()(f32x4 (&acc)[2][2][4][2], const Unit& u, int wr, int wc, int fr, int fq) const {
        const int row0 = u.pm * BM + wr * 64 + fr, col0 = u.pn * BM + wc * 32 + 8 * fq;
#pragma unroll
        for (int ai = 0; ai < 2; ++ai)
#pragma unroll
            for (int m = 0; m < 4; ++m) { const bf16_t* yp = Y + (size_t)(row0 + ai * HALF + m * 16) * DI + col0; float ssq = 0.f;
#pragma unroll
                for (int bj = 0; bj < 2; ++bj) { const u32x4 yv = *(const u32x4*)(yp + bj * HALF); f32x4& z0 = acc[ai][bj][m][0]; f32x4& z1 = acc[ai][bj][m][1];
                    z0[0] = bflo(yv.x) * silu_f(z0[0]); z0[1] = bfhi(yv.x) * silu_f(z0[1]); z0[2] = bflo(yv.y) * silu_f(z0[2]); z0[3] = bfhi(yv.y) * silu_f(z0[3]);
                    z1[0] = bflo(yv.z) * silu_f(z1[0]); z1[1] = bfhi(yv.z) * silu_f(z1[1]); z1[2] = bflo(yv.w) * silu_f(z1[2]); z1[3] = bfhi(yv.w) * silu_f(z1[3]);
                    ssq += (z0[0] * z0[0] + z0[1] * z0[1]) + (z0[2] * z0[2] + z0[3] * z0[3]) + (z1[0] * z1[0] + z1[1] * z1[1]) + (z1[2] * z1[2] + z1[3] * z1[3]); }
                ssq += __shfl_xor(ssq, 16); ssq += __shfl_xor(ssq, 32);
                if (fq == 0) tab[(ai * HALF + wr * 64 + m * 16 + fr) * 4 + wc] = ssq; }
        asm volatile("s_waitcnt lgkmcnt(0)" ::: "memory"); __builtin_amdgcn_s_barrier(); asm volatile("" ::: "memory");
        f32x4 w[2][2];
#pragma unroll
        for (int bj = 0; bj < 2; ++bj) { w[bj][0] = *(const f32x4*)(nw + col0 + bj * HALF); w[bj][1] = *(const f32x4*)(nw + col0 + bj * HALF + 4); }
#pragma unroll
        for (int ai = 0; ai < 2; ++ai)
#pragma unroll
            for (int m = 0; m < 4; ++m) { const f32x4 t = *(const PG8_LAS f32x4*)(tab + (ai * HALF + wr * 64 + m * 16 + fr) * 4);
                const float rs = rsqrtf(((t[0] + t[1]) + (t[2] + t[3])) * (1.f / 256.f) + EPS_);
                bf16_t* yp = Y + (size_t)(row0 + ai * HALF + m * 16) * DI + col0;
#pragma unroll
                for (int bj = 0; bj < 2; ++bj) { const f32x4 v0 = acc[ai][bj][m][0] * rs * w[bj][0], v1 = acc[ai][bj][m][1] * rs * w[bj][1];
                    u32x4 o; o.x = cvtpk(v0[0], v0[1]); o.y = cvtpk(v0[2], v0[3]); o.z = cvtpk(v1[0], v1[1]); o.w = cvtpk(v1[2], v1[3]);
                    *(u32x4*)(yp + bj * HALF) = o; } }
    }
};
struct EpiAttnIn {
    static constexpr bool PERM = true, AFTER_DRAIN = false;
    bf16_t* O; const float* knw; const f32x2* rope; PG8_LAS float* tab;
    __device__ __forceinline__ void operator()(f32x4 (&acc)[2][2][4][2], const Unit& u, int wr, int wc, int fr, int fq) const {
        asm volatile("s_nop 7\n\ts_nop 7\n\ts_nop 7" ::: "memory");
        const int row0 = u.pm * BM + wr * 64 + fr, col0 = u.pn * BM + wc * 32 + 8 * fq;
        const bool isK = u.pn == 8 || u.pn == 10, isB = u.pn == 10;
        if (isB) {
#pragma unroll
            for (int ai = 0; ai < 2; ++ai)
#pragma unroll
                for (int m = 0; m < 4; ++m)
#pragma unroll
                    for (int bj = 0; bj < 2; ++bj) { const f32x4 a = acc[ai][bj][m][0], b = acc[ai][bj][m][1];
                        float ssq = (a[0] * a[0] + a[1] * a[1]) + (a[2] * a[2] + a[3] * a[3]) + (b[0] * b[0] + b[1] * b[1]) + (b[2] * b[2] + b[3] * b[3]);
                        ssq += __shfl_xor(ssq, 16); ssq += __shfl_xor(ssq, 32);
                        if (fq == 0) tab[((ai * HALF + wr * 64 + m * 16 + fr) * 2 + bj) * 4 + wc] = ssq; }
            asm volatile("s_waitcnt lgkmcnt(0)" ::: "memory"); __builtin_amdgcn_s_barrier(); asm volatile("" ::: "memory");
        }
        f32x4 kw0 = {1.f, 1.f, 1.f, 1.f}, kw1 = kw0;
        if (isB) { kw0 = *(const f32x4*)(knw + wc * 32 + 8 * fq); kw1 = *(const f32x4*)(knw + wc * 32 + 8 * fq + 4); }
        const int i0 = wc * 16 + 4 * fq;
#pragma unroll
        for (int ai = 0; ai < 2; ++ai)
#pragma unroll
            for (int m = 0; m < 4; ++m) { const int row = row0 + ai * HALF + m * 16; bf16_t* rowp = O + (size_t)row * AIN + col0;
                f32x4 c01 = {1.f, 0.f, 1.f, 0.f}, c23 = c01;
                const bool rot = isK && row < MLAT;
                if (rot) { const int pos = row & (T_ - 1); const int tb = i0 < 32 ? (pos >> 6) : (pos & 63); const f32x4* tp = (const f32x4*)(rope + tb * 32 + (i0 & 31)); c01 = tp[0]; c23 = tp[1]; }
#pragma unroll
                for (int bj = 0; bj < 2; ++bj) { f32x4 v0 = acc[ai][bj][m][0], v1 = acc[ai][bj][m][1];
                    if (isB) { const f32x4 t = *(const PG8_LAS f32x4*)(tab + ((ai * HALF + wr * 64 + m * 16 + fr) * 2 + bj) * 4);
                        const float rs = rsqrtf(((t[0] + t[1]) + (t[2] + t[3])) * (1.f / 128.f) + EPS_); v0 = v0 * rs * kw0; v1 = v1 * rs * kw1; }
                    if (rot) { float x0, x1;
                        x0 = v0[0]; x1 = v0[1]; v0[0] = x0 * c01[0] - x1 * c01[1]; v0[1] = x0 * c01[1] + x1 * c01[0];
                        x0 = v0[2]; x1 = v0[3]; v0[2] = x0 * c01[2] - x1 * c01[3]; v0[3] = x0 * c01[3] + x1 * c01[2];
                        x0 = v1[0]; x1 = v1[1]; v1[0] = x0 * c23[0] - x1 * c23[1]; v1[1] = x0 * c23[1] + x1 * c23[0];
                        x0 = v1[2]; x1 = v1[3]; v1[2] = x0 * c23[2] - x1 * c23[3]; v1[3] = x0 * c23[3] + x1 * c23[2]; }
                    u32x4 w; w.x = cvtpk(v0[0], v0[1]); w.y = cvtpk(v0[2], v0[3]); w.z = cvtpk(v1[0], v1[1]); w.w = cvtpk(v1[2], v1[3]);
                    *(u32x4*)(rowp + bj * HALF) = w; } }
    }
};
struct EpiXbc {
    static constexpr bool PERM = true, AFTER_DRAIN = false;
    bf16_t* O; bf16_t* halo; float* dt; const float* dtb;
    __device__ __forceinline__ void operator()(const f32x4 (&acc)[2][2][4][2], const Unit& u, int wr, int wc, int fr, int fq) const {
        asm volatile("s_nop 7\n\ts_nop 7\n\ts_nop 7" ::: "memory");
        const int row0 = u.pm * BM + wr * 64 + fr;
        if (u.pn < 16) {
            const int col0 = u.pn * BM + wc * 32 + 8 * fq;
#pragma unroll
            for (int ai = 0; ai < 2; ++ai)
#pragma unroll
                for (int m = 0; m < 4; ++m) { const int row = row0 + ai * HALF + m * 16; bf16_t* rowp = O + (size_t)row * CONVD + col0;
                    const int rl = row & 127;
#pragma unroll
                    for (int bj = 0; bj < 2; ++bj) { const f32x4 v0 = acc[ai][bj][m][0], v1 = acc[ai][bj][m][1];
                        u32x4 w; w.x = cvtpk(v0[0], v0[1]); w.y = cvtpk(v0[2], v0[3]); w.z = cvtpk(v1[0], v1[1]); w.w = cvtpk(v1[2], v1[3]);
                        *(u32x4*)(rowp + bj * HALF) = w;
                        if (rl == 0) *(u32x4*)(halo + ((size_t)(row >> 7) * 2 + 0) * CONVD + col0 + bj * HALF) = w;
                        if (rl == 127) *(u32x4*)(halo + ((size_t)(row >> 7) * 2 + 1) * CONVD + col0 + bj * HALF) = w; } }
        } else {
            const int lc = wc * 32 + 8 * fq;
            if (wc < 2) {
                const f32x4 b0 = *(const f32x4*)(dtb + lc), b1 = *(const f32x4*)(dtb + lc + 4);
#pragma unroll
                for (int ai = 0; ai < 2; ++ai)
#pragma unroll
                    for (int m = 0; m < 4; ++m) { const int row = row0 + ai * HALF + m * 16;
                        f32x4 v0 = acc[ai][0][m][0] + b0, v1 = acc[ai][0][m][1] + b1;
#pragma unroll
                        for (int j = 0; j < 4; ++j) { const float e0 = __expf(v0[j]), e1 = __expf(v1[j]);
                            v0[j] = v0[j] > 20.f ? v0[j] : (v0[j] < -8.f ? e0 : __logf(1.f + e0)); v1[j] = v1[j] > 20.f ? v1[j] : (v1[j] < -8.f ? e1 : __logf(1.f + e1)); }
#pragma unroll
                        for (int j = 0; j < 4; ++j) { dt[(size_t)(lc + j) * MTOT + row] = v0[j]; dt[(size_t)(lc + 4 + j) * MTOT + row] = v1[j]; } }
            }
        }
    }
};
template <class Epi, class Sched, bool ALIGN_EPI = false, bool SP2 = false>
__device__ __forceinline__ void gemm_phase(PG8_LAS unsigned char* lds, const Gemm g, const Sched& S, const Epi& E, const int tid) {
    const int wid = __builtin_amdgcn_readfirstlane(tid >> 6), lane = tid & 63, wr = wid >> 2, wc = wid & 3, fr = lane & 15, fq = lane >> 4;
    const int K = g.K, nt = K / BK;
    unsigned voffA[2], voffB[2];
#pragma unroll
    for (int i = 0; i < 2; ++i) { int R, C; stage_rc(tid * 16 + i * 8192, R, C); const int Rb = Epi::PERM ? ((R & ~31) + perm32(R & 31)) : R;
        voffA[i] = (unsigned)(R * g.lda + C) * 2u; voffB[i] = (unsigned)(Rb * K + C) * 2u; }
    const size_t kstep = (size_t)(BK * 2);
    const size_t hstepA = (size_t)HALF * g.lda * 2, hstepB = (size_t)HALF * K * 2;
    const size_t tstepA = 2 * hstepA, tstepB = 2 * hstepB;
    const unsigned ldsw = (unsigned)wid * 1024u;
    const int aoff = lds_byte(wr * 64 + fr, fq * 8), boff = lds_byte(wc * 32 + fr, fq * 8);
#define PG8_SA(b, h) (((b) * 2 + (h)) * HTB)
#define PG8_SB(b, h) ((4 + (b) * 2 + (h)) * HTB)
#define PG8_STAGE(bufoff, gbase, voff) do { _Pragma("unroll") for (int _i = 0; _i < 2; ++_i) \
        __builtin_amdgcn_global_load_lds((const unsigned*)((const char*)(gbase) + (voff)[_i]), (PG8_LAS unsigned*)(lds + (bufoff) + ldsw + _i * 8192), 16, 0, 0); } while (0)
#define PG8_LDA(dst, b, h) do { _Pragma("unroll") for (int m = 0; m < 4; ++m) _Pragma("unroll") for (int k = 0; k < 2; ++k) dst[m][k] = *(const PG8_LAS bf16x8*)(lds + PG8_SA(b, h) + aoff + m * 2048 + k * 1024); } while (0)
#define PG8_LDB(dst, b, h) do { _Pragma("unroll") for (int n = 0; n < 2; ++n) _Pragma("unroll") for (int k = 0; k < 2; ++k) dst[n][k] = *(const PG8_LAS bf16x8*)(lds + PG8_SB(b, h) + boff + n * 2048 + k * 1024); } while (0)
#define PG8_MMA(ai, bj, At, Bt) do { __builtin_amdgcn_s_setprio(1); _Pragma("unroll") for (int m = 0; m < 4; ++m) _Pragma("unroll") for (int n = 0; n < 2; ++n) _Pragma("unroll") for (int k = 0; k < 2; ++k) \
        acc[ai][bj][m][n] = __builtin_amdgcn_mfma_f32_16x16x32_bf16(Bt[n][k], At[m][k], acc[ai][bj][m][n], 0, 0, 0); __builtin_amdgcn_s_setprio(0); } while (0)
#define PG8_WAIT_V(n) asm volatile("s_waitcnt vmcnt(" #n ")" ::: "memory")
#define PG8_WAIT_L(n) asm volatile("s_waitcnt lgkmcnt(" #n ")" ::: "memory")
#define PG8_BAR __builtin_amdgcn_s_barrier()
#define PG8_SCHED __builtin_amdgcn_sched_barrier(0)
    Unit cur, nxt; int ui = 0;
    if (!S.next(0, cur)) return;
    f32x4 acc[2][2][4][2];
#pragma unroll
    for (int a = 0; a < 2; ++a)
#pragma unroll
        for (int b = 0; b < 2; ++b)
#pragma unroll
            for (int m = 0; m < 4; ++m)
#pragma unroll
                for (int n = 0; n < 2; ++n) acc[a][b][m][n] = (f32x4){0.f, 0.f, 0.f, 0.f};
    bf16x8 At[4][2], B0[2][2], B1[2][2];
    const char* cA = (const char*)g.A + (size_t)cur.pm * tstepA; const char* cB = (const char*)g.Bt + (size_t)cur.pn * tstepB;
    S.a_ready(cur);
    if constexpr (SP2) {
        PG8_STAGE(PG8_SB(0, 0), cB, voffB); PG8_STAGE(PG8_SB(0, 1), cB + hstepB, voffB); PG8_STAGE(PG8_SA(0, 0), cA, voffA); PG8_STAGE(PG8_SA(0, 1), cA + hstepA, voffA);
        if (wr == 1) PG8_BAR;
        PG8_WAIT_V(2); PG8_BAR;
        PG8_STAGE(PG8_SB(1, 0), cB + kstep, voffB); PG8_STAGE(PG8_SA(1, 0), cA + kstep, voffA); PG8_STAGE(PG8_SB(1, 1), cB + hstepB + kstep, voffB);
        PG8_WAIT_V(6); PG8_BAR;
    } else {
        PG8_STAGE(PG8_SB(0, 0), cB, voffB); PG8_STAGE(PG8_SA(0, 0), cA, voffA); PG8_STAGE(PG8_SB(0, 1), cB + hstepB, voffB); PG8_STAGE(PG8_SA(0, 1), cA + hstepA, voffA);
        if (wr == 1) PG8_BAR;
        PG8_WAIT_V(4); PG8_BAR;
        PG8_STAGE(PG8_SB(1, 0), cB + kstep, voffB); PG8_STAGE(PG8_SA(1, 0), cA + kstep, voffA); PG8_STAGE(PG8_SB(1, 1), cB + hstepB + kstep, voffB);
        PG8_WAIT_V(6); PG8_BAR;
    }
    for (;;) {
        const bool has_next = S.next(ui + 1, nxt);
        const char* nA = has_next ? (const char*)g.A + (size_t)nxt.pm * tstepA : cA; const char* nB = has_next ? (const char*)g.Bt + (size_t)nxt.pn * tstepB : cB;
        for (int t = 0; t < nt; t += 2) {
            const bool last = (t == nt - 2);
            const char* a1 = cA + (size_t)(t + 1) * kstep;
            const char* a2 = last ? nA : cA + (size_t)(t + 2) * kstep; const char* b2 = last ? nB : cB + (size_t)(t + 2) * kstep;
            const char* a3 = a2 + kstep; const char* b3 = b2 + kstep;
            if (last && has_next) S.a_ready(nxt);
            if constexpr (SP2) {
            PG8_LDB(B0, 0, 0); PG8_LDB(B1, 0, 1); PG8_SCHED; PG8_LDA(At, 0, 0); PG8_STAGE(PG8_SA(1, 1), a1 + hstepA, voffA);
            PG8_WAIT_V(8); PG8_WAIT_L(0); PG8_BAR; PG8_MMA(0, 0, At, B0); PG8_MMA(0, 1, At, B1); PG8_BAR; PG8_SCHED;
            PG8_LDA(At, 0, 1); PG8_STAGE(PG8_SB(0, 0), b2, voffB); PG8_STAGE(PG8_SB(0, 1), b2 + hstepB, voffB); PG8_STAGE(PG8_SA(0, 0), a2, voffA);
            PG8_WAIT_V(8); PG8_WAIT_L(0); PG8_BAR; PG8_MMA(1, 0, At, B0); PG8_MMA(1, 1, At, B1); PG8_BAR; PG8_SCHED;
            PG8_LDB(B0, 1, 0); PG8_LDB(B1, 1, 1); PG8_SCHED; PG8_LDA(At, 1, 0); PG8_STAGE(PG8_SA(0, 1), a2 + hstepA, voffA);
            PG8_WAIT_V(8); PG8_WAIT_L(0); PG8_BAR; PG8_MMA(0, 0, At, B0); PG8_MMA(0, 1, At, B1); PG8_BAR; PG8_SCHED;
            PG8_LDA(At, 1, 1); PG8_STAGE(PG8_SB(1, 0), b3, voffB); PG8_STAGE(PG8_SB(1, 1), b3 + hstepB, voffB); PG8_STAGE(PG8_SA(1, 0), a3, voffA);
            PG8_WAIT_V(8); PG8_WAIT_L(0); PG8_BAR; PG8_MMA(1, 0, At, B0); PG8_MMA(1, 1, At, B1); PG8_BAR; PG8_SCHED;
            } else {
            PG8_LDB(B0, 0, 0); PG8_SCHED; PG8_LDA(At, 0, 0); PG8_STAGE(PG8_SA(1, 1), a1 + hstepA, voffA);
            PG8_WAIT_L(8); PG8_BAR; PG8_WAIT_L(0); PG8_MMA(0, 0, At, B0); PG8_BAR; PG8_SCHED;
            PG8_LDB(B1, 0, 1); PG8_STAGE(PG8_SB(0, 0), b2, voffB);
            PG8_BAR; PG8_WAIT_L(0); PG8_MMA(0, 1, At, B1); PG8_BAR;
            PG8_LDA(At, 0, 1); PG8_STAGE(PG8_SA(0, 0), a2, voffA);
            PG8_BAR; PG8_WAIT_L(0); PG8_MMA(1, 0, At, B0); PG8_BAR; PG8_SCHED;
            PG8_STAGE(PG8_SB(0, 1), b2 + hstepB, voffB);
            PG8_WAIT_V(6); PG8_BAR; PG8_MMA(1, 1, At, B1); PG8_BAR;
            PG8_LDB(B0, 1, 0); PG8_SCHED; PG8_LDA(At, 1, 0); PG8_STAGE(PG8_SA(0, 1), a2 + hstepA, voffA);
            PG8_WAIT_L(8); PG8_BAR; PG8_WAIT_L(0); PG8_MMA(0, 0, At, B0); PG8_BAR; PG8_SCHED;
            PG8_LDB(B1, 1, 1); PG8_STAGE(PG8_SB(1, 0), b3, voffB);
            PG8_BAR; PG8_WAIT_L(0); PG8_MMA(0, 1, At, B1); PG8_BAR;
            PG8_LDA(At, 1, 1); PG8_STAGE(PG8_SA(1, 0), a3, voffA);
            PG8_BAR; PG8_WAIT_L(0); PG8_MMA(1, 0, At, B0); PG8_BAR; PG8_SCHED;
            PG8_STAGE(PG8_SB(1, 1), b3 + hstepB, voffB);
            PG8_WAIT_V(6); PG8_BAR; PG8_MMA(1, 1, At, B1); PG8_BAR;
            }
        }
        if constexpr (ALIGN_EPI) { if (wr == 0) PG8_BAR; }
        if constexpr (!Epi::AFTER_DRAIN) { E(acc, cur, wr, wc, fr, fq); S.done(cur); }
        if (!has_next) break;
#pragma unroll
        for (int a = 0; a < 2; ++a)
#pragma unroll
            for (int b = 0; b < 2; ++b)
#pragma unroll
                for (int m = 0; m < 4; ++m)
#pragma unroll
                    for (int n = 0; n < 2; ++n) acc[a][b][m][n] = (f32x4){0.f, 0.f, 0.f, 0.f};
        cur = nxt; cA = nA; cB = nB; ++ui;
        if constexpr (ALIGN_EPI) { if (wr == 1) PG8_BAR; }
    }
    PG8_WAIT_V(0);
    if constexpr (!ALIGN_EPI) { if (wr == 0) PG8_BAR; }
    PG8_BAR;
    if constexpr (Epi::AFTER_DRAIN) { E.fused(acc, cur, wr, wc, fr, fq, lds, wid, lane); S.done(cur); }
#undef PG8_SA
#undef PG8_SB
#undef PG8_STAGE
#undef PG8_LDA
#undef PG8_LDB
#undef PG8_MMA
#undef PG8_WAIT_V
#undef PG8_WAIT_L
#undef PG8_BAR
#undef PG8_SCHED
}
}
namespace att {
constexpr int D = 128, NW = 8, QBLK = 32, KVBLK = 64, LDP = AIN;
constexpr float SCALE = 0.088388347648318440f, THR = 8.f;
#ifndef ATT_NQR
#define ATT_NQR 5
#endif
#ifndef ATT_NQR_U
#define ATT_NQR_U 8
#endif
constexpr int NQR = ATT_NQR, NQR_U = ATT_NQR_U;
constexpr size_t SHM_V = KVBLK * D * 2, SHM_K = KVBLK * D * 2, SHM_ATTN = 2 * SHM_V + 2 * SHM_K + NW * 64 * 4, SHM_Q = (8 - NQR) * 8192;
#define KSWZ(row, colB) ((row) * 256 + ((colB) ^ (((row) & 7) << 4)))
__device__ __forceinline__ void partialSM(f32x16& p0, f32x16& p1, float& m_reg, float& mn, float& alpha) {
  constexpr float C = SCALE * 1.4426950408889634f;
  float pmax = p0[0];
#pragma unroll
  for (int r = 1; r < 16; ++r) pmax = fmaxf(pmax, p0[r]);
#pragma unroll
  for (int r = 0; r < 16; ++r) pmax = fmaxf(pmax, p1[r]);
  { auto rr = __builtin_amdgcn_permlane32_swap(__float_as_uint(pmax), __float_as_uint(pmax), false, false);
    pmax = fmaxf(__uint_as_float(rr[0]), __uint_as_float(rr[1])); }
  if (__builtin_expect(__all(pmax - m_reg <= THR / SCALE), 1)) { mn = m_reg; alpha = 1.f; }
  else { mn = fmaxf(m_reg, pmax); alpha = __builtin_amdgcn_exp2f((m_reg - mn) * C); m_reg = mn; }
  float mnC = -mn * C;
#pragma unroll
  for (int r = 0; r < 16; ++r) p0[r] = fmaf(p0[r], C, mnC);
#pragma unroll
  for (int r = 0; r < 16; ++r) p1[r] = fmaf(p1[r], C, mnC);
#pragma unroll
  for (int r = 0; r < 16; ++r) p0[r] = __builtin_amdgcn_exp2f(p0[r]);
}
__device__ __forceinline__ void finishSM(f32x16& p0, f32x16& p1, float alpha, float& l_reg, bf16x8& pa0, bf16x8& pa1, bf16x8& pa2, bf16x8& pa3) {
#pragma unroll
  for (int r = 0; r < 16; ++r) p1[r] = __builtin_amdgcn_exp2f(p1[r]);
  float ps = 0;
#pragma unroll
  for (int r = 0; r < 16; ++r) ps += p0[r];
#pragma unroll
  for (int r = 0; r < 16; ++r) ps += p1[r];
  { auto rr = __builtin_amdgcn_permlane32_swap(__float_as_uint(ps), __float_as_uint(ps), false, false);
    ps = __uint_as_float(rr[0]) + __uint_as_float(rr[1]); }
  l_reg = l_reg * alpha + ps;
#define PK4(P, BASE, OUT) do { unsigned a0 = cvtpk(P[BASE + 0], P[BASE + 1]), a1 = cvtpk(P[BASE + 2], P[BASE + 3]);   \
    unsigned b0 = cvtpk(P[BASE + 4], P[BASE + 5]), b1 = cvtpk(P[BASE + 6], P[BASE + 7]);                              \
    auto r0 = __builtin_amdgcn_permlane32_swap(a0, b0, false, false); auto r1 = __builtin_amdgcn_permlane32_swap(a1, b1, false, false); \
    u32x4 w = {r0[0], r1[0], r0[1], r1[1]}; OUT = *reinterpret_cast<bf16x8*>(&w); } while (0)
  PK4(p0, 0, pa0); PK4(p0, 8, pa1); PK4(p1, 0, pa2); PK4(p1, 8, pa3);
#undef PK4
}
template <int NQ>
__device__ __forceinline__ void qkt(f32x16& p0, f32x16& p1, const char* Ks, const bf16x8* qr, const char* ql, int r32, int hi) {
  p0 = f32x16{}; p1 = f32x16{};
  const int x = (r32 & 7) << 4, kb = r32 * 256;
  const char* a0 = Ks + kb + ((hi * 16) ^ x); const char* a1 = Ks + kb + ((32 + hi * 16) ^ x); const char* a2 = Ks + kb + ((64 + hi * 16) ^ x); const char* a3 = Ks + kb + ((96 + hi * 16) ^ x);
#define QK1(QV, AP, IMM) { const bf16x8 b0 = *reinterpret_cast<const bf16x8*>(AP + IMM); const bf16x8 b1 = *reinterpret_cast<const bf16x8*>(AP + IMM + 8192); const bf16x8 qv = QV; \
    p0 = __builtin_amdgcn_mfma_f32_32x32x16_bf16(b0, qv, p0, 0, 0, 0); p1 = __builtin_amdgcn_mfma_f32_32x32x16_bf16(b1, qv, p1, 0, 0, 0); }
#define QLD(I) (*reinterpret_cast<const bf16x8*>(ql + (I) * 8192))
  #define QSEL(I) ((I) < NQ ? qr[(I) < NQ ? (I) : 0] : QLD((I) - NQ))
  QK1(QSEL(0), a0, 0) QK1(QSEL(1), a1, 0) QK1(QSEL(2), a2, 0) QK1(QSEL(3), a3, 0) QK1(QSEL(4), a0, 128) QK1(QSEL(5), a1, 128) QK1(QSEL(6), a2, 128) QK1(QSEL(7), a3, 128)
#undef QSEL
#undef QK1
#undef QLD
}
__device__ __forceinline__ void wmask(f32x16& p0, f32x16& p1, int kp, int qp, int hi) {
#pragma unroll
  for (int r = 0; r < 16; ++r) { const int d = qp - (kp + crow(r, hi));
    if (d > 128 || d < -128) p0[r] = -INFINITY;
    if (d - 32 > 128 || d - 32 < -128) p1[r] = -INFINITY; }
}
__device__ __forceinline__ int v_st(int k, int c) { const int kk = (k & ~0xC) | ((k & 4) << 1) | ((k & 8) >> 1); return ((kk >> 3) * 4 + (c >> 5)) * 512 + ((kk & 7) * 32 + (c & 31)) * 2; }
__device__ __forceinline__ int v_rd_base(int lane) { return ((lane & 3) << 3) | (((lane >> 2) & 3) << 6) | (((lane >> 4) & 1) << 5) | (((lane >> 5) & 1) << 8); }
constexpr int v_rd_off(int d0, int ks, int half) { return d0 * 512 + ks * 4096 + half * 2048; }
template <int OFF> __device__ __forceinline__ s16x4 tr_read(int vb) {
  s16x4 r; asm volatile("ds_read_b64_tr_b16 %0, %1 offset:%2" : "=&v"(r) : "v"(vb), "i"(OFF) : "memory"); return r;
}
template <int D0> __device__ __forceinline__ void pv_one(f32x16& od, int vb, bf16x8 pa0, bf16x8 pa1, bf16x8 pa2, bf16x8 pa3) {
  const s16x4 l0 = tr_read<v_rd_off(D0, 0, 0)>(vb), h0 = tr_read<v_rd_off(D0, 0, 1)>(vb), l1 = tr_read<v_rd_off(D0, 1, 0)>(vb), h1 = tr_read<v_rd_off(D0, 1, 1)>(vb);
  const s16x4 l2 = tr_read<v_rd_off(D0, 2, 0)>(vb), h2 = tr_read<v_rd_off(D0, 2, 1)>(vb), l3 = tr_read<v_rd_off(D0, 3, 0)>(vb), h3 = tr_read<v_rd_off(D0, 3, 1)>(vb);
  asm volatile("s_waitcnt lgkmcnt(0)" ::: "memory"); SBAR();
#define PK(L, H) (bf16x8){L[0], L[1], L[2], L[3], H[0], H[1], H[2], H[3]}
  od = __builtin_amdgcn_mfma_f32_32x32x16_bf16(pa0, PK(l0, h0), od, 0, 0, 0);
  od = __builtin_amdgcn_mfma_f32_32x32x16_bf16(pa1, PK(l1, h1), od, 0, 0, 0);
  od = __builtin_amdgcn_mfma_f32_32x32x16_bf16(pa2, PK(l2, h2), od, 0, 0, 0);
  od = __builtin_amdgcn_mfma_f32_32x32x16_bf16(pa3, PK(l3, h3), od, 0, 0, 0);
#undef PK
}
__device__ __forceinline__ void pv_d0(f32x16* o, int vb, bf16x8 pa0, bf16x8 pa1, bf16x8 pa2, bf16x8 pa3) {
  pv_one<0>(o[0], vb, pa0, pa1, pa2, pa3); pv_one<1>(o[1], vb, pa0, pa1, pa2, pa3); pv_one<2>(o[2], vb, pa0, pa1, pa2, pa3); pv_one<3>(o[3], vb, pa0, pa1, pa2, pa3);
}

struct Item { int qrow0, qpos0, qcol, gcol, kcol, vcol, n0, r0, r1, NT, kp1, masked, normq, has_sink; float sinkv; };

template <bool MASKED>
__device__ __forceinline__ void attn_item(bf16_t* __restrict__ P, const Item it, const float* __restrict__ qnw, const f32x2* __restrict__ rope, char* lds, const int tid, const bool dry) {
  const int wid = tid >> 6, lane = tid & 63, r32 = lane & 31, hi = lane >> 5;
  constexpr int NBUF = 3;
  char* V_lds = lds; char* K_lds = lds + NBUF * SHM_V;
  float* ws = (float*)(lds + NBUF * (SHM_V + SHM_K)) + wid * 64; float* li_l = ws; float* al_l = ws + 32;
  float m_reg = -1e30f, l_reg = 0; constexpr int NQ = MASKED ? NQR : NQR_U;
  f32x16 o[4] = {}; bf16x8 qr[NQ > 0 ? NQ : 1]; char* ql = lds + NBUF * (SHM_V + SHM_K) + 2048 + tid * 16;
  const int qrow = it.qrow0 + wid * QBLK + r32;
  const int vb0 = (int)(uintptr_t)V_lds + v_rd_base(lane);
  const int widu = __builtin_amdgcn_readfirstlane(wid);
  unsigned koffs[2], voffs[2];
#pragma unroll
  for (int i = 0; i < 2; ++i) { const int ci = (wid * 2 + i) * 64 + lane;
    { const int row = ci >> 4, cc = (ci & 15) ^ (row & 7); koffs[i] = (unsigned)(row * LDP + cc * 8); }
    { const int sub = ci >> 5, kk = (sub >> 2) * 8 + ((ci & 31) >> 2), k = (kk & ~0xC) | ((kk & 4) << 1) | ((kk & 8) >> 1), cv = (sub & 3) * 32 + (ci & 3) * 8; voffs[i] = (unsigned)(k * LDP + cv); } }
#define ALAS __attribute__((address_space(3)))
#define TROW(t) ((size_t)((t) < it.n0 ? it.r0 + 64 * (t) : it.r1 + 64 * ((t) - it.n0)))
#define DMA(t, b) do { const bf16_t* gb_ = P + TROW(t) * LDP; _Pragma("unroll") for (int i_ = 0; i_ < 2; ++i_) {                                  \
    __builtin_amdgcn_global_load_lds((const unsigned*)(gb_ + it.kcol + koffs[i_]), (ALAS unsigned*)(K_lds + (b) * SHM_K + (widu * 2 + i_) * 1024), 16, 0, 0); \
    __builtin_amdgcn_global_load_lds((const unsigned*)(gb_ + it.vcol + voffs[i_]), (ALAS unsigned*)(V_lds + (b) * SHM_V + (widu * 2 + i_) * 1024), 16, 0, 0); } } while (0)
#define LANDED() do { asm volatile("s_waitcnt vmcnt(0)" ::: "memory"); __builtin_amdgcn_s_barrier(); asm volatile("" ::: "memory"); } while (0)
#define RESC(a) do { if (__any((a) < 1.f)) { if (hi == 0) al_l[r32] = (a); asm volatile("s_waitcnt lgkmcnt(0)" ::: "memory"); \
    _Pragma("unroll") for (int d = 0; d < 4; ++d) _Pragma("unroll") for (int r = 0; r < 16; ++r) o[d][r] *= al_l[crow(r, hi)]; } } while (0)
#define WMASK(pa, pb, t) do { if constexpr (MASKED) { if ((t) >= it.n0) wmask(pa, pb, it.kp1 + 64 * ((t) - it.n0), pos_q, hi); } } while (0)
  const int pos_q = it.qpos0 + wid * QBLK + r32;
  f32x16 pA0, pA1, pB0, pB1; float mnA, mnB, alA, alB; bf16x8 pa0, pa1, pa2, pa3; const int NT = it.NT;
  DMA(0, 0); DMA(1, 1);
  {
    const bf16_t* Qw = P + (size_t)qrow * LDP + it.qcol + hi * 8;
    bf16x8 raw[8];
#pragma unroll
    for (int d0 = 0; d0 < 8; ++d0) raw[d0] = *reinterpret_cast<const bf16x8*>(Qw + d0 * 16);
    float rs = 1.f;
    if (it.normq) { float ssq = 0.f;
#pragma unroll
      for (int d0 = 0; d0 < 8; ++d0)
#pragma unroll
        for (int j = 0; j < 8; ++j) { const float v = bf2f((unsigned short)raw[d0][j]); ssq += v * v; }
      ssq += __shfl_xor(ssq, 32);
      rs = rsqrtf(ssq * (1.f / 128.f) + EPS_); }
    const int pos = it.qpos0 + wid * QBLK + r32;
#pragma unroll
    for (int d0 = 0; d0 < 8; ++d0) {
      float v[8];
#pragma unroll
      for (int j = 0; j < 8; ++j) v[j] = bf2f((unsigned short)raw[d0][j]);
      if (it.normq) { const f32x4 w0 = *(const f32x4*)(qnw + d0 * 16 + hi * 8), w1 = *(const f32x4*)(qnw + d0 * 16 + hi * 8 + 4);
#pragma unroll
        for (int j = 0; j < 4; ++j) { v[j] *= rs * w0[j]; v[4 + j] *= rs * w1[j]; } }
      if (it.qpos0 >= 0) { const int tab = d0 < 4 ? (pos >> 6) : (pos & 63); const f32x4* tp = (const f32x4*)(rope + tab * 32 + (d0 & 3) * 8 + hi * 4);
        const f32x4 c01 = tp[0], c23 = tp[1];
        float x0, x1;
        x0 = v[0]; x1 = v[1]; v[0] = x0 * c01[0] - x1 * c01[1]; v[1] = x0 * c01[1] + x1 * c01[0];
        x0 = v[2]; x1 = v[3]; v[2] = x0 * c01[2] - x1 * c01[3]; v[3] = x0 * c01[3] + x1 * c01[2];
        x0 = v[4]; x1 = v[5]; v[4] = x0 * c23[0] - x1 * c23[1]; v[5] = x0 * c23[1] + x1 * c23[0];
        x0 = v[6]; x1 = v[7]; v[6] = x0 * c23[2] - x1 * c23[3]; v[7] = x0 * c23[3] + x1 * c23[2]; }
      u32x4 w = {cvtpk(v[0], v[1]), cvtpk(v[2], v[3]), cvtpk(v[4], v[5]), cvtpk(v[6], v[7])};
      if (d0 < NQ) qr[d0 < NQ ? d0 : 0] = *reinterpret_cast<bf16x8*>(&w); else *reinterpret_cast<u32x4*>(ql + (d0 - NQ) * 8192) = w;
    }
  }
  LANDED();
  qkt<NQ>(pA0, pA1, K_lds, qr, ql, r32, hi); WMASK(pA0, pA1, 0); partialSM(pA0, pA1, m_reg, mnA, alA);
  int b = 1, bp = 0, bn = 2;
  for (int t = 1; t + 1 < NT; t += 2) {
    DMA(t + 1, bn);
    SBAR(); qkt<NQ>(pB0, pB1, K_lds + b * SHM_K, qr, ql, r32, hi); WMASK(pB0, pB1, t);
    finishSM(pA0, pA1, alA, l_reg, pa0, pa1, pa2, pa3); SBAR();
    pv_d0(o, vb0 + bp * (int)SHM_V, pa0, pa1, pa2, pa3); partialSM(pB0, pB1, m_reg, mnB, alB);
    RESC(alB); LANDED();
    bp = b; b = bn; bn = bn == 2 ? 0 : bn + 1;
    DMA(t + 2, bn);
    SBAR(); qkt<NQ>(pA0, pA1, K_lds + b * SHM_K, qr, ql, r32, hi); WMASK(pA0, pA1, t + 1);
    finishSM(pB0, pB1, alB, l_reg, pa0, pa1, pa2, pa3); SBAR();
    pv_d0(o, vb0 + bp * (int)SHM_V, pa0, pa1, pa2, pa3); partialSM(pA0, pA1, m_reg, mnA, alA);
    RESC(alA); LANDED();
    bp = b; b = bn; bn = bn == 2 ? 0 : bn + 1;
  }
  SBAR(); qkt<NQ>(pB0, pB1, K_lds + b * SHM_K, qr, ql, r32, hi); WMASK(pB0, pB1, NT - 1);
  finishSM(pA0, pA1, alA, l_reg, pa0, pa1, pa2, pa3); SBAR();
  pv_d0(o, vb0 + bp * (int)SHM_V, pa0, pa1, pa2, pa3); partialSM(pB0, pB1, m_reg, mnB, alB);
  RESC(alB);
  finishSM(pB0, pB1, alB, l_reg, pa0, pa1, pa2, pa3); SBAR();
  pv_d0(o, vb0 + b * (int)SHM_V, pa0, pa1, pa2, pa3);
  if (it.has_sink) { constexpr float C = SCALE * 1.4426950408889634f; l_reg += __builtin_amdgcn_exp2f(it.sinkv * 1.4426950408889634f - m_reg * C); }
  if (hi == 0) li_l[r32] = l_reg; asm volatile("s_waitcnt lgkmcnt(0)" ::: "memory");
  float rli[16];
#pragma unroll
  for (int r = 0; r < 16; ++r) rli[r] = __builtin_amdgcn_rcpf(li_l[crow(r, hi)]);
  bf16_t* Ow = P + (size_t)(it.qrow0 + wid * QBLK) * LDP;
  __syncthreads();
  {
    char* T = lds + wid * 12288;
#pragma unroll
    for (int r = 0; r < 16; ++r) { const int orow = crow(r, hi);
#pragma unroll
      for (int d0 = 0; d0 < 4; ++d0) *(unsigned short*)(T + orow * 272 + (d0 * 32 + r32) * 2) = f2bf(o[d0][r] * rli[r]); }
    asm volatile("s_waitcnt lgkmcnt(0)" ::: "memory");
    u32x4 gv[8];
#pragma unroll
    for (int k = 0; k < 8; ++k) { const int ci = k * 64 + lane; gv[k] = *(const u32x4*)(Ow + (size_t)(ci >> 4) * LDP + it.gcol + (ci & 15) * 8); }
#pragma unroll
    for (int k = 0; k < 8; ++k) { const int ci = k * 64 + lane; const u32x4 tv = *(const u32x4*)(T + (ci >> 4) * 272 + (ci & 15) * 16); const u32x4 g = gv[k];
      u32x4 w;
      w.x = cvtpk(bflo(tv.x) * silu_f(bflo(g.x)), bfhi(tv.x) * silu_f(bfhi(g.x))); w.y = cvtpk(bflo(tv.y) * silu_f(bflo(g.y)), bfhi(tv.y) * silu_f(bfhi(g.y)));
      w.z = cvtpk(bflo(tv.z) * silu_f(bflo(g.z)), bfhi(tv.z) * silu_f(bfhi(g.z))); w.w = cvtpk(bflo(tv.w) * silu_f(bflo(g.w)), bfhi(tv.w) * silu_f(bfhi(g.w)));
      if (!dry) *(u32x4*)(Ow + (size_t)(ci >> 4) * LDP + it.qcol + (ci & 15) * 8) = w; }
  }
  __syncthreads();
#undef TROW
#undef DMA
#undef LANDED
#undef RESC
#undef WMASK
}
}

struct Ctx {
    int tid, lane, wave, gw, ngw;
    char* lds;
};
#define LDS_WAIT() asm volatile("s_waitcnt lgkmcnt(0)" ::: "memory")

__device__ __forceinline__ void transpose_item(const float* __restrict__ W, int K, int Ntot, int src0, bf16_t* __restrict__ WT, int dst0, int ncols, float* scr, int item, int lane) {
    const int nblk = ncols / 32, kb = item / nblk, nb = item % nblk, k0 = 64 * kb, n0 = 32 * nb;
#pragma unroll 8
    for (int i = 0; i < 32; ++i) { const int kk = 2 * i + (lane >> 5); scr[kk * 33 + (lane & 31)] = __builtin_nontemporal_load(W + (size_t)(k0 + kk) * Ntot + src0 + n0 + (lane & 31)); }
    LDS_WAIT(); asm volatile("" ::: "memory");
    const int c = lane & 7;
#pragma unroll
    for (int j = 0; j < 4; ++j) { const int n = (lane >> 3) + 8 * j; const float* s = scr + (8 * c) * 33 + n;
        u32x4 o; o.x = cvtpk(s[0 * 33], s[1 * 33]); o.y = cvtpk(s[2 * 33], s[3 * 33]); o.z = cvtpk(s[4 * 33], s[5 * 33]); o.w = cvtpk(s[6 * 33], s[7 * 33]);
        *(u32x4*)(WT + (size_t)(dst0 + n0 + n) * K + k0 + 8 * c) = o; }
    LDS_WAIT(); asm volatile("" ::: "memory");
}
__device__ __forceinline__ void convert_weights(const Ctx& c, int l, const float* attn_w_in, const float* attn_w_out, const float* ssm_w_in, const float* ssm_w_out, bf16_t* W1, bf16_t* W2) {
    float* scr = (float*)(c.lds + c.wave * 16384);
    const int i = l >> 1;
    if ((l & 1) == 0) {
        const float* Wi = attn_w_in + (size_t)i * DM * AIN; const float* Wo = attn_w_out + (size_t)i * AW * DM;
        constexpr int I_IN = (DM / 64) * (AIN / 32), I_OUT = (AW / 64) * (DM / 32);
        for (int it = c.gw; it < I_IN + I_OUT; it += c.ngw) {
            if (it < I_IN) {
                const int kb = it / (AIN / 32), nbg = it % (AIN / 32), scol = nbg * 32;
                int src0, ncols, dst0;
                if (scol < 1024) { src0 = 0; ncols = 1024; dst0 = PC_QA; }
                else if (scol < 1280) { src0 = 1024; ncols = 256; dst0 = PC_KA; }
                else if (scol < 1536) { src0 = 1280; ncols = 256; dst0 = PC_VA; }
                else if (scol < 2560) { src0 = 1536; ncols = 1024; dst0 = PC_GA; }
                else if (scol < 3584) { src0 = 2560; ncols = 1024; dst0 = PC_QB; }
                else if (scol < 3840) { src0 = 3584; ncols = 256; dst0 = PC_KB; }
                else if (scol < 4096) { src0 = 3840; ncols = 256; dst0 = PC_VB; }
                else { src0 = 4096; ncols = 1024; dst0 = PC_GB; }
                const int nb = (scol - src0) / 32;
                transpose_item(Wi, DM, AIN, src0, W1, dst0, ncols, scr, kb * (ncols / 32) + nb, c.lane);
            } else transpose_item(Wo, AW, DM, 0, W2, 0, DM, scr, it - I_IN, c.lane);
        }
    } else {
        constexpr int SIN = 6208;
        const float* Wi = ssm_w_in + (size_t)i * DM * SIN; const float* Wo = ssm_w_out + (size_t)i * DI * DM;
        constexpr int I_IN = (DM / 64) * (SIN / 32), I_OUT = (DI / 64) * (DM / 32);
        for (int it = c.gw; it < I_IN + I_OUT; it += c.ngw) {
            if (it < I_IN) {
                const int kb = it / (SIN / 32), nbg = it % (SIN / 32), scol = nbg * 32;
                int src0, ncols, dst0;
                if (scol < 2048) { src0 = 0; ncols = 2048; dst0 = NXB; }
                else if (scol < 6144) { src0 = 2048; ncols = 4096; dst0 = 0; }
                else { src0 = 6144; ncols = 64; dst0 = 4096; }
                const int nb = (scol - src0) / 32;
                transpose_item(Wi, DM, SIN, src0, W1, dst0, ncols, scr, kb * (ncols / 32) + nb, c.lane);
            } else transpose_item(Wo, DI, DM, 0, W2, 0, DM, scr, it - I_IN, c.lane);
        }
    }
}

__device__ __forceinline__ void adaln_phase(const Ctx& c, const float* cvec, const float* cctx, const float* w_ada, const float* b_ada, float* MOD) {
    float* sv = (float*)c.lds;
    float* red = (float*)(c.lds + 5 * 1024 * 4);
    bool have = false;
    for (int it = blockIdx.x; it < DEPTH_ * 48; it += gridDim.x) {
        if (!have) { for (int e = c.tid; e < 5 * 1024; e += 512) { const float v = e < 4096 ? cvec[e] : cctx[e - 4096]; sv[e] = silu_f(v); } have = true; __syncthreads(); }
        const int l = it / 48, col = (it % 48) * 64 + c.lane;
        const float* wp = w_ada + ((size_t)l * DM + c.wave * 128) * 3072 + col;
        float a0 = 0, a1 = 0, a2 = 0, a3 = 0, a4 = 0;
#pragma unroll 8
        for (int k = 0; k < 128; ++k) { const float w = __builtin_nontemporal_load(wp + (size_t)k * 3072); const int kk = c.wave * 128 + k;
            a0 += sv[kk] * w; a1 += sv[1024 + kk] * w; a2 += sv[2048 + kk] * w; a3 += sv[3072 + kk] * w; a4 += sv[4096 + kk] * w; }
        float* rp = red + (c.wave * 5) * 64 + c.lane;
        rp[0] = a0; rp[64] = a1; rp[128] = a2; rp[192] = a3; rp[256] = a4;
        __syncthreads();
        if (c.tid < 320) { const int who = c.tid >> 6, ln = c.tid & 63; float s = b_ada[(size_t)l * 3072 + (it % 48) * 64 + ln];
#pragma unroll
            for (int w = 0; w < 8; ++w) s += red[(w * 5 + who) * 64 + ln];
            MOD[((size_t)l * 5 + who) * 3072 + (it % 48) * 64 + ln] = s; }
        __syncthreads();
    }
}
__device__ __forceinline__ void rope_phase(const Ctx& c, f32x2* rope) {
    for (int e = blockIdx.x * 512 + c.tid; e < 128 * 32; e += gridDim.x * 512) { const int pos = e >> 5, f = e & 31;
        const float inv = 1.0f / powf(10000.0f, (float)f / 32.0f); const float ang = (float)pos * inv;
        rope[e] = (f32x2){cosf(ang), sinf(ang)}; }
}

__device__ __forceinline__ void norm_pass(const Ctx& c, int l, const float* xin, float* xout, const float* cin, float* cout, bf16_t* HY, const float* MOD, const float* norm_pre, const float* norm_post, bool do_ctx, const bool dry) {
    const bool have_y = l >= 0, have_h = l + 1 < DEPTH_;
    const int nchunks = MLAT / 16 + (do_ctx ? MCTX : 0);
    for (int ch = c.gw; ch < nchunks; ch += c.ngw) {
        const bool isctx = ch >= MLAT / 16; const int row0 = isctx ? (ch - MLAT / 16) : ch * 16; const int who = isctx ? 4 : (row0 / T_); const int nrow = isctx ? 1 : 16;
        const float* xi = isctx ? cin : xin; float* xo = isctx ? cout : xout; const int hrow0 = isctx ? MLAT + row0 : row0;
        f32x4 A1[4], A2[4], A3[4];
#pragma unroll
        for (int j = 0; j < 4; ++j) { const int col = 4 * c.lane + 256 * j;
            if (have_y) { const f32x4 gt = *(const f32x4*)(MOD + ((size_t)l * 5 + who) * 3072 + 2048 + col); const f32x4 pw = *(const f32x4*)(norm_post + (size_t)l * DM + col); A1[j] = gt * pw; }
            if (have_h) { const f32x4 sh = *(const f32x4*)(MOD + ((size_t)(l + 1) * 5 + who) * 3072 + col), sc = *(const f32x4*)(MOD + ((size_t)(l + 1) * 5 + who) * 3072 + 1024 + col);
                const f32x4 pw = *(const f32x4*)(norm_pre + (size_t)(l + 1) * DM + col); A2[j] = pw * (sc + 1.0f); A3[j] = sh; } }
        f32x4 nx[4]; u32x2 ny[4];
#pragma unroll
        for (int j = 0; j < 4; ++j) { nx[j] = __builtin_nontemporal_load((const f32x4*)(xi + (size_t)row0 * DM + 4 * c.lane + 256 * j)); if (have_y) ny[j] = __builtin_nontemporal_load((const u32x2*)(HY + (size_t)hrow0 * DM + 4 * c.lane + 256 * j)); }
        for (int r = 0; r < nrow; ++r) {
            const size_t xoff = (size_t)(row0 + r) * DM, hoff = (size_t)(hrow0 + r) * DM;
            f32x4 x[4]; u32x2 yw[4];
#pragma unroll
            for (int j = 0; j < 4; ++j) { x[j] = nx[j]; yw[j] = ny[j]; }
            if (r + 1 < nrow) {
#pragma unroll
                for (int j = 0; j < 4; ++j) { nx[j] = __builtin_nontemporal_load((const f32x4*)(xi + xoff + DM + 4 * c.lane + 256 * j)); if (have_y) ny[j] = __builtin_nontemporal_load((const u32x2*)(HY + hoff + DM + 4 * c.lane + 256 * j)); } }
            if (have_y) {
                f32x4 y[4]; float ssq = 0.f;
#pragma unroll
                for (int j = 0; j < 4; ++j) { const u32x2 w = yw[j]; y[j] = (f32x4){bflo(w.x), bfhi(w.x), bflo(w.y), bfhi(w.y)};
                    ssq += (y[j][0] * y[j][0] + y[j][1] * y[j][1]) + (y[j][2] * y[j][2] + y[j][3] * y[j][3]); }
                const float rs = rsqrtf(wave_sum(ssq) * (1.f / DM) + EPS_);
#pragma unroll
                for (int j = 0; j < 4; ++j) { x[j] = x[j] + A1[j] * (y[j] * rs); if (!dry) __builtin_nontemporal_store(x[j], (f32x4*)(xo + xoff + 4 * c.lane + 256 * j)); }
            }
            if (have_h) {
                float ssq = 0.f;
#pragma unroll
                for (int j = 0; j < 4; ++j) ssq += (x[j][0] * x[j][0] + x[j][1] * x[j][1]) + (x[j][2] * x[j][2] + x[j][3] * x[j][3]);
                const float rs = rsqrtf(wave_sum(ssq) * (1.f / DM) + EPS_);
#pragma unroll
                for (int j = 0; j < 4; ++j) { const f32x4 h = x[j] * rs * A2[j] + A3[j]; u32x2 w; w.x = cvtpk(h[0], h[1]); w.y = cvtpk(h[2], h[3]); if (!dry) *(u32x2*)(HY + hoff + 4 * c.lane + 256 * j) = w; }
            }
        }
    }
}

__device__ __forceinline__ void kprep_pass(const Ctx& c, bf16_t* P, const float* knw, const f32x2* rope, const bool dry) {
    const int hsel = c.lane >> 4, e0 = (c.lane & 15) * 8;
    const int col = (hsel < 2 ? PC_KA + hsel * 128 : PC_KB + (hsel - 2) * 128) + e0;
    const f32x4 w0 = *(const f32x4*)(knw + e0), w1 = *(const f32x4*)(knw + e0 + 4);
    for (int row0 = c.gw; row0 < MTOT; row0 += 2 * c.ngw) {
        const int row1 = row0 + c.ngw; const bool two = row1 < MTOT;
        const u32x4 rawA = *(const u32x4*)(P + (size_t)row0 * AIN + col);
        const u32x4 rawB = two ? *(const u32x4*)(P + (size_t)row1 * AIN + col) : (u32x4){0u, 0u, 0u, 0u};
#pragma unroll
        for (int half = 0; half < 2; ++half) {
        if (half == 1 && !two) break;
        const int row = half ? row1 : row0; const u32x4 raw = half ? rawB : rawA;
        bf16_t* p = P + (size_t)row * AIN + col;
        float v[8] = {bflo(raw.x), bfhi(raw.x), bflo(raw.y), bfhi(raw.y), bflo(raw.z), bfhi(raw.z), bflo(raw.w), bfhi(raw.w)};
        if (hsel >= 2) { float ssq = 0.f;
#pragma unroll
            for (int j = 0; j < 8; ++j) ssq += v[j] * v[j];
            ssq += __shfl_xor(ssq, 1); ssq += __shfl_xor(ssq, 2); ssq += __shfl_xor(ssq, 4); ssq += __shfl_xor(ssq, 8);
            const float rs = rsqrtf(ssq * (1.f / 128.f) + EPS_);
#pragma unroll
            for (int j = 0; j < 4; ++j) { v[j] *= rs * w0[j]; v[4 + j] *= rs * w1[j]; } }
        if (row < MLAT) { const int pos = row & (T_ - 1), i0 = e0 >> 1; const int tab = i0 < 32 ? (pos >> 6) : (pos & 63);
            const f32x4* tp = (const f32x4*)(rope + tab * 32 + (i0 & 31)); const f32x4 c01 = tp[0], c23 = tp[1];
            float x0, x1;
            x0 = v[0]; x1 = v[1]; v[0] = x0 * c01[0] - x1 * c01[1]; v[1] = x0 * c01[1] + x1 * c01[0];
            x0 = v[2]; x1 = v[3]; v[2] = x0 * c01[2] - x1 * c01[3]; v[3] = x0 * c01[3] + x1 * c01[2];
            x0 = v[4]; x1 = v[5]; v[4] = x0 * c23[0] - x1 * c23[1]; v[5] = x0 * c23[1] + x1 * c23[0];
            x0 = v[6]; x1 = v[7]; v[6] = x0 * c23[2] - x1 * c23[3]; v[7] = x0 * c23[3] + x1 * c23[2]; }
        if (!dry && (hsel >= 2 || row < MLAT)) { u32x4 w = {cvtpk(v[0], v[1]), cvtpk(v[2], v[3]), cvtpk(v[4], v[5]), cvtpk(v[6], v[7])}; *(u32x4*)p = w; }
        }
    }
}

__device__ __forceinline__ void conv_pass(const Ctx& c, bf16_t* X, const bf16_t* halo, const float* cw, const float* cb, const bool dry) {
    for (int u = blockIdx.x; u < (MTOT / 128) * 4; u += gridDim.x) {
        const int ck = u >> 2, q = u & 3, strip = c.tid & 127, rg = c.tid >> 7, col = q * 1024 + strip * 8, row0 = ck * 128 + rg * 32;
        const bool seq_start = ck < 256 ? (ck & 63) == 0 : ((ck - 256) & 1) == 0, seq_end = ck < 256 ? (ck & 63) == 63 : ((ck - 256) & 1) == 1;
        float w0[8], w1[8], w2[8], bs[8];
#pragma unroll
        for (int j = 0; j < 8; ++j) { w0[j] = cw[col + j]; w1[j] = cw[CONVD + col + j]; w2[j] = cw[2 * CONVD + col + j]; bs[j] = cb[col + j]; }
        u32x4 prev = {0u, 0u, 0u, 0u}, last = {0u, 0u, 0u, 0u};
        if (rg == 0) { if (!seq_start) prev = *(const u32x4*)(halo + ((size_t)(ck - 1) * 2 + 1) * CONVD + col); } else prev = *(const u32x4*)(X + (size_t)(row0 - 1) * CONVD + col);
        if (rg == 3) { if (!seq_end) last = *(const u32x4*)(halo + ((size_t)(ck + 1) * 2 + 0) * CONVD + col); } else last = *(const u32x4*)(X + (size_t)(row0 + 32) * CONVD + col);
        u32x4 cur = *(const u32x4*)(X + (size_t)row0 * CONVD + col);
        asm volatile("s_waitcnt vmcnt(0)" ::: "memory");
        __syncthreads();
        for (int ib = 0; ib < 4; ++ib) {
            u32x4 nx[8];
#pragma unroll
            for (int i = 0; i < 8; ++i) { const int r = ib * 8 + i + 1; nx[i] = (r < 32) ? *(const u32x4*)(X + (size_t)(row0 + r) * CONVD + col) : last; }
#pragma unroll
            for (int i = 0; i < 8; ++i) {
                const u32x4 n = nx[i];
                const float pv[8] = {bflo(prev.x), bfhi(prev.x), bflo(prev.y), bfhi(prev.y), bflo(prev.z), bfhi(prev.z), bflo(prev.w), bfhi(prev.w)};
                const float cv[8] = {bflo(cur.x), bfhi(cur.x), bflo(cur.y), bfhi(cur.y), bflo(cur.z), bfhi(cur.z), bflo(cur.w), bfhi(cur.w)};
                const float nv[8] = {bflo(n.x), bfhi(n.x), bflo(n.y), bfhi(n.y), bflo(n.z), bfhi(n.z), bflo(n.w), bfhi(n.w)};
                float o[8];
#pragma unroll
                for (int j = 0; j < 8; ++j) o[j] = silu_f(bs[j] + w0[j] * pv[j] + w1[j] * cv[j] + w2[j] * nv[j]);
                u32x4 w = {cvtpk(o[0], o[1]), cvtpk(o[2], o[3]), cvtpk(o[4], o[5]), cvtpk(o[6], o[7])};
                if (!dry) *(u32x4*)(X + (size_t)(row0 + ib * 8 + i) * CONVD + col) = w;
                prev = cur; cur = n;
            }
        }
        asm volatile("s_waitcnt vmcnt(0)" ::: "memory");
        __syncthreads();
    }
}

__device__ __forceinline__ void gnorm_pass(const Ctx& c, bf16_t* Y, const bf16_t* Z, const float* nw, const int nrows, const bool dry) {
    f32x4 w[8];
#pragma unroll
    for (int j = 0; j < 8; ++j) w[j] = *(const f32x4*)(nw + 256 * j + 4 * c.lane);
    for (int row = c.gw; row < nrows; row += c.ngw) {
        const size_t off = (size_t)row * DI + 4 * c.lane;
        u32x2 yv[8], zv[8];
#pragma unroll
        for (int j = 0; j < 8; ++j) { yv[j] = *(const u32x2*)(Y + off + 256 * j); zv[j] = *(const u32x2*)(Z + off + 256 * j); }
#pragma unroll
        for (int j = 0; j < 8; ++j) {
            f32x4 g = {bflo(yv[j].x) * silu_f(bflo(zv[j].x)), bfhi(yv[j].x) * silu_f(bfhi(zv[j].x)), bflo(yv[j].y) * silu_f(bflo(zv[j].y)), bfhi(yv[j].y) * silu_f(bfhi(zv[j].y))};
            const float ssq = wave_sum((g[0] * g[0] + g[1] * g[1]) + (g[2] * g[2] + g[3] * g[3]));
            const float rs = rsqrtf(ssq * (1.f / 256.f) + EPS_);
            g = g * rs * w[j];
            u32x2 o; o.x = cvtpk(g[0], g[1]); o.y = cvtpk(g[2], g[3]); if (!dry) *(u32x2*)(Y + off + 256 * j) = o;
        }
    }
}

namespace ssd {
constexpr int RS = 272;
constexpr int O_CN = 0, O_BN = 34816, O_GP = 69632, O_XDT = 104448, O_XW = 112640, O_XN = 120832, O_HS = 129024, O_CUM = 137728, LDS_SSD = O_CUM + 1024;
#define MF32(a, b, c) __builtin_amdgcn_mfma_f32_32x32x16_bf16(a, b, c, 0, 0, 0)
#define PK8(L, H) (bf16x8){L[0], L[1], L[2], L[3], H[0], H[1], H[2], H[3]}
__device__ __forceinline__ u32x2 pack4(float a, float b, float c, float d) { u32x2 w; w.x = cvtpk(a, b); w.y = cvtpk(c, d); return w; }


#define RDL(x, n) __uint_as_float((unsigned)__builtin_amdgcn_readlane((int)__float_as_uint(x), (n)))
__device__ __forceinline__ float wave_scan_incl(float v, int lane) {
#define DPP_SHR(x, n) __uint_as_float((unsigned)__builtin_amdgcn_update_dpp(0, (int)__float_as_uint(x), 0x110 + (n), 0xf, 0xf, true))
    v += DPP_SHR(v, 1); v += DPP_SHR(v, 2); v += DPP_SHR(v, 4); v += DPP_SHR(v, 8);
#undef DPP_SHR
    const float t0 = RDL(v, 15), t1 = RDL(v, 31), t2 = RDL(v, 47);
    const int row = lane >> 4;
    v += row == 1 ? t0 : row == 2 ? t0 + t1 : row == 3 ? (t0 + t1) + t2 : 0.f;
    return v;
}
template <int KK0> __device__ __forceinline__ void state_steps(f32x16& S, int base_b, int base_w) {
    using att::tr_read;
    const s16x4 a0l = tr_read<(KK0 + 0) * 16 * RS>(base_b), a0h = tr_read<(KK0 + 0) * 16 * RS + 4 * RS>(base_b), a1l = tr_read<(KK0 + 1) * 16 * RS>(base_b), a1h = tr_read<(KK0 + 1) * 16 * RS + 4 * RS>(base_b);
    const s16x4 a2l = tr_read<(KK0 + 2) * 16 * RS>(base_b), a2h = tr_read<(KK0 + 2) * 16 * RS + 4 * RS>(base_b), a3l = tr_read<(KK0 + 3) * 16 * RS>(base_b), a3h = tr_read<(KK0 + 3) * 16 * RS + 4 * RS>(base_b);
    const s16x4 b0l = tr_read<(KK0 + 0) * 1024>(base_w), b0h = tr_read<(KK0 + 0) * 1024 + 256>(base_w), b1l = tr_read<(KK0 + 1) * 1024>(base_w), b1h = tr_read<(KK0 + 1) * 1024 + 256>(base_w);
    const s16x4 b2l = tr_read<(KK0 + 2) * 1024>(base_w), b2h = tr_read<(KK0 + 2) * 1024 + 256>(base_w), b3l = tr_read<(KK0 + 3) * 1024>(base_w), b3h = tr_read<(KK0 + 3) * 1024 + 256>(base_w);
    asm volatile("s_waitcnt lgkmcnt(0)" ::: "memory"); SBAR();
    S = MF32(PK8(a0l, a0h), PK8(b0l, b0h), S); S = MF32(PK8(a1l, a1h), PK8(b1l, b1h), S);
    S = MF32(PK8(a2l, a2h), PK8(b2l, b2h), S); S = MF32(PK8(a3l, a3h), PK8(b3l, b3h), S);
}
template <int KK0> __device__ __forceinline__ void ydiag_steps(f32x16& acc, int base_x, const char* gp_row) {
    using att::tr_read;
    const s16x4 a0l = tr_read<(KK0 + 0) * 1024>(base_x), a0h = tr_read<(KK0 + 0) * 1024 + 256>(base_x), a1l = tr_read<(KK0 + 1) * 1024>(base_x), a1h = tr_read<(KK0 + 1) * 1024 + 256>(base_x);
    const s16x4 a2l = tr_read<(KK0 + 2) * 1024>(base_x), a2h = tr_read<(KK0 + 2) * 1024 + 256>(base_x), a3l = tr_read<(KK0 + 3) * 1024>(base_x), a3h = tr_read<(KK0 + 3) * 1024 + 256>(base_x);
    asm volatile("s_waitcnt lgkmcnt(0)" ::: "memory"); SBAR();
    const bf16x8 b0 = *(const bf16x8*)(gp_row + (KK0 + 0) * 32), b1 = *(const bf16x8*)(gp_row + (KK0 + 1) * 32), b2 = *(const bf16x8*)(gp_row + (KK0 + 2) * 32), b3 = *(const bf16x8*)(gp_row + (KK0 + 3) * 32);
    acc = MF32(PK8(a0l, a0h), b0, acc); acc = MF32(PK8(a1l, a1h), b1, acc); acc = MF32(PK8(a2l, a2h), b2, acc); acc = MF32(PK8(a3l, a3h), b3, acc);
}

__device__ __forceinline__ void scan_phase(const Ctx& c, const int dir, const bf16_t* __restrict__ X, const float* __restrict__ DT, bf16_t* __restrict__ Y, const float* __restrict__ a_log, const float* __restrict__ dskip, const bool dry, const int pvar) {
    char* L = c.lds; float* cumL = (float*)(L + O_CUM);
    const int tid = c.tid, lane = c.lane, wave = c.wave, r32 = lane & 31, hi = lane >> 5;
    const int blk = (lane >> 4) & 1, qq = (lane & 15) >> 2, pp = lane & 3;
    for (int item = blockIdx.x; item < 256; item += gridDim.x) {
        const int xcd_ = item & 7, slot_ = item >> 3, grp_ = xcd_ + 8 * (slot_ >> 3), mem_ = slot_ & 7;
        const int ph = mem_ & 1, b = grp_ >> 3, g = grp_ & 7, h = 4 * g + (mem_ >> 1);
        const float Acoef = -__expf(a_log[dir * 32 + h]), Dh = dskip[h];
        const int xcol = h * 64 + ph * 32, bcol = 2048 + g * 128, ccol = 3072 + g * 128, dtcol = dir * 32 + h;
        f32x16 S = {};
        bf16x8 rc[4], rb[4], rx; float d0r, d1r;
#define CHUNK_ROW(q) ((q) < 2 ? MLAT + b * CL + (dir == 0 ? (q) : 1 - (q)) * 128 : b * T_ + (dir == 0 ? (q) - 2 : 65 - (q)) * 128)
#define LOADCHUNK(q) do { const int R_ = CHUNK_ROW(q);                                                                         \
        _Pragma("unroll") for (int i = 0; i < 4; ++i) { const size_t ro = (size_t)(R_ + (tid >> 4) + 32 * i) * CONVD + (tid & 15) * 8;     \
            rc[i] = *(const bf16x8*)(X + ro + ccol); rb[i] = *(const bf16x8*)(X + ro + bcol); }                                \
        rx = *(const bf16x8*)(X + (size_t)(R_ + (tid >> 2)) * CONVD + xcol + (tid & 3) * 8);                                    \
        d0r = DT[(size_t)dtcol * MTOT + R_ + lane]; d1r = DT[(size_t)dtcol * MTOT + R_ + 64 + lane]; } while (0)
        LOADCHUNK(0);
        for (int q = 0; q < 66; ++q) {
            const int R0 = CHUNK_ROW(q);
            const float a0 = d0r * Acoef, a1 = d1r * Acoef;
            float p0 = wave_scan_incl(a0, lane), p1 = wave_scan_incl(a1, lane);
            p1 += RDL(p0, 63);
            const float tot = RDL(p1, 63);
            float c0, c1;
            if (dir == 0) { c0 = p0; c1 = p1; } else { c0 = tot - p0 + a0; c1 = tot - p1 + a1; }
            if (wave == 0) { cumL[lane] = c0; cumL[64 + lane] = c1; }
#pragma unroll
            for (int i = 0; i < 4; ++i) { const int off = ((tid >> 4) + 32 * i) * RS + (tid & 15) * 16;
                *(bf16x8*)(L + O_CN + off) = rc[i]; *(bf16x8*)(L + O_BN + off) = rb[i]; }
            {
                const int sl = (tid >> 2) & 63;
                const float dts = __shfl(wave < 4 ? d0r : d1r, sl), cums = __shfl(wave < 4 ? c0 : c1, sl);
                const float wend = dts * __expf(tot - cums);
                float xv[8];
#pragma unroll
                for (int j = 0; j < 8; ++j) xv[j] = bf2f((unsigned short)rx[j]);
                const int xo = (tid >> 2) * 64 + (tid & 3) * 16;
                *(bf16x8*)(L + O_XN + xo) = rx;
                u32x4 w1 = {cvtpk(xv[0] * dts, xv[1] * dts), cvtpk(xv[2] * dts, xv[3] * dts), cvtpk(xv[4] * dts, xv[5] * dts), cvtpk(xv[6] * dts, xv[7] * dts)};
                u32x4 w2 = {cvtpk(xv[0] * wend, xv[1] * wend), cvtpk(xv[2] * wend, xv[3] * wend), cvtpk(xv[4] * wend, xv[5] * wend), cvtpk(xv[6] * wend, xv[7] * wend)};
                *(u32x4*)(L + O_XDT + xo) = w1; *(u32x4*)(L + O_XW + xo) = w2;
            }
            if (q + 1 < 66) LOADCHUNK(q + 1);
            __syncthreads();
            if (!(dry && pvar == 1)) {
            if (wave >= 4) { const int nb = (wave - 4) * 32;
#pragma unroll
                for (int qd = 0; qd < 4; ++qd) *(u32x2*)(L + O_HS + r32 * RS + (nb + 8 * qd + 4 * hi) * 2) = pack4(S[4 * qd], S[4 * qd + 1], S[4 * qd + 2], S[4 * qd + 3]); }
            {
                const int sb = wave >> 1, lb0 = 2 * (wave & 1);
                const char* ap = L + O_BN + (sb * 32 + r32) * RS + hi * 16; const char* bp0 = L + O_CN + (lb0 * 32 + r32) * RS + hi * 16; const char* bp1 = bp0 + 32 * RS;
                bf16x8 fa[8], fb0[8], fb1[8];
#pragma unroll
                for (int kk = 0; kk < 8; ++kk) { fa[kk] = *(const bf16x8*)(ap + kk * 32); fb0[kk] = *(const bf16x8*)(bp0 + kk * 32); fb1[kk] = *(const bf16x8*)(bp1 + kk * 32); }
                f32x16 acc0 = {}, acc1 = {};
#pragma unroll
                for (int kk = 0; kk < 8; ++kk) { acc0 = MF32(fa[kk], fb0[kk], acc0); acc1 = MF32(fa[kk], fb1[kk], acc1); }
#pragma unroll
                for (int tt = 0; tt < 2; ++tt) {
                    const int lb = lb0 + tt, l = lb * 32 + r32; const float cl = cumL[l];
#pragma unroll
                    for (int qd = 0; qd < 4; ++qd) { float v[4];
#pragma unroll
                        for (int e = 0; e < 4; ++e) { const int s_ = sb * 32 + 8 * qd + 4 * hi + e; const float cs = cumL[s_];
                            const float av = tt == 0 ? acc0[4 * qd + e] : acc1[4 * qd + e];
                            const bool valid = dir == 0 ? (s_ <= l) : (s_ >= l); v[e] = valid ? av * __expf(cl - cs) : 0.f; }
                        *(u32x2*)(L + O_GP + l * RS + (sb * 32 + 8 * qd + 4 * hi) * 2) = pack4(v[0], v[1], v[2], v[3]); }
                }
            }
            }
            __syncthreads();
            if (dry && pvar >= 1) { } else
            if (wave < 4) {
                const int l = wave * 32 + r32;
                f32x16 aoff = {}, adg = {};
                bf16_t* yp = Y + (size_t)(R0 + l) * DI + xcol;
                u32x2 pvv[4] = {};
                if (dir == 0) {
#pragma unroll
                    for (int qd = 0; qd < 4; ++qd) pvv[qd] = *(const u32x2*)(yp + 8 * qd + 4 * hi); }
                const char* hp = L + O_HS + r32 * RS + hi * 16; const char* cp = L + O_CN + l * RS + hi * 16;
                {
                    bf16x8 fh[8], fc[8];
#pragma unroll
                    for (int kk = 0; kk < 8; ++kk) { fh[kk] = *(const bf16x8*)(hp + kk * 32); fc[kk] = *(const bf16x8*)(cp + kk * 32); }
#pragma unroll
                    for (int kk = 0; kk < 8; ++kk) aoff = MF32(fh[kk], fc[kk], aoff);
                }
                const int base_x = (int)(uintptr_t)(L + O_XDT) + (8 * hi + qq) * 64 + (16 * blk + 4 * pp) * 2;
                const char* gp_row = L + O_GP + l * RS + hi * 16;
                ydiag_steps<0>(adg, base_x, gp_row); ydiag_steps<4>(adg, base_x, gp_row);
                const float ec = __expf(cumL[l]);
#pragma unroll
                for (int qd = 0; qd < 4; ++qd) { const int pc = 8 * qd + 4 * hi; float v[4];
#pragma unroll
                    for (int e = 0; e < 4; ++e) v[e] = aoff[4 * qd + e] * ec + adg[4 * qd + e];
                    if (dir == 0) { const u32x2 xn = *(const u32x2*)(L + O_XN + l * 64 + pc * 2); const u32x2 pv = pvv[qd];
                        v[0] += Dh * bflo(xn.x) + bflo(pv.x); v[1] += Dh * bfhi(xn.x) + bfhi(pv.x); v[2] += Dh * bflo(xn.y) + bflo(pv.y); v[3] += Dh * bfhi(xn.y) + bfhi(pv.y); }
                    if (!dry) *(u32x2*)(yp + pc) = pack4(v[0], v[1], v[2], v[3]); }
            } else {
                const int nb = (wave - 4) * 32; const float dec = __expf(tot);
#pragma unroll
                for (int r = 0; r < 16; ++r) S[r] *= dec;
                const int base_b = (int)(uintptr_t)(L + O_BN) + (8 * hi + qq) * RS + (nb + 16 * blk + 4 * pp) * 2;
                const int base_w = (int)(uintptr_t)(L + O_XW) + (8 * hi + qq) * 64 + (16 * blk + 4 * pp) * 2;
                state_steps<0>(S, base_b, base_w); state_steps<4>(S, base_b, base_w);
            }
            __syncthreads();
        }
#undef CHUNK_ROW
#undef LOADCHUNK
    }
}
}

constexpr int LDS_BYTES = 163840;
#ifndef PROBE_OP
#define PROBE_OP -1
#endif
struct Args { const float* in[21]; float* out; unsigned char* ws; long probe; };

enum Op { OP_GEMM_BF16 = 0, OP_GEMM_XBC, OP_GEMM_IN, OP_ATTN, OP_CONV, OP_SCAN, OP_GEMM_Z, OP_NORM, OP_PROLOGUE };

__device__ __forceinline__ void attn_phase(const Ctx& c, int li, bf16_t* P, const float* sink, const float* qnw, const f32x2* rope, const bool dry, const int pvar) {
    for (int i = blockIdx.x; i < 2112; i += gridDim.x) {
        att::Item it;
        if (i < 2048) {
            const int ii = i & 1023, x = ii & 7, wi = (ii >> 3) & 31, k = ii >> 8, b = x >> 1, kvh = x & 1, head = kvh * 4 + k, i0 = wi * 256;
            const bool mixB = i < 1024;
            it.qrow0 = b * T_ + i0; it.qpos0 = i0;
            if (mixB) { it.qcol = PC_QB + head * 128; it.gcol = PC_GB + head * 128; it.kcol = PC_KB + kvh * 128; it.vcol = PC_VB + kvh * 128;
                it.n0 = T_ / 64; it.r0 = b * T_; it.r1 = MLAT + b * CL; it.NT = T_ / 64 + CL / 64; it.kp1 = 0; it.masked = 0; it.normq = 1; it.has_sink = 0; it.sinkv = 0.f; }
            else { const int ks = i0 >= 128 ? i0 - 128 : 0, ke = i0 + 384 <= T_ ? i0 + 384 : T_;
                it.qcol = PC_QA + head * 128; it.gcol = PC_GA + head * 128; it.kcol = PC_KA + kvh * 128; it.vcol = PC_VA + kvh * 128;
                it.n0 = CL / 64; it.r0 = MLAT + b * CL; it.r1 = b * T_ + ks; it.NT = CL / 64 + (ke - ks) / 64; it.kp1 = ks; it.masked = 1; it.normq = 0; it.has_sink = 1; it.sinkv = sink[head]; }
        } else {
            const int j = i - 2048, head = j & 7, mixB = (j >> 3) & 1, b = j >> 4, kvh = head >> 2;
            it.qrow0 = MLAT + b * CL; it.qpos0 = -1; it.n0 = CL / 64; it.r0 = MLAT + b * CL; it.r1 = 0; it.NT = CL / 64; it.kp1 = 0; it.masked = 0;
            if (mixB) { it.qcol = PC_QB + head * 128; it.gcol = PC_GB + head * 128; it.kcol = PC_KB + kvh * 128; it.vcol = PC_VB + kvh * 128; it.normq = 1; it.has_sink = 0; it.sinkv = 0.f; }
            else { it.qcol = PC_QA + head * 128; it.gcol = PC_GA + head * 128; it.kcol = PC_KA + kvh * 128; it.vcol = PC_VA + kvh * 128; it.normq = 0; it.has_sink = 1; it.sinkv = sink[head]; }
        }
        if (it.masked) att::attn_item<true>(P, it, qnw, rope, c.lds, c.tid, dry); else att::attn_item<false>(P, it, qnw, rope, c.lds, c.tid, dry);
    }
}

__global__ void __launch_bounds__(512) mega(Args a) {
    extern __shared__ __attribute__((aligned(16))) unsigned char lds_[];
    cg::grid_group grid = cg::this_grid();
    volatile XLAS unsigned* bst = (volatile XLAS unsigned*)((XLAS unsigned char*)lds_ + (LDS_BYTES - 16));
    if (threadIdx.x < 4) bst[threadIdx.x] = 0u;
    __syncthreads();
    XcdBarrier xbar = xcd_barrier_post((unsigned*)a.ws, bst);
    int nsync = 0;
    unsigned char* ws = a.ws;
    float* MOD = (float*)(ws + WS_MOD); f32x2* ROPE = (f32x2*)(ws + WS_ROPE); float* CTXR = (float*)(ws + WS_CTX);
    bf16_t* W1 = (bf16_t*)(ws + WS_W1); bf16_t* W2 = (bf16_t*)(ws + WS_W2); bf16_t* HY = (bf16_t*)(ws + WS_HY);
    float* DTB = (float*)(ws + WS_DT); bf16_t* HALO = (bf16_t*)(ws + WS_HALO); bf16_t* BIG = (bf16_t*)(ws + WS_BIG); bf16_t* YB = (bf16_t*)(ws + WS_Y);
    const float* x_in = a.in[0]; const float* cvec = a.in[1]; const float* ctx_in = a.in[2]; const float* c_ctx = a.in[3]; const float* w_ada = a.in[4]; const float* b_ada = a.in[5];
    const float* norm_pre = a.in[6]; const float* norm_post = a.in[7]; const float* attn_w_in = a.in[8]; const float* attn_w_out = a.in[9]; const float* attn_sink = a.in[10];
    const float* attn_qn = a.in[11]; const float* attn_kn = a.in[12]; const float* ssm_w_in = a.in[13]; const float* conv_w = a.in[14]; const float* conv_b = a.in[15];
    const float* dt_bias = a.in[16]; const float* a_log = a.in[17]; const float* ssm_d = a.in[18]; const float* ssm_norm = a.in[19]; const float* ssm_w_out = a.in[20];

    int l = -1, st = 0;
    for (;;) {
        int op; const bool ssm = (l & 1) != 0 && l >= 0;
        if (l < 0) op = st == 0 ? OP_PROLOGUE : OP_NORM;
        else if (!ssm) op = st == 0 ? OP_GEMM_IN : st == 1 ? OP_ATTN : st == 2 ? OP_GEMM_BF16 : OP_NORM;
        else op = st == 0 ? OP_GEMM_XBC : st == 1 ? OP_CONV : (st == 2 || st == 3) ? OP_SCAN : st == 4 ? OP_GEMM_Z : st == 5 ? OP_GEMM_BF16 : OP_NORM;
        const int li = l >> 1;
        {
        constexpr bool dry = false;
        int tid_ = threadIdx.x; asm volatile("" : "+v"(tid_));
        Ctx c; c.tid = tid_; c.lane = c.tid & 63; c.wave = __builtin_amdgcn_readfirstlane(c.tid >> 6); c.gw = blockIdx.x * 8 + c.wave; c.ngw = gridDim.x * 8; c.lds = (char*)lds_;
        switch (op) {
#ifndef DIS_PRO
        case OP_PROLOGUE: {
            convert_weights(c, 0, attn_w_in, attn_w_out, ssm_w_in, ssm_w_out, W1, W2);
            __syncthreads();
            adaln_phase(c, cvec, c_ctx, w_ada, b_ada, MOD);
            rope_phase(c, ROPE);
        } break;
#endif
#ifndef DIS_NORM
        case OP_NORM: {
            const bool first = l <= 0;
            norm_pass(c, l, first ? x_in : a.out, a.out, first ? ctx_in : CTXR, CTXR, HY, MOD, norm_pre, norm_post, l < DEPTH_ - 1, dry);
            if (!dry && l >= 0 && l + 1 < DEPTH_) { __syncthreads(); convert_weights(c, l + 1, attn_w_in, attn_w_out, ssm_w_in, ssm_w_out, W1, W2); }
        } break;
#endif
#ifndef DIS_GEMM
        case OP_GEMM_BF16: {
            pg8::Gemm g; pg8::EpiBf16 E;
            if (!ssm) { g = pg8::Gemm{BIG, W2, MTOT, DM, AW, AIN}; E = pg8::EpiBf16{HY, DM}; }
            else { g = pg8::Gemm{YB, W2, MTOT, DM, DI, DI}; E = pg8::EpiBf16{HY, DM}; }
            if (l == DEPTH_ - 1) g.M = MLAT;
            pg8::StaticOrder S; S.init(g.M, g.N, (int)gridDim.x, (int)blockIdx.x);
            pg8::gemm_phase<pg8::EpiBf16, pg8::StaticOrder, true, true>((PG8_LAS unsigned char*)lds_, g, S, E, c.tid);
        } break;
#endif
#ifndef DIS_GEMMX
        case OP_GEMM_XBC: {
            pg8::Gemm g{HY, W1, MTOT, NXB, DM, DM}; pg8::EpiXbc E{BIG, HALO, DTB, dt_bias + (size_t)li * 64};
            pg8::StaticOrder S; S.init(g.M, g.N, (int)gridDim.x, (int)blockIdx.x);
            pg8::gemm_phase<pg8::EpiXbc, pg8::StaticOrder, true, true>((PG8_LAS unsigned char*)lds_, g, S, E, c.tid);
        } break;
#endif
#ifndef DIS_KPREP
        case OP_GEMM_IN: {
            pg8::Gemm g{HY, W1, MTOT, AIN, DM, DM};
            pg8::EpiAttnIn E{BIG, attn_kn + (size_t)li * 128, ROPE, (PG8_LAS float*)((PG8_LAS unsigned char*)lds_ + 131072)};
            pg8::StaticOrder S; S.init(g.M, g.N, (int)gridDim.x, (int)blockIdx.x);
            pg8::gemm_phase<pg8::EpiAttnIn, pg8::StaticOrder, true, true>((PG8_LAS unsigned char*)lds_, g, S, E, c.tid);
        } break;
#endif
#ifndef DIS_ATTN
        case OP_ATTN: attn_phase(c, li, BIG, attn_sink + (size_t)li * 8, attn_qn + (size_t)li * 128, ROPE, dry, 0); break;
#endif
#ifndef DIS_CONV
        case OP_CONV: conv_pass(c, BIG, HALO, conv_w + (size_t)li * 3 * CONVD, conv_b + (size_t)li * CONVD, dry); break;
#endif
#ifndef DIS_SCAN
        case OP_SCAN: ssd::scan_phase(c, st == 2 ? 1 : 0, BIG, DTB, YB, a_log + (size_t)li * 64, ssm_d + (size_t)li * 32, dry, 0); break;
#endif
#ifndef DIS_GNORM
        case OP_GEMM_Z: {
            pg8::Gemm g{HY, W1 + (size_t)NXB * DM, l == DEPTH_ - 1 ? MLAT : MTOT, DI, DM, DM};
            pg8::EpiGnorm E{YB, ssm_norm + (size_t)li * DI, (PG8_LAS float*)((PG8_LAS unsigned char*)lds_ + 131072)};
            pg8::StaticOrder S; S.init(g.M, g.N, (int)gridDim.x, (int)blockIdx.x);
            pg8::gemm_phase<pg8::EpiGnorm, pg8::StaticOrder, true, true>((PG8_LAS unsigned char*)lds_, g, S, E, c.tid);
        } break;
#endif
        default: break;
        }
        }
        const int nst = l < 0 ? 2 : (ssm ? 7 : 4);
        if (++st == nst) { st = 0; ++l; if (l == DEPTH_) break; }
        if (nsync++ == 0) grid.sync(); else xcd_barrier(xbar);
    }
}

extern "C" void kernel_launch(void* const* d_in, const int* in_sizes, int n_in, void* d_out, int out_size, void* d_ws, size_t ws_size, hipStream_t stream) {
    static int grid = 0;
    if (grid == 0) {
        if (n_in != 21 || in_sizes[0] != MLAT * DM || out_size != MLAT * DM || ws_size < WS_END) {
            fprintf(stderr, "kernel_launch: unexpected shapes (n_in %d, in0 %d, out %d, ws %zu < %zu?)\n", n_in, n_in > 0 ? in_sizes[0] : -1, out_size, ws_size, (size_t)WS_END); grid = -1; return; }
        int dev = 0, cus = 0, per_cu = 0;
        if (hipGetDevice(&dev) != hipSuccess || hipDeviceGetAttribute(&cus, hipDeviceAttributeMultiprocessorCount, dev) != hipSuccess) { grid = -1; return; }
        if (hipFuncSetAttribute((const void*)mega, hipFuncAttributeMaxDynamicSharedMemorySize, LDS_BYTES) != hipSuccess) { fprintf(stderr, "kernel_launch: hipFuncSetAttribute failed\n"); grid = -1; return; }
        if (hipOccupancyMaxActiveBlocksPerMultiprocessor(&per_cu, (const void*)mega, 512, LDS_BYTES) != hipSuccess || per_cu < 1) { fprintf(stderr, "kernel_launch: occupancy query says %d\n", per_cu); per_cu = 1; }
        (void)hipGetLastError();
        grid = cus * per_cu;
    }
    if (grid < 0) return;
    Args a{};
    for (int i = 0; i < 21; ++i) a.in[i] = (const float*)d_in[i];
    a.out = (float*)d_out; a.ws = (unsigned char*)d_ws; a.probe = PROBE_OP;
    if (hipMemsetAsync(d_ws, 0, 16384, stream) != hipSuccess) { fprintf(stderr, "kernel_launch: memset failed\n"); return; }
    void* args[] = {&a};
    hipError_t e = hipLaunchCooperativeKernel((const void*)mega, dim3(grid), dim3(512), args, LDS_BYTES, stream);
    if (e != hipSuccess) fprintf(stderr, "kernel_launch: cooperative launch failed: %s (grid %d)\n", hipGetErrorString(e), grid);
}
```
